# Optimizing an MI355X kernel written in HIP

```python
import math
import jax, jax.numpy as jnp
from jax import lax
import numpy as np

D_MODEL = 1024
BATCH = 2
SEQ = 8192
DEPTH = 4

N_A_LAYERS = DEPTH // 2
N_B_LAYERS = DEPTH - N_A_LAYERS

DN_HEADS = 8
DN_HEAD_DIM = D_MODEL // DN_HEADS
DN_WIDTH = DN_HEADS * DN_HEAD_DIM
CONV_K = 4
DN_CHUNK = 64

DA_HEADS = 8
DA_HEAD_DIM = D_MODEL // (2 * DA_HEADS)
DA_V_DIM = 2 * DA_HEAD_DIM
DA_QK_WIDTH = 2 * DA_HEADS * DA_HEAD_DIM
DA_WIDTH = DA_HEADS * DA_V_DIM
Q_BLOCK = 128

N_GROUPS = 4
EXPERTS_PER_GROUP = 8
N_EXPERTS = N_GROUPS * EXPERTS_PER_GROUP
TOP_K = 2
EXPERT_FF = D_MODEL // 2
MOE_BLOCK = 128

ALPHA = (2 * DEPTH) ** 0.25
BETA_INIT = (8 * DEPTH) ** -0.25
LN_EPS = 1e-5
RMS_EPS = 1e-6

kernel_name = 'yoco_deltanet_diffattn_hier_moe'


def layer_norm(x, g, b):
    xf = x.astype(jnp.float32)
    mu = jnp.mean(xf, axis=-1, keepdims=True)
    var = jnp.mean(jnp.square(xf - mu), axis=-1, keepdims=True)
    return ((xf - mu) * lax.rsqrt(var + LN_EPS) * g + b).astype(x.dtype)


def rms_norm(x, w):
    xf = x.astype(jnp.float32)
    return xf * lax.rsqrt(jnp.mean(jnp.square(xf), axis=-1, keepdims=True) + RMS_EPS) * w.astype(jnp.float32)


def l2_normalize(x):
    xf = x.astype(jnp.float32)
    return xf * lax.rsqrt(jnp.sum(jnp.square(xf), axis=-1, keepdims=True) + RMS_EPS)


def causal_depthwise_conv(x, w):
    k_width, t = w.shape[0], x.shape[1]
    xp = jnp.pad(x, ((0, 0), (k_width - 1, 0), (0, 0)))
    y = xp[:, 0:t] * w[0]
    for j in range(1, k_width):
        y = y + xp[:, j:j + t] * w[j]
    return y


def chunked_gated_delta_rule(q, k, v, g, beta):
    b, t, h, dk = q.shape
    dv = v.shape[-1]
    n, c = t // DN_CHUNK, DN_CHUNK

    def to_chunks(a):
        return jnp.moveaxis(a.reshape((b, n, c, h) + a.shape[3:]), 3, 1)

    q = to_chunks(q * dk ** -0.5)
    k = to_chunks(k)
    v = to_chunks(v.astype(jnp.float32))
    gc = jnp.cumsum(to_chunks(g), axis=-1)
    beta = to_chunks(beta)
    idx = jnp.arange(c)
    causal = idx[:, None] >= idx[None, :]
    strict = idx[:, None] > idx[None, :]
    decay = jnp.exp(jnp.where(causal, gc[..., :, None] - gc[..., None, :], -jnp.inf))
    k_beta = k * beta[..., None]
    a_mat = jnp.where(strict, jnp.einsum('bhnid,bhnjd->bhnij', k_beta, k) * decay, 0.0)
    rhs = jnp.concatenate([v * beta[..., None], k_beta * jnp.exp(gc)[..., None]], axis=-1)
    sol = lax.linalg.triangular_solve(a_mat + jnp.eye(c, dtype=jnp.float32), rhs,
                                      left_side=True, lower=True, unit_diagonal=True)
    u, w = sol[..., :dv], sol[..., dv:]
    attn = jnp.where(causal, jnp.einsum('bhnid,bhnjd->bhnij', q, k) * decay, 0.0)
    q_dec = q * jnp.exp(gc)[..., None]
    k_dec = k * jnp.exp(gc[..., -1:] - gc)[..., None]
    g_last = jnp.exp(gc[..., -1])

    def step(state, xs):
        u_i, w_i, q_i, k_i, attn_i, gl_i = xs
        v_new = u_i - jnp.einsum('bhcd,bhdv->bhcv', w_i, state)
        o_i = jnp.einsum('bhcd,bhdv->bhcv', q_i, state) + jnp.einsum('bhij,bhjv->bhiv', attn_i, v_new)
        state = state * gl_i[..., None, None] + jnp.einsum('bhcd,bhcv->bhdv', k_i, v_new)
        return state, o_i

    xs = tuple(jnp.moveaxis(a, 2, 0) for a in (u, w, q_dec, k_dec, attn, g_last))
    state0 = jnp.zeros((b, h, dk, dv), jnp.float32)
    _, o = lax.scan(step, state0, xs)
    return o.transpose(1, 0, 3, 2, 4).reshape(b, t, h, dv)


def gated_deltanet(x, w_in, conv_w, a_log, dt_bias, norm_w, w_out):
    b, t, _ = x.shape
    proj = x @ w_in
    qkv = jax.nn.silu(causal_depthwise_conv(proj[..., :3 * DN_WIDTH], conv_w))
    qkv = qkv.reshape(b, t, 3, DN_HEADS, DN_HEAD_DIM)
    q = l2_normalize(qkv[:, :, 0])
    k = l2_normalize(qkv[:, :, 1])
    v = qkv[:, :, 2]
    z = proj[..., 3 * DN_WIDTH:4 * DN_WIDTH].reshape(b, t, DN_HEADS, DN_HEAD_DIM)
    beta = jax.nn.sigmoid(proj[..., 4 * DN_WIDTH:4 * DN_WIDTH + DN_HEADS].astype(jnp.float32))
    alpha_logit = proj[..., 4 * DN_WIDTH + DN_HEADS:].astype(jnp.float32)
    g = -jnp.exp(a_log.astype(jnp.float32)) * jax.nn.softplus(alpha_logit + dt_bias.astype(jnp.float32))
    o = chunked_gated_delta_rule(q, k, v, g, beta)
    o = rms_norm(o, norm_w) * jax.nn.silu(z.astype(jnp.float32))
    return o.reshape(b, t, DN_WIDTH).astype(x.dtype) @ w_out


def shared_kv(x, kv_w):
    b, t, _ = x.shape
    kv = x @ kv_w
    keys = kv[..., :DA_QK_WIDTH].reshape(b, t, DA_HEADS, 2, DA_HEAD_DIM).transpose(3, 0, 2, 1, 4)
    vals = kv[..., DA_QK_WIDTH:].reshape(b, t, DA_HEADS, DA_V_DIM).transpose(0, 2, 1, 3)
    return keys, vals


def differential_attention(x, keys, vals, w_q, lam_p, subln_w, w_out, lam_init):
    b, t, _ = x.shape
    nb = t // Q_BLOCK
    q = (x @ w_q).reshape(b, nb, Q_BLOCK, DA_HEADS, 2, DA_HEAD_DIM).transpose(1, 4, 0, 3, 2, 5)
    lp = lam_p.astype(jnp.float32)
    lam = jnp.exp(jnp.sum(lp[0] * lp[1])) - jnp.exp(jnp.sum(lp[2] * lp[3])) + lam_init
    key_pos = jnp.arange(t)
    scale = DA_HEAD_DIM ** -0.5

    def block(args):
        q_blk, blk = args
        query_pos = blk * Q_BLOCK + jnp.arange(Q_BLOCK)
        mask = key_pos[None, :] <= query_pos[:, None]
        s = jnp.einsum('sbhqd,sbhkd->sbhqk', q_blk, keys).astype(jnp.float32) * scale
        p = jax.nn.softmax(jnp.where(mask, s, -jnp.inf), axis=-1)
        a = p[0] - lam * p[1]
        return jnp.einsum('bhqk,bhkv->bhqv', a.astype(vals.dtype), vals)

    o = lax.map(block, (q, jnp.arange(nb)))
    o = o.transpose(1, 0, 3, 2, 4).reshape(b, t, DA_HEADS, DA_V_DIM)
    o = rms_norm(o, subln_w) * (1.0 - lam_init)
    return o.reshape(b, t, DA_WIDTH).astype(x.dtype) @ w_out


def hierarchical_moe(x, w_group, w_expert, w13, w2):
    b, t, d = x.shape
    n = b * t
    m = n * TOP_K
    xf = x.reshape(n, d)
    group_prob = jax.nn.softmax((xf @ w_group).astype(jnp.float32), axis=-1)
    p_group, group_idx = lax.top_k(group_prob, 1)
    expert_logits = (xf @ w_expert).astype(jnp.float32).reshape(n, N_GROUPS, EXPERTS_PER_GROUP)
    in_group = expert_logits[jnp.arange(n), group_idx[:, 0]]
    top_p, top_i = lax.top_k(jax.nn.softmax(in_group, axis=-1), TOP_K)
    gate = (p_group * top_p / jnp.sum(top_p, axis=-1, keepdims=True)).reshape(m)
    expert_id = (group_idx * EXPERTS_PER_GROUP + top_i).reshape(m)
    token_id = jnp.repeat(jnp.arange(n), TOP_K)
    order = jnp.argsort(expert_id)
    eid_s, tok_s, gate_s = expert_id[order], token_id[order], gate[order]
    counts = jnp.bincount(expert_id, length=N_EXPERTS)
    start = jnp.cumsum(counts) - counts
    padded = (counts + MOE_BLOCK - 1) // MOE_BLOCK * MOE_BLOCK
    pad_end = jnp.cumsum(padded)
    pad_start = pad_end - padded
    dest = pad_start[eid_s] + jnp.arange(m) - start[eid_s]
    n_rows = (m + N_EXPERTS * (MOE_BLOCK - 1) + MOE_BLOCK - 1) // MOE_BLOCK * MOE_BLOCK
    n_blocks = n_rows // MOE_BLOCK
    row_tok = jnp.zeros((n_rows,), jnp.int32).at[dest].set(tok_s)
    row_gate = jnp.zeros((n_rows,), x.dtype).at[dest].set(gate_s.astype(x.dtype))
    block_eid = jnp.minimum(jnp.searchsorted(pad_end, jnp.arange(n_blocks) * MOE_BLOCK, side='right'),
                            N_EXPERTS - 1)
    x_rows = xf[row_tok].reshape(n_blocks, MOE_BLOCK, d)

    def expert_block(args):
        xb, e = args
        hcat = xb @ w13[e]
        hid = jax.nn.silu(hcat[:, :EXPERT_FF]) * hcat[:, EXPERT_FF:]
        return hid @ w2[e]

    y_rows = lax.map(expert_block, (x_rows, block_eid)).reshape(n_rows, d)
    y = jax.ops.segment_sum(y_rows * row_gate[:, None], row_tok, num_segments=n)
    return y.reshape(b, t, d)


def lambda_init(layer_idx):
    return 0.8 - 0.6 * math.exp(-0.3 * layer_idx)


def setup_inputs(seed: int = 0) -> dict:
    key = jax.random.key(seed)
    ks = jax.random.split(key, 24)
    f32 = jnp.float32
    D = D_MODEL

    def nrm(k, shape, scale):
        return jax.random.normal(k, shape, f32) * scale

    in_a = 4 * DN_WIDTH + 2 * DN_HEADS
    x = nrm(ks[0], (BATCH, SEQ, D), 1.0)
    a_w_in = nrm(ks[1], (N_A_LAYERS, D, in_a), D ** -0.5)
    a_conv_w = nrm(ks[2], (N_A_LAYERS, CONV_K, 3 * DN_WIDTH), CONV_K ** -0.5)
    a_a_log = jnp.log(jax.random.uniform(ks[3], (N_A_LAYERS, DN_HEADS), f32, 1.0, 16.0))
    dt = jnp.exp(jax.random.uniform(ks[4], (N_A_LAYERS, DN_HEADS), f32, math.log(1e-3), math.log(1e-1)))
    a_dt_bias = dt + jnp.log(-jnp.expm1(-dt))
    a_norm_w = 1.0 + nrm(ks[5], (N_A_LAYERS, DN_HEAD_DIM), 0.02)
    a_w_out = nrm(ks[6], (N_A_LAYERS, DN_WIDTH, D), DN_WIDTH ** -0.5 * BETA_INIT)
    kv_w = nrm(ks[7], (D, DA_QK_WIDTH + DA_WIDTH), D ** -0.5)
    b_w_q = nrm(ks[8], (N_B_LAYERS, D, DA_QK_WIDTH), D ** -0.5)
    b_lambda = nrm(ks[9], (N_B_LAYERS, 4, DA_HEAD_DIM), 0.1)
    b_subln_w = 1.0 + nrm(ks[10], (N_B_LAYERS, DA_V_DIM), 0.02)
    b_w_out = nrm(ks[11], (N_B_LAYERS, DA_WIDTH, D), DA_WIDTH ** -0.5 * BETA_INIT)
    ln_mix_g = 1.0 + nrm(ks[12], (DEPTH, D), 0.02)
    ln_mix_b = nrm(ks[13], (DEPTH, D), 0.02)
    ln_ffn_g = 1.0 + nrm(ks[14], (DEPTH, D), 0.02)
    ln_ffn_b = nrm(ks[15], (DEPTH, D), 0.02)
    moe_w_group = nrm(ks[16], (DEPTH, D, N_GROUPS), D ** -0.5)
    moe_w_expert = nrm(ks[17], (DEPTH, D, N_EXPERTS), D ** -0.5)
    moe_w13 = nrm(ks[18], (DEPTH, N_EXPERTS, D, 2 * EXPERT_FF), D ** -0.5)
    moe_w2 = nrm(ks[19], (DEPTH, N_EXPERTS, EXPERT_FF, D), EXPERT_FF ** -0.5 * BETA_INIT)
    return {'x': x, 'a_w_in': a_w_in, 'a_conv_w': a_conv_w, 'a_a_log': a_a_log, 'a_dt_bias': a_dt_bias,
            'a_norm_w': a_norm_w, 'a_w_out': a_w_out, 'kv_w': kv_w, 'b_w_q': b_w_q, 'b_lambda': b_lambda,
            'b_subln_w': b_subln_w, 'b_w_out': b_w_out, 'ln_mix_g': ln_mix_g, 'ln_mix_b': ln_mix_b,
            'ln_ffn_g': ln_ffn_g, 'ln_ffn_b': ln_ffn_b, 'moe_w_group': moe_w_group,
            'moe_w_expert': moe_w_expert, 'moe_w13': moe_w13, 'moe_w2': moe_w2}


def reference(x, a_w_in, a_conv_w, a_a_log, a_dt_bias, a_norm_w, a_w_out, kv_w, b_w_q, b_lambda,
              b_subln_w, b_w_out, ln_mix_g, ln_mix_b, ln_ffn_g, ln_ffn_b, moe_w_group, moe_w_expert,
              moe_w13, moe_w2):
    h = x
    keys, vals = None, None
    for layer in range(DEPTH):
        if layer < N_A_LAYERS:
            mix = gated_deltanet(h, a_w_in[layer], a_conv_w[layer], a_a_log[layer], a_dt_bias[layer],
                                 a_norm_w[layer], a_w_out[layer])
        else:
            j = layer - N_A_LAYERS
            if j == 0:
                keys, vals = shared_kv(h, kv_w)
            mix = differential_attention(h, keys, vals, b_w_q[j], b_lambda[j], b_subln_w[j], b_w_out[j],
                                         lambda_init(layer))
        h = layer_norm(ALPHA * h + mix, ln_mix_g[layer], ln_mix_b[layer])
        ffn = hierarchical_moe(h, moe_w_group[layer], moe_w_expert[layer], moe_w13[layer], moe_w2[layer])
        h = layer_norm(ALPHA * h + ffn, ln_ffn_g[layer], ln_ffn_b[layer])
    return h
```

```cpp
#include <hip/hip_runtime.h>
#include <stdint.h>
#include <stdio.h>
#include <math.h>

namespace nv {
constexpr int B_ = 2, T_ = 8192, D_ = 1024, NTOK = B_ * T_;
constexpr int INA = 4112, NH = 8, HD = 128;
constexpr int NEXP = 32, MOEB = 128, NROWS = 36864, NBLK = NROWS / MOEB;
constexpr float ALPHA = 1.6817928305074292f;
constexpr float LN_EPS = 1e-5f, RMS_EPS = 1e-6f;

__global__ __launch_bounds__(256) void gemm_naive(const float* __restrict__ A, int lda, const int* __restrict__ arow, const float* __restrict__ Bw, int ldb, long bstride,
                                                  const int* __restrict__ tile_e, float* __restrict__ C, int ldc, int M, int N, int K) {
    __shared__ float As[16][68];
    __shared__ float Bs[16][68];
    const int t = threadIdx.x, tx = t & 15, ty = t >> 4;
    const int row0 = blockIdx.y * 64, col0 = blockIdx.x * 64;
    const float* Bp = Bw;
    if (tile_e) { const int e = tile_e[row0 / MOEB]; if (e < 0) return; Bp = Bw + (long)e * bstride; }
    const int ar = t >> 2, ak = (t & 3) * 4;
    long arow_off;
    { int r = row0 + ar; if (arow) r = arow[r]; arow_off = (long)r * lda; }
    const int bk = t >> 4, bc = (t & 15) * 4;
    const bool bok = (col0 + bc) < N;
    float acc[4][4];
#pragma unroll
    for (int i = 0; i < 4; ++i)
#pragma unroll
        for (int j = 0; j < 4; ++j) acc[i][j] = 0.f;
    for (int k0 = 0; k0 < K; k0 += 16) {
        const float4 av = *(const float4*)(A + arow_off + k0 + ak);
        float4 bv = make_float4(0.f, 0.f, 0.f, 0.f);
        if (bok) bv = *(const float4*)(Bp + (long)(k0 + bk) * ldb + col0 + bc);
        __syncthreads();
        As[ak + 0][ar] = av.x; As[ak + 1][ar] = av.y; As[ak + 2][ar] = av.z; As[ak + 3][ar] = av.w;
        *(float4*)&Bs[bk][bc] = bv;
        __syncthreads();
#pragma unroll
        for (int k = 0; k < 16; ++k) {
            const float4 a = *(const float4*)&As[k][ty * 4];
            const float4 b = *(const float4*)&Bs[k][tx * 4];
            const float aa[4] = {a.x, a.y, a.z, a.w}, bb[4] = {b.x, b.y, b.z, b.w};
#pragma unroll
            for (int i = 0; i < 4; ++i)
#pragma unroll
                for (int j = 0; j < 4; ++j) acc[i][j] = fmaf(aa[i], bb[j], acc[i][j]);
        }
    }
    if (col0 + tx * 4 < N) {
#pragma unroll
        for (int i = 0; i < 4; ++i) *(float4*)(C + (long)(row0 + ty * 4 + i) * ldc + col0 + tx * 4) = make_float4(acc[i][0], acc[i][1], acc[i][2], acc[i][3]);
    }
}

__device__ __forceinline__ float wave_sum(float v) {
#pragma unroll
    for (int o = 1; o < 64; o <<= 1) v += __shfl_xor(v, o);
    return v;
}
__device__ __forceinline__ float silu_f(float x) { return x / (1.f + expf(-x)); }

__global__ __launch_bounds__(256) void ln_naive(const float* __restrict__ h, const float* __restrict__ addp, const float* __restrict__ yrows, const int* __restrict__ apos,
                                                const float* __restrict__ gate, const float* __restrict__ g, const float* __restrict__ b, float* __restrict__ out, int mode) {
    const int lane = threadIdx.x & 63, row = blockIdx.x * 4 + (threadIdx.x >> 6);
    float v[16];
    const float* hr = h + (long)row * D_;
    const float* a0 = nullptr; const float* a1 = nullptr; float g0 = 1.f, g1 = 0.f;
    if (mode == 0) { a0 = addp + (long)row * D_; }
    else { a0 = yrows + (long)apos[2 * row] * D_; a1 = yrows + (long)apos[2 * row + 1] * D_; g0 = gate[2 * row]; g1 = gate[2 * row + 1]; }
    float s = 0.f;
#pragma unroll
    for (int j = 0; j < 4; ++j) {
        const int c = j * 256 + lane * 4;
        const float4 hv = *(const float4*)(hr + c);
        float4 av = *(const float4*)(a0 + c);
        if (mode == 1) { const float4 bv = *(const float4*)(a1 + c); av.x = g0 * av.x + g1 * bv.x; av.y = g0 * av.y + g1 * bv.y; av.z = g0 * av.z + g1 * bv.z; av.w = g0 * av.w + g1 * bv.w; }
        v[j * 4 + 0] = ALPHA * hv.x + av.x; v[j * 4 + 1] = ALPHA * hv.y + av.y; v[j * 4 + 2] = ALPHA * hv.z + av.z; v[j * 4 + 3] = ALPHA * hv.w + av.w;
        s += (v[j * 4] + v[j * 4 + 1]) + (v[j * 4 + 2] + v[j * 4 + 3]);
    }
    const float mean = wave_sum(s) * (1.f / D_);
    float q = 0.f;
#pragma unroll
    for (int i = 0; i < 16; ++i) { v[i] -= mean; q += v[i] * v[i]; }
    const float rstd = 1.f / sqrtf(wave_sum(q) * (1.f / D_) + LN_EPS);
#pragma unroll
    for (int j = 0; j < 4; ++j) {
        const int c = j * 256 + lane * 4;
        const float4 gv = *(const float4*)(g + c), bv = *(const float4*)(b + c);
        *(float4*)(out + (long)row * D_ + c) = make_float4(v[j * 4] * rstd * gv.x + bv.x, v[j * 4 + 1] * rstd * gv.y + bv.y, v[j * 4 + 2] * rstd * gv.z + bv.z, v[j * 4 + 3] * rstd * gv.w + bv.w);
    }
}

__global__ __launch_bounds__(256) void dn_prep_naive(const float* __restrict__ proj, const float* __restrict__ convw, const float* __restrict__ a_log, const float* __restrict__ dt_bias,
                                                     float* __restrict__ qn, float* __restrict__ kn, float* __restrict__ vv, float* __restrict__ beta, float* __restrict__ gg) {
    const int lane = threadIdx.x & 63, w = blockIdx.x * 4 + (threadIdx.x >> 6);
    const int tok = w >> 3, hh = w & 7, tpos = tok % T_;
    float val[3][2];
#pragma unroll
    for (int which = 0; which < 3; ++which)
#pragma unroll
        for (int e = 0; e < 2; ++e) {
            const int c = which * 1024 + hh * 128 + lane * 2 + e;
            float y = 0.f;
#pragma unroll
            for (int j = 0; j < 4; ++j) { const int tt = tpos - 3 + j; if (tt >= 0) y = fmaf(convw[j * 3072 + c], proj[(long)(tok - 3 + j) * INA + c], y); }
            val[which][e] = silu_f(y);
        }
    const float sq = wave_sum(val[0][0] * val[0][0] + val[0][1] * val[0][1]);
    const float sk = wave_sum(val[1][0] * val[1][0] + val[1][1] * val[1][1]);
    const float rq = 1.f / sqrtf(sq + RMS_EPS), rk = 1.f / sqrtf(sk + RMS_EPS);
    const long o = ((long)tok * NH + hh) * HD + lane * 2;
    *(float2*)(qn + o) = make_float2(val[0][0] * rq, val[0][1] * rq);
    *(float2*)(kn + o) = make_float2(val[1][0] * rk, val[1][1] * rk);
    *(float2*)(vv + o) = make_float2(val[2][0], val[2][1]);
    if (lane == 0) {
        const float bl = proj[(long)tok * INA + 4096 + hh], al = proj[(long)tok * INA + 4104 + hh];
        beta[(long)tok * NH + hh] = 1.f / (1.f + expf(-bl));
        const float x = al + dt_bias[hh];
        const float sp = (x > 20.f) ? x : log1pf(expf(x));
        gg[(long)tok * NH + hh] = -expf(a_log[hh]) * sp;
    }
}

__global__ __launch_bounds__(64) void delta_naive(const float* __restrict__ qn, const float* __restrict__ kn, const float* __restrict__ vv, const float* __restrict__ beta,
                                                  const float* __restrict__ gg, float* __restrict__ o) {
    const int bh = blockIdx.x >> 1, half = blockIdx.x & 1, b = bh >> 3, hh = bh & 7, lane = threadIdx.x, col = half * 64 + lane;
    __shared__ float ks[32][128];
    __shared__ float qs[32][128];
    __shared__ float bs[32], gs[32];
    float S[128];
#pragma unroll
    for (int i = 0; i < 128; ++i) S[i] = 0.f;
    for (int t0 = 0; t0 < T_; t0 += 32) {
        __syncthreads();
        for (int i = lane; i < 32 * 32; i += 64) {
            const int tt = i >> 5, c4 = (i & 31) * 4; const long base = ((long)(b * T_ + t0 + tt) * NH + hh) * HD + c4;
            *(float4*)&ks[tt][c4] = *(const float4*)(kn + base); *(float4*)&qs[tt][c4] = *(const float4*)(qn + base);
        }
        if (lane < 32) { bs[lane] = beta[(long)(b * T_ + t0 + lane) * NH + hh]; gs[lane] = gg[(long)(b * T_ + t0 + lane) * NH + hh]; }
        __syncthreads();
#pragma unroll 1
        for (int tt = 0; tt < 32; ++tt) {
            const float eg = expf(gs[tt]), bt = bs[tt];
            const long oi = ((long)(b * T_ + t0 + tt) * NH + hh) * HD + col;
            const float v = vv[oi];
            float kS = 0.f;
#pragma unroll
            for (int i = 0; i < 128; ++i) kS = fmaf(ks[tt][i], S[i], kS);
            const float vn = bt * (v - eg * kS);
            float oo = 0.f;
#pragma unroll
            for (int i = 0; i < 128; ++i) { S[i] = fmaf(ks[tt][i], vn, eg * S[i]); oo = fmaf(qs[tt][i], S[i], oo); }
            o[oi] = oo * 0.08838834764831845f;
        }
    }
}

__global__ __launch_bounds__(256) void dn_gate_naive(const float* __restrict__ o, const float* __restrict__ proj, const float* __restrict__ norm_w, float* __restrict__ on) {
    const int lane = threadIdx.x & 63, w = blockIdx.x * 4 + (threadIdx.x >> 6);
    const int tok = w >> 3, hh = w & 7;
    const long oi = ((long)tok * NH + hh) * HD + lane * 2;
    const float2 ov = *(const float2*)(o + oi);
    const float ms = wave_sum(ov.x * ov.x + ov.y * ov.y) * (1.f / HD);
    const float r = 1.f / sqrtf(ms + RMS_EPS);
    const float z0 = proj[(long)tok * INA + 3072 + hh * 128 + lane * 2], z1 = proj[(long)tok * INA + 3072 + hh * 128 + lane * 2 + 1];
    *(float2*)(on + oi) = make_float2(ov.x * r * norm_w[lane * 2] * silu_f(z0), ov.y * r * norm_w[lane * 2 + 1] * silu_f(z1));
}

__global__ __launch_bounds__(256) void attn_naive(const float* __restrict__ q, const float* __restrict__ kv, const float* __restrict__ lam_p, const float* __restrict__ subln,
                                                  float lam_init, float* __restrict__ on) {
    __shared__ float Q1[32][64], Q2[32][64];
    __shared__ float K1[32][65], K2[32][65];
    __shared__ float V[32][128];
    __shared__ float P1[32][33], P2[32][33];
    const int t = threadIdx.x;
    const int qb = (T_ / 32 - 1) - (blockIdx.x % (T_ / 32));
    const int bh = blockIdx.x / (T_ / 32), b = bh >> 3, hh = bh & 7;
    const int qi = t >> 3, sub = t & 7;
    float l01 = 0.f, l23 = 0.f;
    for (int i = 0; i < 64; ++i) { l01 = fmaf(lam_p[i], lam_p[64 + i], l01); l23 = fmaf(lam_p[128 + i], lam_p[192 + i], l23); }
    const float lam = expf(l01) - expf(l23) + lam_init;
    for (int i = t; i < 32 * 32; i += 256) {
        const int r = i >> 5, c4 = (i & 31) * 4; const float4 v = *(const float4*)(q + (long)(b * T_ + qb * 32 + r) * 1024 + hh * 128 + c4);
        if (c4 < 64) *(float4*)&Q1[r][c4] = v; else *(float4*)&Q2[r][c4 - 64] = v;
    }
    float m1 = -INFINITY, m2 = -INFINITY, l1 = 0.f, l2 = 0.f;
    float o1[16], o2[16];
#pragma unroll
    for (int i = 0; i < 16; ++i) { o1[i] = 0.f; o2[i] = 0.f; }
    for (int kt = 0; kt <= qb; ++kt) {
        __syncthreads();
        for (int i = t; i < 32 * 32; i += 256) {
            const int r = i >> 5, c4 = (i & 31) * 4; const long rowb = (long)(b * T_ + kt * 32 + r) * 2048;
            const float4 kk = *(const float4*)(kv + rowb + hh * 128 + c4);
            if (c4 < 64) { K1[r][c4] = kk.x; K1[r][c4 + 1] = kk.y; K1[r][c4 + 2] = kk.z; K1[r][c4 + 3] = kk.w; }
            else { K2[r][c4 - 64] = kk.x; K2[r][c4 - 63] = kk.y; K2[r][c4 - 62] = kk.z; K2[r][c4 - 61] = kk.w; }
            *(float4*)&V[r][c4] = *(const float4*)(kv + rowb + 1024 + hh * 128 + c4);
        }
        __syncthreads();
        float s1[4] = {0.f, 0.f, 0.f, 0.f}, s2[4] = {0.f, 0.f, 0.f, 0.f};
#pragma unroll 8
        for (int d = 0; d < 64; ++d) {
            const float a1 = Q1[qi][d], a2 = Q2[qi][d];
#pragma unroll
            for (int j = 0; j < 4; ++j) { s1[j] = fmaf(a1, K1[sub * 4 + j][d], s1[j]); s2[j] = fmaf(a2, K2[sub * 4 + j][d], s2[j]); }
        }
        float tm1 = -INFINITY, tm2 = -INFINITY;
#pragma unroll
        for (int j = 0; j < 4; ++j) {
            s1[j] *= 0.125f; s2[j] *= 0.125f;
            if (kt == qb && (sub * 4 + j) > qi) { s1[j] = -INFINITY; s2[j] = -INFINITY; }
            tm1 = fmaxf(tm1, s1[j]); tm2 = fmaxf(tm2, s2[j]);
        }
#pragma unroll
        for (int o = 1; o < 8; o <<= 1) { tm1 = fmaxf(tm1, __shfl_xor(tm1, o)); tm2 = fmaxf(tm2, __shfl_xor(tm2, o)); }
        const float n1 = fmaxf(m1, tm1), n2 = fmaxf(m2, tm2);
        const float f1 = expf(m1 - n1), f2 = expf(m2 - n2);
        float ps1 = 0.f, ps2 = 0.f;
#pragma unroll
        for (int j = 0; j < 4; ++j) { const float p1 = expf(s1[j] - n1), p2 = expf(s2[j] - n2); P1[qi][sub * 4 + j] = p1; P2[qi][sub * 4 + j] = p2; ps1 += p1; ps2 += p2; }
#pragma unroll
        for (int o = 1; o < 8; o <<= 1) { ps1 += __shfl_xor(ps1, o); ps2 += __shfl_xor(ps2, o); }
        l1 = l1 * f1 + ps1; l2 = l2 * f2 + ps2; m1 = n1; m2 = n2;
#pragma unroll
        for (int i = 0; i < 16; ++i) { o1[i] *= f1; o2[i] *= f2; }
        __syncthreads();
#pragma unroll 4
        for (int j = 0; j < 32; ++j) {
            const float p1 = P1[qi][j], p2 = P2[qi][j];
#pragma unroll
            for (int i = 0; i < 16; ++i) { const float v = V[j][sub * 16 + i]; o1[i] = fmaf(p1, v, o1[i]); o2[i] = fmaf(p2, v, o2[i]); }
        }
    }
    const float r1 = 1.f / l1, r2 = lam / l2;
    float ss = 0.f;
#pragma unroll
    for (int i = 0; i < 16; ++i) { o1[i] = o1[i] * r1 - o2[i] * r2; ss += o1[i] * o1[i]; }
#pragma unroll
    for (int o = 1; o < 8; o <<= 1) ss += __shfl_xor(ss, o);
    const float rr = (1.f - lam_init) / sqrtf(ss * (1.f / 128.f) + RMS_EPS);
#pragma unroll
    for (int i = 0; i < 16; ++i) on[(long)(b * T_ + qb * 32 + qi) * 1024 + hh * 128 + sub * 16 + i] = o1[i] * rr * subln[sub * 16 + i];
}

__global__ __launch_bounds__(256) void router_naive(const float* __restrict__ h, const float* __restrict__ wg, const float* __restrict__ we, int* __restrict__ eid, float* __restrict__ gate,
                                                    int* __restrict__ counts) {
    __shared__ float hs[4][1024];
    __shared__ float lg[4][40];
    const int lane = threadIdx.x & 63, wv = threadIdx.x >> 6, tok = blockIdx.x * 4 + wv;
#pragma unroll
    for (int j = 0; j < 4; ++j) *(float4*)&hs[wv][j * 256 + lane * 4] = *(const float4*)(h + (long)tok * D_ + j * 256 + lane * 4);
    __syncthreads();
    if (lane < 36) {
        float acc = 0.f;
        if (lane < 4) { for (int i = 0; i < 1024; ++i) acc = fmaf(hs[wv][i], wg[i * 4 + lane], acc); }
        else { for (int i = 0; i < 1024; ++i) acc = fmaf(hs[wv][i], we[i * 32 + (lane - 4)], acc); }
        lg[wv][lane] = acc;
    }
    __syncthreads();
    if (lane == 0) {
        int gi = 0; float gm = lg[wv][0];
        for (int g = 1; g < 4; ++g) if (lg[wv][g] > gm) { gm = lg[wv][g]; gi = g; }
        float gs = 0.f; for (int g = 0; g < 4; ++g) gs += expf(lg[wv][g] - gm);
        const float pg = 1.f / gs;
        const float* el = &lg[wv][4 + gi * 8];
        int i0 = 0; float v0 = el[0];
        for (int i = 1; i < 8; ++i) if (el[i] > v0) { v0 = el[i]; i0 = i; }
        int i1 = -1; float v1 = -INFINITY;
        for (int i = 0; i < 8; ++i) if (i != i0 && el[i] > v1) { v1 = el[i]; i1 = i; }
        const float e1 = expf(v1 - v0);
        const int ea = gi * 8 + i0, eb = gi * 8 + i1;
        eid[2 * tok] = ea; eid[2 * tok + 1] = eb;
        gate[2 * tok] = pg / (1.f + e1); gate[2 * tok + 1] = pg * e1 / (1.f + e1);
        atomicAdd(&counts[ea], 1); atomicAdd(&counts[eb], 1);
    }
}
__global__ void offsets_naive(const int* __restrict__ counts, int* __restrict__ pad_start, int* __restrict__ block_eid) {
    __shared__ int pe[NEXP + 1];
    if (threadIdx.x == 0) { int acc = 0; for (int e = 0; e < NEXP; ++e) { pad_start[e] = acc; acc += (counts[e] + MOEB - 1) / MOEB * MOEB; pe[e] = acc; } }
    __syncthreads();
    for (int blk = threadIdx.x; blk < NBLK; blk += blockDim.x) { const int row = blk * MOEB; int e = -1; for (int i = 0; i < NEXP; ++i) if (pe[i] > row) { e = i; break; } block_eid[blk] = e; }
}
__global__ __launch_bounds__(256) void scatter_naive(const int* __restrict__ eid, const int* __restrict__ pad_start, int* __restrict__ cursor, int* __restrict__ row_tok, int* __restrict__ apos) {
    const int a = blockIdx.x * 256 + threadIdx.x;
    const int e = eid[a]; const int pos = pad_start[e] + atomicAdd(&cursor[e], 1);
    row_tok[pos] = a >> 1; apos[a] = pos;
}
__global__ __launch_bounds__(256) void swiglu_naive(const float* __restrict__ hcat, const int* __restrict__ block_eid, float* __restrict__ hid) {
    const int row = blockIdx.x; if (block_eid[row / MOEB] < 0) return;
    for (int c = threadIdx.x; c < 512; c += 256) { const float a = hcat[(long)row * 1024 + c], g = hcat[(long)row * 1024 + 512 + c]; hid[(long)row * 512 + c] = silu_f(a) * g; }
}
}

extern "C" void kernel_launch(void* const* d_in, const int* in_sizes, int n_in, void* d_out, int out_size, void* d_ws, size_t ws_size, hipStream_t stream) {
    using namespace nv;
    const float* x = (const float*)d_in[0];
    const float* a_w_in = (const float*)d_in[1]; const float* a_conv_w = (const float*)d_in[2]; const float* a_a_log = (const float*)d_in[3];
    const float* a_dt_bias = (const float*)d_in[4]; const float* a_norm_w = (const float*)d_in[5]; const float* a_w_out = (const float*)d_in[6];
    const float* kv_w = (const float*)d_in[7]; const float* b_w_q = (const float*)d_in[8]; const float* b_lambda = (const float*)d_in[9];
    const float* b_subln_w = (const float*)d_in[10]; const float* b_w_out = (const float*)d_in[11];
    const float* ln_mix_g = (const float*)d_in[12]; const float* ln_mix_b = (const float*)d_in[13]; const float* ln_ffn_g = (const float*)d_in[14]; const float* ln_ffn_b = (const float*)d_in[15];
    const float* moe_w_group = (const float*)d_in[16]; const float* moe_w_expert = (const float*)d_in[17]; const float* moe_w13 = (const float*)d_in[18]; const float* moe_w2 = (const float*)d_in[19];
    float* out = (float*)d_out;
    char* ws = (char*)d_ws; size_t off = 0;
    auto take = [&](size_t bytes) { char* p = ws + off; off += (bytes + 255) & ~(size_t)255; return p; };
    int* ctl = (int*)take(4096);
    int* pad_start = (int*)take(256); int* block_eid = (int*)take(NBLK * 4); int* row_tok = (int*)take(NROWS * 4);
    int* eid = (int*)take(2 * NTOK * 4); float* gate = (float*)take(2 * NTOK * 4); int* apos = (int*)take(2 * NTOK * 4);
    float* hA = (float*)take((size_t)NTOK * D_ * 4); float* hB = (float*)take((size_t)NTOK * D_ * 4);
    float* proj = (float*)take((size_t)NTOK * INA * 4);
    float* kvb = (float*)take((size_t)NTOK * 2048 * 4);
    float* qn = (float*)take((size_t)NTOK * D_ * 4); float* kn = (float*)take((size_t)NTOK * D_ * 4); float* vv = (float*)take((size_t)NTOK * D_ * 4);
    float* betab = (float*)take((size_t)NTOK * NH * 4); float* gb = (float*)take((size_t)NTOK * NH * 4);
    float* ob = (float*)take((size_t)NTOK * D_ * 4); float* onb = (float*)take((size_t)NTOK * D_ * 4); float* mix = (float*)take((size_t)NTOK * D_ * 4);
    float* hcat = (float*)take((size_t)NROWS * 1024 * 4); float* hid = (float*)take((size_t)NROWS * 512 * 4); float* yrows = (float*)take((size_t)NROWS * 1024 * 4);
    if (off > ws_size) { fprintf(stderr, "kernel_launch: workspace too small: need %zu have %zu\n", off, ws_size); return; }
    int* counts = ctl; int* cursor = ctl + 32;
    float* qb = proj;

    const float* hcur = x;
    for (int layer = 0; layer < 4; ++layer) {
        float* hmix = hB;
        float* hnext = (layer == 3) ? out : hA;
        if (layer < 2) {
            gemm_naive<<<dim3((INA + 63) / 64, NTOK / 64), 256, 0, stream>>>(hcur, D_, nullptr, a_w_in + (size_t)layer * D_ * INA, INA, 0, nullptr, proj, INA, NTOK, INA, D_);
            dn_prep_naive<<<NTOK * NH / 4, 256, 0, stream>>>(proj, a_conv_w + (size_t)layer * 4 * 3072, a_a_log + layer * 8, a_dt_bias + layer * 8, qn, kn, vv, betab, gb);
            delta_naive<<<32, 64, 0, stream>>>(qn, kn, vv, betab, gb, ob);
            dn_gate_naive<<<NTOK * NH / 4, 256, 0, stream>>>(ob, proj, a_norm_w + layer * 128, onb);
            gemm_naive<<<dim3(D_ / 64, NTOK / 64), 256, 0, stream>>>(onb, D_, nullptr, a_w_out + (size_t)layer * D_ * D_, D_, 0, nullptr, mix, D_, NTOK, D_, D_);
        } else {
            const int j = layer - 2;
            if (j == 0) gemm_naive<<<dim3(2048 / 64, NTOK / 64), 256, 0, stream>>>(hcur, D_, nullptr, kv_w, 2048, 0, nullptr, kvb, 2048, NTOK, 2048, D_);
            gemm_naive<<<dim3(D_ / 64, NTOK / 64), 256, 0, stream>>>(hcur, D_, nullptr, b_w_q + (size_t)j * D_ * D_, D_, 0, nullptr, qb, D_, NTOK, D_, D_);
            const float lam_init = (float)(0.8 - 0.6 * exp(-0.3 * (double)layer));
            attn_naive<<<B_ * NH * (T_ / 32), 256, 0, stream>>>(qb, kvb, b_lambda + j * 256, b_subln_w + j * 128, lam_init, onb);
            gemm_naive<<<dim3(D_ / 64, NTOK / 64), 256, 0, stream>>>(onb, D_, nullptr, b_w_out + (size_t)j * D_ * D_, D_, 0, nullptr, mix, D_, NTOK, D_, D_);
        }
        ln_naive<<<NTOK / 4, 256, 0, stream>>>(hcur, mix, nullptr, nullptr, nullptr, ln_mix_g + layer * D_, ln_mix_b + layer * D_, hmix, 0);
        (void)hipMemsetAsync(ctl, 0, 256, stream);
        (void)hipMemsetAsync(row_tok, 0, NROWS * 4, stream);
        router_naive<<<NTOK / 4, 256, 0, stream>>>(hmix, moe_w_group + (size_t)layer * D_ * 4, moe_w_expert + (size_t)layer * D_ * 32, eid, gate, counts);
        offsets_naive<<<1, 64, 0, stream>>>(counts, pad_start, block_eid);
        scatter_naive<<<2 * NTOK / 256, 256, 0, stream>>>(eid, pad_start, cursor, row_tok, apos);
        gemm_naive<<<dim3(1024 / 64, NROWS / 64), 256, 0, stream>>>(hmix, D_, row_tok, moe_w13 + (size_t)layer * NEXP * 1024 * 1024, 1024, (long)1024 * 1024, block_eid, hcat, 1024, NROWS, 1024, D_);
        swiglu_naive<<<NROWS, 256, 0, stream>>>(hcat, block_eid, hid);
        gemm_naive<<<dim3(1024 / 64, NROWS / 64), 256, 0, stream>>>(hid, 512, nullptr, moe_w2 + (size_t)layer * NEXP * 512 * 1024, 1024, (long)512 * 1024, block_eid, yrows, 1024, NROWS, 1024, 512);
        ln_naive<<<NTOK / 4, 256, 0, stream>>>(hmix, nullptr, yrows, apos, gate, ln_ffn_g + layer * D_, ln_ffn_b + layer * D_, hnext, 1);
        hcur = hnext;
    }
}
```

```cpp
#include <hip/hip_runtime.h>
#include <stdint.h>
#include <stdio.h>
#include <math.h>
#include <cstdint>
namespace pg8 {
#define PG8_LAS __attribute__((address_space(3)))
typedef unsigned short bf16_t;
typedef short bf16x8 __attribute__((ext_vector_type(8)));
typedef float f32x4 __attribute__((ext_vector_type(4)));
typedef unsigned u32x4 __attribute__((ext_vector_type(4)));
constexpr int BM = 256, BK = 64, HALF = 128, HTB = HALF * BK * 2  , STAGE_BYTES = 8 * HTB, NXCD = 8, WGM = 8;

__host__ __device__ __forceinline__ int lds_byte(int r, int c) { const int st = (r >> 4) * 2 + (c >> 5), rr = r & 15, cc = c & 31, ob = rr * 64 + cc * 2; return st * 1024 + (ob ^ (((ob >> 9) & 1) << 5)); }
__host__ __device__ __forceinline__ void stage_rc(int b, int& R, int& C) { const int st = b / 1024, sb = b % 1024, swz = sb ^ (((sb >> 9) & 1) << 5); R = (st >> 1) * 16 + swz / 64; C = (st & 1) * 32 + (swz % 64) / 2; }
__host__ __device__ __forceinline__ int perm32(int rho) { const int n = rho >> 4, i = rho & 15; return 8 * (i >> 2) + 4 * n + (i & 3); }

struct Unit { int pm, pn; };
struct Gemm { const bf16_t* A; const bf16_t* Bt; int M, N, K; };

struct StaticOrder {
    int nM, nN, nwg, G, c;
    __host__ __device__ void init(int M, int N, int G_, int c_) { nM = M / BM; nN = N / BM; nwg = nM * nN; G = G_; c = c_; }
    __host__ __device__ bool next(int i, Unit& u) const {
        const long L = (long)i * G + c; if (L >= nwg) return false;
        int wgid = (int)L; { const int q = nwg / NXCD, r = nwg % NXCD, xcd = wgid % NXCD, off = wgid / NXCD; wgid = (xcd < r ? xcd * (q + 1) : r * (q + 1) + (xcd - r) * q) + off; }
        const int nig = WGM * nN, gid = wgid / nig, fm = gid * WGM, gsz = (nM - fm) < WGM ? (nM - fm) : WGM;
        u.pm = fm + ((wgid % nig) % gsz); u.pn = (wgid % nig) / gsz; return true;
    }
    __device__ __forceinline__ void a_ready(const Unit&) const {}
    __device__ __forceinline__ void done(const Unit&) const {}
};

__device__ __forceinline__ unsigned cvt_pk_bf16(float lo, float hi) { unsigned r; asm volatile("v_cvt_pk_bf16_f32 %0, %1, %2" : "=v"(r) : "v"(lo), "v"(hi)); return r; }
typedef float f32x2 __attribute__((ext_vector_type(2)));
__device__ __forceinline__ f32x2 gelu_pk(f32x2 v) {
    const f32x2 av = __builtin_elementwise_abs(v), d = av * 0.2316418882f + 1.0f;
    f32x2 t; t.x = __builtin_amdgcn_rcpf(d.x); t.y = __builtin_amdgcn_rcpf(d.y);
    f32x2 q = t * 0.5307027145f + (-0.7265760135f); q = q * t + 0.7107068705f; q = q * t + (-0.142248368f); q = q * t + 0.127414796f; q = q * t;
    const f32x2 s = (v * v) * (-0.72134752044f);
    f32x2 e; e.x = __builtin_amdgcn_exp2f(s.x); e.y = __builtin_amdgcn_exp2f(s.y);
    const f32x2 m = v * (q * e), r = v - m;
    f32x2 o; o.x = v.x < 0.f ? m.x : r.x; o.y = v.y < 0.f ? m.y : r.y; return o;
}

template <int ACT  > struct EpiBf16 {
    static constexpr bool PERM = true, AFTER_DRAIN = false; static_assert(ACT == 0 || ACT == 1, "EpiBf16: ACT is 0 (none) or 1 (gelu_pk)");
    bf16_t* O; int ldc; const float* bias; int split_cols; size_t split_stride; float scale0;
    __device__ __forceinline__ void operator()(const f32x4 (&acc)[2][2][4][2], const Unit& u, int wr, int wc, int fr, int fq) const {
        const int row0 = u.pm * BM + wr * 64 + fr; int colt = u.pn * BM; bf16_t* base = O;
        float sc = 1.f; if (split_cols) { const int t = colt / split_cols; base += (size_t)t * split_stride; colt -= t * split_cols; if (t == 0) sc = scale0; }
        const int col0 = colt + wc * 32 + 8 * fq, bcol0 = u.pn * BM + wc * 32 + 8 * fq;
        f32x4 bv[2][2];
#pragma unroll
        for (int bj = 0; bj < 2; ++bj)
#pragma unroll
            for (int n = 0; n < 2; ++n) bv[bj][n] = bias ? *(const f32x4*)(bias + bcol0 + bj * HALF + 4 * n) : (f32x4){0.f, 0.f, 0.f, 0.f};
#pragma unroll
        for (int ai = 0; ai < 2; ++ai)
#pragma unroll
            for (int m = 0; m < 4; ++m) { bf16_t* rowp = base + (size_t)(row0 + ai * HALF + m * 16) * ldc + col0;
#pragma unroll
                for (int bj = 0; bj < 2; ++bj) { f32x4 v0 = acc[ai][bj][m][0] + bv[bj][0], v1 = acc[ai][bj][m][1] + bv[bj][1];
                    if (ACT == 1) { f32x2 a = gelu_pk((f32x2){v0[0], v0[1]}), b = gelu_pk((f32x2){v0[2], v0[3]}), c = gelu_pk((f32x2){v1[0], v1[1]}), d = gelu_pk((f32x2){v1[2], v1[3]});
                        v0 = (f32x4){a.x, a.y, b.x, b.y}; v1 = (f32x4){c.x, c.y, d.x, d.y}; }
                    v0 = v0 * sc; v1 = v1 * sc; u32x4 w; w.x = cvt_pk_bf16(v0[0], v0[1]); w.y = cvt_pk_bf16(v0[2], v0[3]); w.z = cvt_pk_bf16(v1[0], v1[1]); w.w = cvt_pk_bf16(v1[2], v1[3]);
                    *(u32x4*)(rowp + bj * HALF) = w; } }
    }
};

struct PanelStats {
    unsigned* xbuf;
    unsigned* cnt;
    unsigned* tmo;
    int ntn; float eps;
    unsigned code;
    __device__ __forceinline__ bool run(const f32x4 (&v)[2][2][4][2], const Unit& u, int wr, int wc, int fr, int fq, PG8_LAS unsigned char* lds, int wid, int lane) const {
        typedef float f32x2v __attribute__((ext_vector_type(2)));
        PG8_LAS f32x2v* P = (PG8_LAS f32x2v*)lds;
        PG8_LAS f32x2v* S = (PG8_LAS f32x2v*)(lds + 8192);
        PG8_LAS unsigned* flag = (PG8_LAS unsigned*)(lds + 8192 + 2048);
#pragma unroll
        for (int ai = 0; ai < 2; ++ai)
#pragma unroll
            for (int m = 0; m < 4; ++m) {
                float s = 0.f;
#pragma unroll
                for (int bj = 0; bj < 2; ++bj)
#pragma unroll
                    for (int n = 0; n < 2; ++n) { const f32x4 x = v[ai][bj][m][n]; s += (x[0] + x[1]) + (x[2] + x[3]); }
                s += __shfl_xor(s, 16); s += __shfl_xor(s, 32);
                const float mw = s * (1.0f / 64.0f); float q = 0.f;
#pragma unroll
                for (int bj = 0; bj < 2; ++bj)
#pragma unroll
                    for (int n = 0; n < 2; ++n) { const f32x4 d = v[ai][bj][m][n] - mw; q += (d[0] * d[0] + d[1] * d[1]) + (d[2] * d[2] + d[3] * d[3]); }
                q += __shfl_xor(q, 16); q += __shfl_xor(q, 32);
                if (fq == 0) P[(ai * HALF + wr * 64 + m * 16 + fr) * 4 + wc] = (f32x2v){mw, q};
            }
        asm volatile("s_waitcnt lgkmcnt(0)" ::: "memory"); __builtin_amdgcn_s_barrier(); asm volatile("" ::: "memory");
#if defined(BROKEN_EXCHANGE_NO_WAIT)
#warning BROKEN CONTROL BUILD: the row-statistics exchange does not wait; results are wrong by design
        if (blockIdx.x >= 64) { const long long t0_ = clock64(); while (clock64() - t0_ < 60000) __builtin_amdgcn_s_sleep(8); }
#endif
        const int row = wid * 32 + (lane & 31);
        if (lane < 32) {
            const f32x2v a = P[row * 4 + 0], b = P[row * 4 + 1], c = P[row * 4 + 2], d = P[row * 4 + 3];
            const float mt = (a.x + b.x + c.x + d.x) * 0.25f;
            const float da = a.x - mt, db = b.x - mt, dc = c.x - mt, dd = d.x - mt;
            const float m2 = (a.y + b.y) + (c.y + d.y) + 64.0f * ((da * da + db * db) + (dc * dc + dd * dd));
            unsigned long long* slot = (unsigned long long*)xbuf + ((size_t)(u.pm * BM + row) * 4 + u.pn);
            __hip_atomic_store(slot, ((unsigned long long)__float_as_uint(m2) << 32) | __float_as_uint(mt), __ATOMIC_RELAXED, __HIP_MEMORY_SCOPE_AGENT);
        }
        asm volatile("s_waitcnt vmcnt(0)" ::: "memory");
        if (lane == 0) __hip_atomic_fetch_add(cnt + 64 * u.pm, 1u, __ATOMIC_RELAXED, __HIP_MEMORY_SCOPE_AGENT);
        if (wid == 0) {
            bool dead = false; const unsigned long long t0 = __builtin_amdgcn_s_memrealtime(); const unsigned want = 8u * (unsigned)ntn;
            for (;;) {
#if defined(BROKEN_EXCHANGE_NO_WAIT)
                break;
#endif
                if ((unsigned)__builtin_amdgcn_readfirstlane(__hip_atomic_load(cnt + 64 * u.pm, __ATOMIC_RELAXED, __HIP_MEMORY_SCOPE_AGENT)) >= want) break;
                if (__builtin_amdgcn_s_memrealtime() - t0 > 2000000ull) {
                    if (lane == 0) { unsigned expect = 0u; __hip_atomic_compare_exchange_strong(tmo + 1, &expect, code | (unsigned)(u.pm & 0xff), __ATOMIC_RELAXED, __ATOMIC_RELAXED, __HIP_MEMORY_SCOPE_AGENT);
                                     __hip_atomic_store(tmo, 1u, __ATOMIC_RELAXED, __HIP_MEMORY_SCOPE_AGENT); }
                    dead = true; break; }
                __builtin_amdgcn_s_sleep(2);
            }
            __builtin_amdgcn_fence(__ATOMIC_ACQUIRE, "agent");
            if (lane == 0) flag[0] = dead ? 1u : 0u;
        }
        asm volatile("s_waitcnt vmcnt(0) lgkmcnt(0)" ::: "memory"); __builtin_amdgcn_s_barrier(); asm volatile("" ::: "memory");
        const bool bad = flag[0] != 0u;
        if (lane < 32) {
            const unsigned long long* slot = (const unsigned long long*)xbuf + (size_t)(u.pm * BM + row) * 4; float mt[4], m2[4]; float ms = 0.f;
#pragma unroll
            for (int t = 0; t < 4; ++t) { if (t < ntn) { const unsigned long long w = __hip_atomic_load(slot + t, __ATOMIC_RELAXED, __HIP_MEMORY_SCOPE_AGENT); mt[t] = __uint_as_float((unsigned)w); m2[t] = __uint_as_float((unsigned)(w >> 32)); } else { mt[t] = 0.f; m2[t] = 0.f; } ms += mt[t]; }
            const float mean = ms / (float)ntn; float q = 0.f;
#pragma unroll
            for (int t = 0; t < 4; ++t) if (t < ntn) { const float dm = mt[t] - mean; q += m2[t] + 256.0f * dm * dm; }
            S[row] = (f32x2v){mean, 1.0f / sqrtf(q / (256.0f * (float)ntn) + eps)};
        }
        asm volatile("s_waitcnt lgkmcnt(0)" ::: "memory"); __builtin_amdgcn_s_barrier(); asm volatile("" ::: "memory");
        return bad;
    }
};
struct EpiLnRes {
    static constexpr bool PERM = false, AFTER_DRAIN = true;
    const float* base; float* out; int ldc; const float* bias; PanelStats st; unsigned poison;
    __device__ __forceinline__ void fused(f32x4 (&acc)[2][2][4][2], const Unit& u, int wr, int wc, int fr, int fq, PG8_LAS unsigned char* lds, int wid, int lane) const {
        typedef float f32x2v __attribute__((ext_vector_type(2)));
        const PG8_LAS f32x2v* S = (const PG8_LAS f32x2v*)(lds + 8192);
        const int col0 = u.pn * BM + wc * 32 + 4 * fq;
#pragma unroll
        for (int bj = 0; bj < 2; ++bj)
#pragma unroll
            for (int n = 0; n < 2; ++n) { const f32x4 bv = bias ? *(const f32x4*)(bias + col0 + bj * HALF + n * 16) : (f32x4){0.f, 0.f, 0.f, 0.f};
#pragma unroll
                for (int ai = 0; ai < 2; ++ai)
#pragma unroll
                    for (int m = 0; m < 4; ++m) acc[ai][bj][m][n] += bv; }
        f32x4 pre[4][2][2];
#pragma unroll
        for (int m = 0; m < 4; ++m) { const size_t off = (size_t)(u.pm * BM + wr * 64 + m * 16 + fr) * ldc + col0;
#pragma unroll
            for (int bj = 0; bj < 2; ++bj)
#pragma unroll
                for (int n = 0; n < 2; ++n) pre[m][bj][n] = *(const f32x4*)(base + off + bj * HALF + n * 16); }
        const bool bad = st.run(acc, u, wr, wc, fr, fq, lds, wid, lane) || poison != 0u;
        const float qnan = __builtin_nanf("");
#pragma unroll
        for (int ai = 0; ai < 2; ++ai)
#pragma unroll
            for (int m = 0; m < 4; ++m) { const int r = ai * HALF + wr * 64 + m * 16 + fr; const f32x2v sr = S[r]; const size_t off = (size_t)(u.pm * BM + r) * ldc + col0;
#pragma unroll
                for (int bj = 0; bj < 2; ++bj)
#pragma unroll
                    for (int n = 0; n < 2; ++n) { const f32x4 bs = ai == 0 ? pre[m][bj][n] : *(const f32x4*)(base + off + bj * HALF + n * 16); f32x4 o = bs + (acc[ai][bj][m][n] - sr.x) * sr.y;
                        if (bad) o = (f32x4){qnan, qnan, qnan, qnan}; *(f32x4*)(out + off + bj * HALF + n * 16) = o; }
                if (m & 1) asm volatile("" ::: "memory"); }
    }
};
struct EpiLnResLn {
    static constexpr bool PERM = false, AFTER_DRAIN = true;
    const float* base; float* out; bf16_t* xn; int ldc; const float* bias; PanelStats st1, st2; unsigned poison;
    __device__ __forceinline__ void fused(f32x4 (&acc)[2][2][4][2], const Unit& u, int wr, int wc, int fr, int fq, PG8_LAS unsigned char* lds, int wid, int lane) const {
        typedef float f32x2v __attribute__((ext_vector_type(2))); typedef unsigned u32x2v __attribute__((ext_vector_type(2)));
        const PG8_LAS f32x2v* S = (const PG8_LAS f32x2v*)(lds + 8192);
        const int col0 = u.pn * BM + wc * 32 + 4 * fq;
#pragma unroll
        for (int bj = 0; bj < 2; ++bj)
#pragma unroll
            for (int n = 0; n < 2; ++n) { const f32x4 bv = bias ? *(const f32x4*)(bias + col0 + bj * HALF + n * 16) : (f32x4){0.f, 0.f, 0.f, 0.f};
#pragma unroll
                for (int ai = 0; ai < 2; ++ai)
#pragma unroll
                    for (int m = 0; m < 4; ++m) acc[ai][bj][m][n] += bv; }
        bool bad = st1.run(acc, u, wr, wc, fr, fq, lds, wid, lane) || poison != 0u;
        const float qnan = __builtin_nanf("");
#pragma unroll
        for (int ai = 0; ai < 2; ++ai)
#pragma unroll
            for (int m = 0; m < 4; ++m) { const int r = ai * HALF + wr * 64 + m * 16 + fr; const f32x2v sr = S[r]; const size_t off = (size_t)(u.pm * BM + r) * ldc + col0;
#pragma unroll
                for (int bj = 0; bj < 2; ++bj)
#pragma unroll
                    for (int n = 0; n < 2; ++n) { const f32x4 bs = *(const f32x4*)(base + off + bj * HALF + n * 16); acc[ai][bj][m][n] = bs + (acc[ai][bj][m][n] - sr.x) * sr.y; }
                asm volatile("" : "+v"(acc[ai][0][m][0]), "+v"(acc[ai][0][m][1]), "+v"(acc[ai][1][m][0]), "+v"(acc[ai][1][m][1]));
                if (m & 1) asm volatile("" ::: "memory"); }
        const bool bad1 = bad;
        bad = st2.run(acc, u, wr, wc, fr, fq, lds, wid, lane) || bad;
#pragma unroll
        for (int ai = 0; ai < 2; ++ai)
#pragma unroll
            for (int m = 0; m < 4; ++m) { const int r = ai * HALF + wr * 64 + m * 16 + fr; const f32x2v sr = S[r]; const size_t off = (size_t)(u.pm * BM + r) * ldc + col0;
#pragma unroll
                for (int bj = 0; bj < 2; ++bj)
#pragma unroll
                    for (int n = 0; n < 2; ++n) { const f32x4 x1 = acc[ai][bj][m][n]; *(f32x4*)(out + off + bj * HALF + n * 16) = bad1 ? (f32x4){qnan, qnan, qnan, qnan} : x1;
                        const f32x4 o = (x1 - sr.x) * sr.y; u32x2v w; w.x = cvt_pk_bf16(o[0], o[1]); w.y = cvt_pk_bf16(o[2], o[3]);
                        if (bad) { w.x = 0x7fc07fc0u; w.y = 0x7fc07fc0u; } *(u32x2v*)(xn + off + bj * HALF + n * 16) = w; }
                asm volatile("" ::: "memory"); }
    }
};

template <class Epi, class Sched, bool ALIGN_EPI = false, bool SP2 = false>
__device__ __forceinline__ void gemm_phase(PG8_LAS unsigned char* lds, const Gemm g, const Sched& S, const Epi& E, const int wave_id) {
    int tid_ = wave_id * 64 + (int)__builtin_amdgcn_mbcnt_hi(~0u, __builtin_amdgcn_mbcnt_lo(~0u, 0u)); asm volatile("" : "+v"(tid_));
    const int tid = tid_, wid = __builtin_amdgcn_readfirstlane(tid >> 6), lane = tid & 63, wr = wid >> 2, wc = wid & 3, fr = lane & 15, fq = lane >> 4;
    const int K = g.K, nt = K / BK;
    unsigned voffA[2], voffB[2];
#pragma unroll
    for (int i = 0; i < 2; ++i) { int R, C; stage_rc(tid * 16 + i * 8192, R, C); const int Rb = Epi::PERM ? ((R & ~31) + perm32(R & 31)) : R;
        voffA[i] = (unsigned)(R * K + C) * 2u; voffB[i] = (unsigned)(Rb * K + C) * 2u; }
    const size_t kstep = (size_t)(BK * 2);
    const size_t hstep = (size_t)HALF * K * 2;
    const size_t tstep = 2 * hstep;
    const unsigned ldsw = (unsigned)wid * 1024u;
    const int aoff = lds_byte(wr * 64 + fr, fq * 8), boff = lds_byte(wc * 32 + fr, fq * 8);
#define PG8_SA(b, h) (((b) * 2 + (h)) * HTB)
#define PG8_SB(b, h) ((4 + (b) * 2 + (h)) * HTB)
#define PG8_STAGE(bufoff, gbase, voff) do { _Pragma("unroll") for (int _i = 0; _i < 2; ++_i) \
        __builtin_amdgcn_global_load_lds((const unsigned*)((const char*)(gbase) + (voff)[_i]), (PG8_LAS unsigned*)(lds + (bufoff) + ldsw + _i * 8192), 16, 0, 0); } while (0)
#define PG8_LDA(dst, b, h) do { _Pragma("unroll") for (int m = 0; m < 4; ++m) _Pragma("unroll") for (int k = 0; k < 2; ++k) dst[m][k] = *(const PG8_LAS bf16x8*)(lds + PG8_SA(b, h) + aoff + m * 2048 + k * 1024); } while (0)
#define PG8_LDB(dst, b, h) do { _Pragma("unroll") for (int n = 0; n < 2; ++n) _Pragma("unroll") for (int k = 0; k < 2; ++k) dst[n][k] = *(const PG8_LAS bf16x8*)(lds + PG8_SB(b, h) + boff + n * 2048 + k * 1024); } while (0)
#define PG8_MMA(ai, bj, At, Bt) do { __builtin_amdgcn_s_setprio(1); _Pragma("unroll") for (int m = 0; m < 4; ++m) _Pragma("unroll") for (int n = 0; n < 2; ++n) _Pragma("unroll") for (int k = 0; k < 2; ++k) \
        acc[ai][bj][m][n] = __builtin_amdgcn_mfma_f32_16x16x32_bf16(Bt[n][k], At[m][k], acc[ai][bj][m][n], 0, 0, 0); __builtin_amdgcn_s_setprio(0); } while (0)
#define PG8_WAIT_V(n) asm volatile("s_waitcnt vmcnt(" #n ")" ::: "memory")
#define PG8_WAIT_L(n) asm volatile("s_waitcnt lgkmcnt(" #n ")" ::: "memory")
#define PG8_BAR __builtin_amdgcn_s_barrier()
#define PG8_SCHED __builtin_amdgcn_sched_barrier(0)
    Unit cur, nxt; int ui = 0;
    if (!S.next(0, cur)) return;
    f32x4 acc[2][2][4][2];
#pragma unroll
    for (int a = 0; a < 2; ++a)
#pragma unroll
        for (int b = 0; b < 2; ++b)
#pragma unroll
            for (int m = 0; m < 4; ++m)
#pragma unroll
                for (int n = 0; n < 2; ++n) acc[a][b][m][n] = (f32x4){0.f, 0.f, 0.f, 0.f};
    bf16x8 At[4][2], B0[2][2], B1[2][2];
    const char* cA = (const char*)g.A + (size_t)cur.pm * tstep; const char* cB = (const char*)g.Bt + (size_t)cur.pn * tstep;
    S.a_ready(cur);
    if constexpr (SP2) {
        PG8_STAGE(PG8_SB(0, 0), cB, voffB); PG8_STAGE(PG8_SB(0, 1), cB + hstep, voffB); PG8_STAGE(PG8_SA(0, 0), cA, voffA); PG8_STAGE(PG8_SA(0, 1), cA + hstep, voffA);
        if (wr == 1) PG8_BAR;
        PG8_WAIT_V(2); PG8_BAR;
        PG8_STAGE(PG8_SB(1, 0), cB + kstep, voffB); PG8_STAGE(PG8_SA(1, 0), cA + kstep, voffA); PG8_STAGE(PG8_SB(1, 1), cB + hstep + kstep, voffB);
        PG8_WAIT_V(6); PG8_BAR;
    } else {
        PG8_STAGE(PG8_SB(0, 0), cB, voffB); PG8_STAGE(PG8_SA(0, 0), cA, voffA); PG8_STAGE(PG8_SB(0, 1), cB + hstep, voffB); PG8_STAGE(PG8_SA(0, 1), cA + hstep, voffA);
        if (wr == 1) PG8_BAR;
        PG8_WAIT_V(4); PG8_BAR;
        PG8_STAGE(PG8_SB(1, 0), cB + kstep, voffB); PG8_STAGE(PG8_SA(1, 0), cA + kstep, voffA); PG8_STAGE(PG8_SB(1, 1), cB + hstep + kstep, voffB);
        PG8_WAIT_V(6); PG8_BAR;
    }
    for (;;) {
        const bool has_next = S.next(ui + 1, nxt);
        const char* nA = has_next ? (const char*)g.A + (size_t)nxt.pm * tstep : cA; const char* nB = has_next ? (const char*)g.Bt + (size_t)nxt.pn * tstep : cB;
        for (int t = 0; t < nt; t += 2) {
            const bool last = (t == nt - 2);
            const char* a1 = cA + (size_t)(t + 1) * kstep;
            const char* a2 = last ? nA : cA + (size_t)(t + 2) * kstep; const char* b2 = last ? nB : cB + (size_t)(t + 2) * kstep;
            const char* a3 = a2 + kstep; const char* b3 = b2 + kstep;
            if (last && has_next) S.a_ready(nxt);
            if constexpr (SP2) {
            PG8_LDB(B0, 0, 0); PG8_LDB(B1, 0, 1); PG8_SCHED; PG8_LDA(At, 0, 0); PG8_STAGE(PG8_SA(1, 1), a1 + hstep, voffA);
            PG8_WAIT_V(8); PG8_WAIT_L(0); PG8_BAR; PG8_MMA(0, 0, At, B0); PG8_MMA(0, 1, At, B1); PG8_BAR; PG8_SCHED;
            PG8_LDA(At, 0, 1); PG8_STAGE(PG8_SB(0, 0), b2, voffB); PG8_STAGE(PG8_SB(0, 1), b2 + hstep, voffB); PG8_STAGE(PG8_SA(0, 0), a2, voffA);
            PG8_WAIT_V(8); PG8_WAIT_L(0); PG8_BAR; PG8_MMA(1, 0, At, B0); PG8_MMA(1, 1, At, B1); PG8_BAR; PG8_SCHED;
            PG8_LDB(B0, 1, 0); PG8_LDB(B1, 1, 1); PG8_SCHED; PG8_LDA(At, 1, 0); PG8_STAGE(PG8_SA(0, 1), a2 + hstep, voffA);
            PG8_WAIT_V(8); PG8_WAIT_L(0); PG8_BAR; PG8_MMA(0, 0, At, B0); PG8_MMA(0, 1, At, B1); PG8_BAR; PG8_SCHED;
            PG8_LDA(At, 1, 1); PG8_STAGE(PG8_SB(1, 0), b3, voffB); PG8_STAGE(PG8_SB(1, 1), b3 + hstep, voffB); PG8_STAGE(PG8_SA(1, 0), a3, voffA);
            PG8_WAIT_V(8); PG8_WAIT_L(0); PG8_BAR; PG8_MMA(1, 0, At, B0); PG8_MMA(1, 1, At, B1); PG8_BAR; PG8_SCHED;
            } else {
            PG8_LDB(B0, 0, 0); PG8_SCHED; PG8_LDA(At, 0, 0); PG8_STAGE(PG8_SA(1, 1), a1 + hstep, voffA);
            PG8_WAIT_L(8); PG8_BAR; PG8_WAIT_L(0); PG8_MMA(0, 0, At, B0); PG8_BAR; PG8_SCHED;
            PG8_LDB(B1, 0, 1); PG8_STAGE(PG8_SB(0, 0), b2, voffB);
            PG8_BAR; PG8_WAIT_L(0); PG8_MMA(0, 1, At, B1); PG8_BAR;
            PG8_LDA(At, 0, 1); PG8_STAGE(PG8_SA(0, 0), a2, voffA);
            PG8_BAR; PG8_WAIT_L(0); PG8_MMA(1, 0, At, B0); PG8_BAR; PG8_SCHED;
            PG8_STAGE(PG8_SB(0, 1), b2 + hstep, voffB);
            PG8_WAIT_V(6); PG8_BAR; PG8_MMA(1, 1, At, B1); PG8_BAR;
            PG8_LDB(B0, 1, 0); PG8_SCHED; PG8_LDA(At, 1, 0); PG8_STAGE(PG8_SA(0, 1), a2 + hstep, voffA);
            PG8_WAIT_L(8); PG8_BAR; PG8_WAIT_L(0); PG8_MMA(0, 0, At, B0); PG8_BAR; PG8_SCHED;
            PG8_LDB(B1, 1, 1); PG8_STAGE(PG8_SB(1, 0), b3, voffB);
            PG8_BAR; PG8_WAIT_L(0); PG8_MMA(0, 1, At, B1); PG8_BAR;
            PG8_LDA(At, 1, 1); PG8_STAGE(PG8_SA(1, 0), a3, voffA);
            PG8_BAR; PG8_WAIT_L(0); PG8_MMA(1, 0, At, B0); PG8_BAR; PG8_SCHED;
            PG8_STAGE(PG8_SB(1, 1), b3 + hstep, voffB);
            PG8_WAIT_V(6); PG8_BAR; PG8_MMA(1, 1, At, B1); PG8_BAR;
            }
        }
        if constexpr (ALIGN_EPI) { if (wr == 0) PG8_BAR; }
        if constexpr (!Epi::AFTER_DRAIN) { E(acc, cur, wr, wc, fr, fq); S.done(cur); }
        if (!has_next) break;
#pragma unroll
        for (int a = 0; a < 2; ++a)
#pragma unroll
            for (int b = 0; b < 2; ++b)
#pragma unroll
                for (int m = 0; m < 4; ++m)
#pragma unroll
                    for (int n = 0; n < 2; ++n) acc[a][b][m][n] = (f32x4){0.f, 0.f, 0.f, 0.f};
        cur = nxt; cA = nA; cB = nB; ++ui;
        if constexpr (ALIGN_EPI) { if (wr == 1) PG8_BAR; }
    }
    PG8_WAIT_V(0);
    if constexpr (!ALIGN_EPI) { if (wr == 0) PG8_BAR; }
    PG8_BAR;
    if constexpr (Epi::AFTER_DRAIN) { E.fused(acc, cur, wr, wc, fr, fq, lds, wid, lane); S.done(cur); }
#undef PG8_SA
#undef PG8_SB
#undef PG8_STAGE
#undef PG8_LDA
#undef PG8_LDB
#undef PG8_MMA
#undef PG8_WAIT_V
#undef PG8_WAIT_L
#undef PG8_BAR
#undef PG8_SCHED
}
}
namespace pg8 {
struct EpiF32 {
    static constexpr bool PERM = false, AFTER_DRAIN = false;
    float* C; int ldc;
    __device__ __forceinline__ void operator()(const f32x4 (&acc)[2][2][4][2], const Unit& u, int wr, int wc, int fr, int fq) const {
        const int row0 = u.pm * BM + wr * 64 + fr, col0 = u.pn * BM + wc * 32 + 4 * fq;
#pragma unroll
        for (int ai = 0; ai < 2; ++ai)
#pragma unroll
            for (int m = 0; m < 4; ++m) { float* rowp = C + (size_t)(row0 + ai * HALF + m * 16) * ldc + col0;
#pragma unroll
                for (int bj = 0; bj < 2; ++bj)
#pragma unroll
                    for (int n = 0; n < 2; ++n) *(f32x4*)(rowp + bj * HALF + n * 16) = acc[ai][bj][m][n]; }
    }
};
struct EpiBf16G {
    static constexpr bool PERM = true, AFTER_DRAIN = false;
    bf16_t* O; int ldc; int pnmask;
    __device__ __forceinline__ void operator()(const f32x4 (&acc)[2][2][4][2], const Unit& u, int wr, int wc, int fr, int fq) const {
        const int row0 = u.pm * BM + wr * 64 + fr, col0 = (u.pn & pnmask) * BM + wc * 32 + 8 * fq;
#pragma unroll
        for (int ai = 0; ai < 2; ++ai)
#pragma unroll
            for (int m = 0; m < 4; ++m) { bf16_t* rowp = O + (size_t)(row0 + ai * HALF + m * 16) * ldc + col0;
#pragma unroll
                for (int bj = 0; bj < 2; ++bj) { const f32x4 v0 = acc[ai][bj][m][0], v1 = acc[ai][bj][m][1];
                    u32x4 w; w.x = cvt_pk_bf16(v0[0], v0[1]); w.y = cvt_pk_bf16(v0[2], v0[3]); w.z = cvt_pk_bf16(v1[0], v1[1]); w.w = cvt_pk_bf16(v1[2], v1[3]);
                    *(u32x4*)(rowp + bj * HALF) = w; } }
    }
};
__device__ __forceinline__ float silu_fast(float x) { return x * __builtin_amdgcn_rcpf(1.f + __builtin_amdgcn_exp2f(-1.4426950408889634f * x)); }
struct EpiSwiGLU {
    static constexpr bool PERM = true, AFTER_DRAIN = false;
    bf16_t* O; int ldc;
    __device__ __forceinline__ void operator()(const f32x4 (&acc)[2][2][4][2], const Unit& u, int wr, int wc, int fr, int fq) const {
        const int row0 = u.pm * BM + wr * 64 + fr, col0 = (u.pn & 3) * HALF + wc * 32 + 8 * fq;
#pragma unroll
        for (int ai = 0; ai < 2; ++ai)
#pragma unroll
            for (int m = 0; m < 4; ++m) { bf16_t* rowp = O + (size_t)(row0 + ai * HALF + m * 16) * ldc + col0;
                const f32x4 a0 = acc[ai][0][m][0], a1 = acc[ai][0][m][1], g0 = acc[ai][1][m][0], g1 = acc[ai][1][m][1];
                u32x4 w; w.x = cvt_pk_bf16(silu_fast(a0[0]) * g0[0], silu_fast(a0[1]) * g0[1]); w.y = cvt_pk_bf16(silu_fast(a0[2]) * g0[2], silu_fast(a0[3]) * g0[3]);
                w.z = cvt_pk_bf16(silu_fast(a1[0]) * g1[0], silu_fast(a1[1]) * g1[1]); w.w = cvt_pk_bf16(silu_fast(a1[2]) * g1[2], silu_fast(a1[3]) * g1[3]);
                *(u32x4*)rowp = w; }
    }
};
struct MoeOrder {
    int nunits, G, v; const PG8_LAS int* tile_e;
    __device__ __forceinline__ bool next(int i, Unit& u) const { const int L = i * G + v; if (L >= nunits) return false; const int t = L >> 2; u.pm = t; u.pn = __builtin_amdgcn_readfirstlane(tile_e[t]) * 4 + (L & 3); return true; }
    __device__ __forceinline__ void a_ready(const Unit&) const {}
    __device__ __forceinline__ void done(const Unit&) const {}
};
}
#include <hip/hip_bf16.h>
#include <cmath>
namespace attn_body {
using bf16=__hip_bfloat16;
using bf16x8=__attribute__((ext_vector_type(8)))short;
using s16x4=__attribute__((ext_vector_type(4)))short;
using f32x16=__attribute__((ext_vector_type(16)))float;
using u32x4=__attribute__((ext_vector_type(4)))unsigned;
constexpr int BATCH=2,NHEAD=16,SEQ=8192,D=64,DM=NHEAD*D;
constexpr int NW=8,QBLK=32,QB=QBLK*NW,KVBLK=64,NQB=SEQ/QB;
constexpr int ATTN_PITCH=DM, ATTN_UNIT_ROWS=QB;
__device__ __forceinline__ int crow(int r,int hi){return (r&3)+8*(r>>2)+4*hi;}
#define SBAR() __builtin_amdgcn_sched_barrier(0)
__device__ __forceinline__ void cmask(f32x16&p0,f32x16&p1,int jb,int qrel,int hi){
  const float NEG=-INFINITY; int kb=64*jb+4*hi;
  #pragma unroll
  for(int r=0;r<16;++r){int kv=kb+(r&3)+8*(r>>2); if(kv>qrel)p0[r]=NEG; if(kv+32>qrel)p1[r]=NEG;}
}

constexpr int NSLOT=3, SLOTB=8192;
constexpr int LDS_K=0, LDS_V=NSLOT*SLOTB, LDS_WS=2*NSLOT*SLOTB, LDS_OST=LDS_WS+NW*64*4, LDS_BYTES=LDS_OST+NW*4096;
constexpr float C2=0.125f*1.4426950408889634f;
__device__ __forceinline__ void glds16(const void*gsrc,unsigned lds_dst){unsigned keep;
  asm volatile("s_mov_b32 %0, m0\n\ts_mov_b32 m0, %2\n\ts_nop 0\n\tglobal_load_lds_dwordx4 %1, off\n\ts_mov_b32 m0, %0":"=&s"(keep):"v"(gsrc),"s"(lds_dst):"memory");}
__device__ __forceinline__ float max3f(float a,float b,float c){float r;asm("v_max3_f32 %0, %1, %2, %3":"=v"(r):"v"(a),"v"(b),"v"(c));return r;}
__device__ __forceinline__ float max2f(float a,float b){float r;asm("v_max_f32_e32 %0, %1, %2":"=v"(r):"v"(a),"v"(b));return r;}
__device__ __forceinline__ float fadd_s(float a,float b){float r;asm("v_add_f32_e32 %0, %1, %2":"=v"(r):"v"(a),"v"(b));return r;}
__device__ __forceinline__ float fsub_s(float a,float b){float r;asm("v_sub_f32_e32 %0, %1, %2":"=v"(r):"v"(a),"v"(b));return r;}
typedef float f32x2_t __attribute__((ext_vector_type(2))); typedef __bf16 bf16x2_t __attribute__((ext_vector_type(2)));
__device__ __forceinline__ unsigned cvtpk_s(float lo,float hi){f32x2_t v={lo,hi};bf16x2_t b=__builtin_convertvector(v,bf16x2_t);return __builtin_bit_cast(unsigned,b);}
#define WAIT_BAR(N) asm volatile("s_waitcnt vmcnt(" #N ") lgkmcnt(0)\n\ts_barrier":::"memory")

__device__ __forceinline__ void qkt(f32x16&p0,f32x16&p1,const char*Kslot,const bf16x8*qr,const f32x16&negm,int r32,int hi){
  const char*kb=Kslot+hi*1024+r32*16;
  #pragma unroll
  for(int d0=0;d0<4;++d0){
    const bf16x8 b0=*reinterpret_cast<const bf16x8*>(kb+d0*2048);
    const bf16x8 b1=*reinterpret_cast<const bf16x8*>(kb+d0*2048+512);
    if(d0==0){p0=__builtin_amdgcn_mfma_f32_32x32x16_bf16(b0,qr[0],negm,0,0,0);p1=__builtin_amdgcn_mfma_f32_32x32x16_bf16(b1,qr[0],negm,0,0,0);}
    else{p0=__builtin_amdgcn_mfma_f32_32x32x16_bf16(b0,qr[d0],p0,0,0,0);p1=__builtin_amdgcn_mfma_f32_32x32x16_bf16(b1,qr[d0],p1,0,0,0);}}
}
typedef __attribute__((address_space(3))) const char* lds_cptr;
typedef short v4i16_t __attribute__((ext_vector_type(4)));
__device__ __forceinline__ void kload8(bf16x8*kf,lds_cptr kp){
  kf[0]=*(const __attribute__((address_space(3))) bf16x8*)(kp);      kf[1]=*(const __attribute__((address_space(3))) bf16x8*)(kp+512);
  kf[2]=*(const __attribute__((address_space(3))) bf16x8*)(kp+2048); kf[3]=*(const __attribute__((address_space(3))) bf16x8*)(kp+2560);
  kf[4]=*(const __attribute__((address_space(3))) bf16x8*)(kp+4096); kf[5]=*(const __attribute__((address_space(3))) bf16x8*)(kp+4608);
  kf[6]=*(const __attribute__((address_space(3))) bf16x8*)(kp+6144); kf[7]=*(const __attribute__((address_space(3))) bf16x8*)(kp+6656);
}
__device__ __forceinline__ void kload2(bf16x8*kf,lds_cptr kp,int j){ kf[2*j]=*(const __attribute__((address_space(3))) bf16x8*)(kp+j*2048); kf[2*j+1]=*(const __attribute__((address_space(3))) bf16x8*)(kp+j*2048+512); }
__device__ __forceinline__ s16x4 vtr(lds_cptr p){ return __builtin_bit_cast(s16x4,__builtin_amdgcn_ds_read_tr16_b64_v4i16((__attribute__((address_space(3))) v4i16_t*)p)); }
__device__ __forceinline__ float rowmax(const f32x16&p0,const f32x16&p1){
  float a=max3f(p0[0],p0[1],p1[0]),b=max3f(p0[2],p0[3],p1[1]);a=max3f(a,p1[2],p1[3]);
  #pragma unroll
  for(int r=4;r<16;r+=4){a=max3f(a,p0[r],p0[r+1]);b=max3f(b,p0[r+2],p0[r+3]);a=max3f(a,p1[r],p1[r+1]);b=max3f(b,p1[r+2],p1[r+3]);}
  const float m=max2f(a,b);
  auto rr=__builtin_amdgcn_permlane32_swap(__float_as_uint(m),__float_as_uint(m),false,false);
  return max2f(__uint_as_float(rr[0]),__uint_as_float(rr[1]));
}
__device__ __forceinline__ void pv(f32x16*o,int vb,bf16x8 pa0,bf16x8 pa1,bf16x8 pa2,bf16x8 pa3){
  #pragma unroll
  for(int d0=0;d0<2;++d0){s16x4 lo[4],hi[4];
    #pragma unroll
    for(int ks=0;ks<4;++ks){
      asm volatile("ds_read_b64_tr_b16 %0,%1 offset:%c2":"=&v"(lo[ks]):"v"(vb),"i"(d0*4096+ks*1024):"memory");
      asm volatile("ds_read_b64_tr_b16 %0,%1 offset:%c2":"=&v"(hi[ks]):"v"(vb),"i"(d0*4096+ks*1024+512):"memory");}
    asm volatile("s_waitcnt lgkmcnt(0)":::"memory");SBAR();
    #define PK(k) (bf16x8){lo[k][0],lo[k][1],lo[k][2],lo[k][3],hi[k][0],hi[k][1],hi[k][2],hi[k][3]}
    o[d0]=__builtin_amdgcn_mfma_f32_32x32x16_bf16(pa0,PK(0),o[d0],0,0,0);
    o[d0]=__builtin_amdgcn_mfma_f32_32x32x16_bf16(pa1,PK(1),o[d0],0,0,0);
    o[d0]=__builtin_amdgcn_mfma_f32_32x32x16_bf16(pa2,PK(2),o[d0],0,0,0);
    o[d0]=__builtin_amdgcn_mfma_f32_32x32x16_bf16(pa3,PK(3),o[d0],0,0,0);
    #undef PK
  }
}

#ifndef ATTN_STORE16
#define ATTN_STORE16(p,v) (*(u32x4*)(p)=(v))
#endif
template<int THRL> __device__ __forceinline__ void attn_unit(int b,int h,int hv,int qb,const bf16*Q,const bf16*__restrict__ K,const bf16*__restrict__ V,bf16*O,char*shm,const int wave_id){
  int tid_=wave_id*64+(int)__builtin_amdgcn_mbcnt_hi(~0u,__builtin_amdgcn_mbcnt_lo(~0u,0u)); asm volatile("":"+v"(tid_)); const int tid=tid_,lane=tid&63,r32=lane&31,hi=lane>>5; const int wid=__builtin_amdgcn_readfirstlane(tid>>6);
  const long rowbase=(long)b*SEQ; const int q0=qb*QB;
  const bf16*Qw=Q+(rowbase+q0+wid*QBLK)*DM+h*D;
  const bf16*Kh=K+rowbase*DM+h*D,*Vh=V+rowbase*DM+hv*D;
  const unsigned lds0=(unsigned)(uintptr_t)shm;
  float*wsf=(float*)(shm+LDS_WS)+wid*64;
  const bf16*ksrc=Kh+(long)lane*DM+wid*8;
  const bf16*vsrc=Vh+(long)(16*(wid&3)+(lane>>2))*DM+(wid>>2)*32+(lane&3)*8;
  const unsigned kdst=lds0+LDS_K+wid*1024, vdst=lds0+LDS_V+wid*1024;
  #define DMA_K(t,slot) glds16(ksrc+(long)(t)*KVBLK*DM,(unsigned)__builtin_amdgcn_readfirstlane(kdst+(slot)))
  #define DMA_V(t,slot) glds16(vsrc+(long)(t)*KVBLK*DM,(unsigned)__builtin_amdgcn_readfirstlane(vdst+(slot)))
  const int vb0=(int)(lds0+LDS_V)+((lane>>4)&1)*32+(lane&3)*8+(4*hi+((lane&15)>>2))*64;
  const char*Kbase=shm+LDS_K; bf16x8 kf[8];
  const lds_cptr shm3=(lds_cptr)shm; const lds_cptr kp0=shm3+LDS_K+hi*1024+r32*16; const lds_cptr vp0=shm3+LDS_V+((lane>>4)&1)*32+(lane&3)*8+(4*hi+((lane&15)>>2))*64;
  const int NT=(q0+QB)/KVBLK;
  DMA_K(0,0);DMA_V(0,0);DMA_K(1,SLOTB);
  bf16x8 qr[4];
  #pragma unroll
  for(int d0=0;d0<4;++d0)qr[d0]=*reinterpret_cast<const bf16x8*>(&Qw[(long)r32*DM+d0*16+hi*8]);
  float mhat=0.f,l_reg=0.f;f32x16 o[2];o[0]=f32x16{};o[1]=f32x16{};f32x16 negm=f32x16{};asm volatile("":"+v"(negm));
  const int qrel=wid*QBLK+r32;
  #define CMASK(P0,P1,t) do{int jb_=(t)-(NT-4); if(jb_>=0)cmask(P0,P1,jb_,qrel,hi);}while(0)
  bool resc=false;
  #define START(P0,P1) do{ const float rm=rowmax(P0,P1); resc=false; \
    { const float dl=rm; mhat=fadd_s(mhat,dl); \
      _Pragma("unroll") for(int r=0;r<16;++r){P0[r]=fsub_s(P0[r],dl);P1[r]=fsub_s(P1[r],dl);} \
      _Pragma("unroll") for(int r=0;r<16;++r)negm[r]=-mhat; asm volatile("":"+v"(negm)); } \
    _Pragma("unroll") for(int r=0;r<16;++r)P0[r]=__builtin_amdgcn_exp2f(P0[r]); }while(0)
  #define RESC() do{ if(resc){ asm volatile("s_waitcnt lgkmcnt(0)":::"memory"); \
      _Pragma("unroll") for(int d_=0;d_<2;++d_) _Pragma("unroll") for(int r=0;r<16;++r)o[d_][r]*=wsf[crow(r,hi)]; } }while(0)
  f32x16 pA0,pA1,pB0,pB1;
  int sl_prev=0,sl_cur=0,sl_next=SLOTB;
  #define ROT() do{sl_prev=sl_cur;sl_cur=sl_next;sl_next=(sl_next==(NSLOT-1)*SLOTB)?0:sl_next+SLOTB;}while(0)
  DMA_K(2,2*SLOTB);
  WAIT_BAR(3);
  qkt(pA0,pA1,Kbase,qr,negm,r32,hi);asm volatile("s_nop 15\n\ts_nop 7":"+v"(pA0),"+v"(pA1));CMASK(pA0,pA1,0);
  START(pA0,pA1);
  _Pragma("unroll") for(int r=0;r<16;++r)pA1[r]=__builtin_amdgcn_exp2f(pA1[r]);
  WAIT_BAR(0);
  DMA_K(3,0);DMA_V(1,SLOTB);
  ROT();
  kload8(kf,kp0+sl_cur);
  WAIT_BAR(2);
  s16x4 vlo[8],vhi[8]; u32x4 pw0,pw1,pw2,pw3;
  #define PKW(P,B) cvtpk_s(P[B],P[B+1])
  #define PAF(k) __builtin_bit_cast(bf16x8,pw##k)
  #define VFR(i) (bf16x8){vlo[i][0],vlo[i][1],vlo[i][2],vlo[i][3],vhi[i][0],vhi[i][1],vhi[i][2],vhi[i][3]}
  #define PIN(x) asm volatile("":"+v"(x))
  #define MX3(a,b,c) __builtin_fmaxf(__builtin_fmaxf((a),(b)),(c))
  #define GAPA(MF,A0,A1,A2,A3,W0,W1,PW) do{ MF; sacc+=A0; sacc+=A1; sacc+=A2; sacc+=A3; PIN(sacc); W0; W1; PIN(PW); SBAR(); }while(0)
  #define EX(v) __builtin_amdgcn_exp2f(v)
  #define GAPB(MF,X,B) do{ MF; X[B]=EX(X[B]); X[B+1]=EX(X[B+1]); X[B+2]=EX(X[B+2]); X[B+3]=EX(X[B+3]); PIN(X); SBAR(); }while(0)
  #define VRD(i) do{ vlo[i]=vtr(vp_+(((i)>>2)*4096+((i)&3)*1024)); vhi[i]=vtr(vp_+(((i)>>2)*4096+((i)&3)*1024+512)); }while(0)
  #define KRD(G,j) do{ if(G){ kload2(kf,kp0+sl_next,j); SBAR(); } }while(0)
  #define STEP(C0,C1,P0,P1,t,GK,GV,GL) do{ SBAR(); \
    const lds_cptr vp_=vp0+sl_prev; \
    VRD(0); SBAR(); float sacc=(P0[0]+P0[1]); \
    GAPA(C0=__builtin_amdgcn_mfma_f32_32x32x16_bf16(kf[0],qr[0],negm,0,0,0), P0[2],P0[3],P0[4],P0[5],     pw0[0]=PKW(P0,0), pw0[1]=PKW(P0,2), pw0); \
    VRD(4); SBAR(); GAPA(C1=__builtin_amdgcn_mfma_f32_32x32x16_bf16(kf[1],qr[0],negm,0,0,0), P0[6],P0[7],P0[8],P0[9],     pw0[2]=PKW(P0,4), pw0[3]=PKW(P0,6), pw0); \
    VRD(1); SBAR(); GAPA(C0=__builtin_amdgcn_mfma_f32_32x32x16_bf16(kf[2],qr[1],C0,0,0,0),   P0[10],P0[11],P0[12],P0[13], pw1[0]=PKW(P0,8), pw1[1]=PKW(P0,10), pw1); \
    VRD(5); SBAR(); GAPA(C1=__builtin_amdgcn_mfma_f32_32x32x16_bf16(kf[3],qr[1],C1,0,0,0),   P0[14],P0[15],P1[0],P1[1],   pw1[2]=PKW(P0,12),pw1[3]=PKW(P0,14), pw1); \
    VRD(2); SBAR(); GAPA(C0=__builtin_amdgcn_mfma_f32_32x32x16_bf16(kf[4],qr[2],C0,0,0,0),   P1[2],P1[3],P1[4],P1[5],     pw2[0]=PKW(P1,0), pw2[1]=PKW(P1,2), pw2); \
    VRD(6); SBAR(); GAPA(C1=__builtin_amdgcn_mfma_f32_32x32x16_bf16(kf[5],qr[2],C1,0,0,0),   P1[6],P1[7],P1[8],P1[9],     pw2[2]=PKW(P1,4), pw2[3]=PKW(P1,6), pw2); \
    VRD(3); SBAR(); GAPA(C0=__builtin_amdgcn_mfma_f32_32x32x16_bf16(kf[6],qr[3],C0,0,0,0),   P1[10],P1[11],P1[12],P1[13], pw3[0]=PKW(P1,8), pw3[1]=PKW(P1,10), pw3); \
    VRD(7); SBAR(); GAPA(C1=__builtin_amdgcn_mfma_f32_32x32x16_bf16(kf[7],qr[3],C1,0,0,0),   P1[14],P1[15],0.f,0.f,       pw3[2]=PKW(P1,12),pw3[3]=PKW(P1,14), pw3); \
    l_reg+=sacc; \
    if(GK){DMA_K((t)+3,sl_cur);} if(GV){DMA_V((t)+1,sl_next);} \
    CMASK(C0,C1,t); \
    { float a=MX3(C0[0],C0[1],C1[0]),b=MX3(C0[2],C0[3],C1[1]); a=MX3(a,C1[2],C1[3]); \
      _Pragma("unroll") for(int r=4;r<16;r+=4){a=MX3(a,C0[r],C0[r+1]);b=MX3(b,C0[r+2],C0[r+3]);a=MX3(a,C1[r],C1[r+1]);b=MX3(b,C1[r+2],C1[r+3]);} \
      float rm=__builtin_fmaxf(a,b); { auto rr=__builtin_amdgcn_permlane32_swap(__float_as_uint(rm),__float_as_uint(rm),false,false); rm=__builtin_fmaxf(__uint_as_float(rr[0]),__uint_as_float(rr[1])); } \
      resc=false; \
      if(__builtin_expect(__any(rm>(float)THRL),0)){ const float dl=__builtin_fmaxf(rm,0.f); mhat+=dl; \
        _Pragma("unroll") for(int r=0;r<16;++r){C0[r]-=dl;C1[r]-=dl;} \
        _Pragma("unroll") for(int r=0;r<16;++r)negm[r]=-mhat; asm volatile("":"+v"(negm)); \
        const float f=__builtin_amdgcn_exp2f(-dl); l_reg*=f; if(hi==0)wsf[r32]=f; resc=true; } } \
    SBAR(); \
    GAPB(o[0]=__builtin_amdgcn_mfma_f32_32x32x16_bf16(PAF(0),VFR(0),o[0],0,0,0), C0,0); \
    GAPB(o[1]=__builtin_amdgcn_mfma_f32_32x32x16_bf16(PAF(0),VFR(4),o[1],0,0,0), C0,4); \
    KRD(GL,0); GAPB(o[0]=__builtin_amdgcn_mfma_f32_32x32x16_bf16(PAF(1),VFR(1),o[0],0,0,0), C0,8); \
    KRD(GL,1); GAPB(o[1]=__builtin_amdgcn_mfma_f32_32x32x16_bf16(PAF(1),VFR(5),o[1],0,0,0), C0,12); \
    KRD(GL,2); GAPB(o[0]=__builtin_amdgcn_mfma_f32_32x32x16_bf16(PAF(2),VFR(2),o[0],0,0,0), C1,0); \
    KRD(GL,3); GAPB(o[1]=__builtin_amdgcn_mfma_f32_32x32x16_bf16(PAF(2),VFR(6),o[1],0,0,0), C1,4); \
    GAPB(o[0]=__builtin_amdgcn_mfma_f32_32x32x16_bf16(PAF(3),VFR(3),o[0],0,0,0), C1,8); \
    GAPB(o[1]=__builtin_amdgcn_mfma_f32_32x32x16_bf16(PAF(3),VFR(7),o[1],0,0,0), C1,12); \
    }while(0)
  int t=1;
  #undef CMASK
  #define CMASK(P0,P1,t) do{}while(0)
  for(;t+5<NT;t+=2){
    STEP(pB0,pB1,pA0,pA1,t,true,true,true);     WAIT_BAR(2); RESC(); ROT();
    STEP(pA0,pA1,pB0,pB1,t+1,true,true,true);   WAIT_BAR(2); RESC(); ROT();
  }
  #undef CMASK
  #define CMASK(P0,P1,t) do{int jb_=(t)-(NT-4); if(jb_>=0)cmask(P0,P1,jb_,qrel,hi);}while(0)
  #define ENDW(tt) do{ if((tt)+3<NT){WAIT_BAR(2);} else if((tt)+2<NT){WAIT_BAR(1);} else {WAIT_BAR(0);} }while(0)
  for(;t+1<NT;t+=2){
    STEP(pB0,pB1,pA0,pA1,t,(t+3<NT),(t+1<NT),(t+1<NT));       ENDW(t);   RESC(); ROT();
    STEP(pA0,pA1,pB0,pB1,t+1,(t+4<NT),(t+2<NT),(t+2<NT));     ENDW(t+1); RESC(); ROT();
  }
  STEP(pB0,pB1,pA0,pA1,NT-1,false,false,false); RESC();
  { float sacc=pB0[0]+pB0[1]; _Pragma("unroll") for(int r=2;r<16;++r)sacc+=pB0[r]; _Pragma("unroll") for(int r=0;r<16;++r)sacc+=pB1[r]; l_reg+=sacc;
    pw0=(u32x4){PKW(pB0,0),PKW(pB0,2),PKW(pB0,4),PKW(pB0,6)};pw1=(u32x4){PKW(pB0,8),PKW(pB0,10),PKW(pB0,12),PKW(pB0,14)};pw2=(u32x4){PKW(pB1,0),PKW(pB1,2),PKW(pB1,4),PKW(pB1,6)};pw3=(u32x4){PKW(pB1,8),PKW(pB1,10),PKW(pB1,12),PKW(pB1,14)};
    SBAR(); pv(o,vb0+sl_cur,PAF(0),PAF(1),PAF(2),PAF(3)); }
  #undef PKW
  #undef PAF
  #undef VFR
  #undef PIN
  #undef MX3
  #undef GAPA
  #undef GAPB
  #undef EX
  #undef VRD
  #undef KRD
  #undef STEP
  #undef ENDW
  {auto rr=__builtin_amdgcn_permlane32_swap(__float_as_uint(l_reg),__float_as_uint(l_reg),false,false);l_reg=__uint_as_float(rr[0])+__uint_as_float(rr[1]);}
  if(hi==0)wsf[32+r32]=l_reg;asm volatile("s_waitcnt lgkmcnt(0)":::"memory");
  float rli[16];
  #pragma unroll
  for(int r=0;r<16;++r)rli[r]=__builtin_amdgcn_rcpf(wsf[32+crow(r,hi)]);
  bf16*Ow=O+(rowbase+q0+wid*QBLK)*DM+hv*D;
  { bf16*stg=(bf16*)(shm+LDS_OST)+wid*2048;
    #pragma unroll
    for(int r=0;r<16;++r){const int orow=crow(r,hi);
      #pragma unroll
      for(int d0=0;d0<2;++d0)stg[orow*64+d0*32+r32]=__float2bfloat16(o[d0][r]*rli[r]);}
    asm volatile("s_waitcnt lgkmcnt(0)":::"memory");
    #pragma unroll
    for(int i=0;i<4;++i){const int row=i*8+(lane>>3),ch=lane&7; const u32x4 v=*(const u32x4*)(stg+row*64+ch*8); ATTN_STORE16(Ow+(long)row*DM+ch*8,v);} }
  asm volatile("s_waitcnt lgkmcnt(0)\n\ts_barrier":::"memory");
  #undef DMA_K
  #undef DMA_V
  #undef CMASK
  #undef START
  #undef RESC
  #undef ROT
}
constexpr int ATTN_LDS_BYTES=LDS_BYTES;
struct AttnTensors { const bf16* Q; const bf16* K; const bf16* V; bf16* O1; bf16* O2; };
struct AttnUnit { int vb; int qb; };
struct StaticOrder {
  int vcu;
  __device__ __forceinline__ explicit StaticOrder(int grid,int block):vcu((block%8)*(grid/8)+block/8){}
  __device__ __forceinline__ bool next(int i,AttnUnit&u)const{ if(i>=8)return false; const int s=vcu&7,j=i&3; u.vb=2*(vcu>>3)+(i>>2); u.qb=(j==0)?s:(j==1)?15-s:(j==2)?16+s:31-s; return true; }
  __device__ __forceinline__ void a_ready(const AttnUnit&)const{}
  __device__ __forceinline__ void done(const AttnUnit&)const{}
};
template<class Sched,int THRL=8> __device__ __forceinline__ void attn_phase(char*lds,const AttnTensors&T,const Sched&S,const int wave_id){
  AttnUnit u;
  for(int i=0;S.next(i,u);++i){ S.a_ready(u); const int c=u.vb&1,bhq=u.vb>>1,b=bhq>>4,hq=bhq&15; attn_unit<THRL>(b,hq,(hq>>1)*2+c,u.qb,T.Q,T.K,T.V,(hq&1)?T.O2:T.O1,lds,wave_id); S.done(u); }
}
#undef SBAR
#undef WAIT_BAR
}
#define GAS __attribute__((address_space(1)))
#define LAS __attribute__((address_space(3)))
typedef unsigned short bf16;
typedef unsigned v4u __attribute__((ext_vector_type(4)));
typedef float f32x4 __attribute__((ext_vector_type(4)));
typedef short bf16x8 __attribute__((ext_vector_type(8)));
typedef GAS unsigned gu32;
typedef GAS unsigned long long gu64;
#define RLX_AGENT __ATOMIC_RELAXED, __HIP_MEMORY_SCOPE_AGENT
#define LDS_WAIT() asm volatile("s_waitcnt lgkmcnt(0)" ::: "memory")
#define VM_WAIT() asm volatile("s_waitcnt vmcnt(0)" ::: "memory")
__device__ __forceinline__ unsigned long long rt() { return __builtin_amdgcn_s_memrealtime(); }
__device__ __forceinline__ unsigned f2bf(float f) { unsigned u = __builtin_bit_cast(unsigned, f); return (u + 0x7fffu + ((u >> 16) & 1u)) >> 16; }
__device__ __forceinline__ unsigned pk2(float lo, float hi) { return f2bf(lo) | (f2bf(hi) << 16); }

#define XB_TMO      128
#define XB_XCNT(j)  (256  + 64 * (j))
#define XB_XSUB(j)  (1280 + 64 * (j))
#define XB_XGEN(j)  (2304 + 64 * (j))
#define XB_TOP      3328
#define XB_TOPGEN   3392
#define XCD_BAR_WORDS 3456
#define XB_SPIN_CAP (1u << 18)

__device__ __forceinline__ unsigned xb_ld(unsigned* p)              { return __hip_atomic_load(p, __ATOMIC_RELAXED, __HIP_MEMORY_SCOPE_AGENT); }
__device__ __forceinline__ unsigned xb_add(unsigned* p, unsigned v) { return __hip_atomic_fetch_add(p, v, __ATOMIC_RELAXED, __HIP_MEMORY_SCOPE_AGENT); }
__device__ __forceinline__ unsigned xb_xcc_id() { return (unsigned)__builtin_amdgcn_s_getreg((3 << 11) | 20) & 0xFu; }
#define XB_SPIN(cond, bar) do { unsigned _sp = 0; while (cond) { __builtin_amdgcn_s_sleep(1); \
    if ((++_sp & 255u) == 0u) { if (xb_ld(&(bar)[XB_TMO])) break; if (_sp > XB_SPIN_CAP) { atomicAdd(&(bar)[XB_TMO], 1u); break; } } } } while (0)

struct XcdBarrier {
    unsigned* bar; unsigned x;
    volatile LAS unsigned* st;
};

__device__ __forceinline__ XcdBarrier xcd_barrier_post(unsigned* bar, volatile LAS unsigned* st, const int wave_id) {
    XcdBarrier b; b.bar = bar; b.x = xb_xcc_id(); b.st = st;
    if (wave_id == 0 && __builtin_amdgcn_mbcnt_hi(~0u, __builtin_amdgcn_mbcnt_lo(~0u, 0u)) == 0u) (void)xb_add(&bar[XB_XCNT(b.x)], 1u);
    return b;
}
__device__ __forceinline__ void xcd_barrier_complete(unsigned* bar, unsigned x, unsigned& nloc, unsigned& nx) {
    const unsigned G = gridDim.x * gridDim.y * gridDim.z;
    unsigned sum, cnt, mine, sp = 0u;
    for (;;) {
        sum = 0u; cnt = 0u; mine = 0u;
#pragma unroll
        for (unsigned j = 0; j < 16; ++j) { const unsigned c = xb_ld(&bar[XB_XCNT(j)]); sum += c; cnt += (c > 0u) ? 1u : 0u; mine = (j == x) ? c : mine; }
        if (sum == G) break;
        __builtin_amdgcn_s_sleep(1);
        if ((++sp & 255u) == 0u) { if (xb_ld(&bar[XB_TMO])) break; if (sp > XB_SPIN_CAP) { atomicAdd(&bar[XB_TMO], 1u); break; } }
    }
    nloc = mine > 0u ? mine : 1u; nx = cnt > 0u ? cnt : 1u;
}

__device__ __forceinline__ void xcd_barrier(const XcdBarrier& b, const int wave_id) {
    asm volatile("s_waitcnt vmcnt(0)" ::: "memory");
    __syncthreads();
    if (wave_id == 0 && __builtin_amdgcn_mbcnt_hi(~0u, __builtin_amdgcn_mbcnt_lo(~0u, 0u)) == 0u) {
        unsigned* bar = b.bar;
        __builtin_amdgcn_s_waitcnt(0);
        unsigned nloc = b.st[0], nx = b.st[1];
        if (nloc == 0u) { xcd_barrier_complete(bar, b.x, nloc, nx); b.st[0] = nloc; b.st[1] = nx; }
        const unsigned old = xb_add(&bar[XB_XSUB(b.x)], 1u);
        const unsigned gen = old / nloc;
        if (old + 1u == (gen + 1u) * nloc) {
            __builtin_amdgcn_fence(__ATOMIC_RELEASE, "agent");
            asm volatile("s_waitcnt vmcnt(0)" ::: "memory");
            const unsigned og = xb_add(&bar[XB_TOP], 1u);
            const unsigned tg = og / nx;
            if (og + 1u == (tg + 1u) * nx) xb_add(&bar[XB_TOPGEN], 1u);
            else XB_SPIN(xb_ld(&bar[XB_TOPGEN]) == tg, bar);
            __builtin_amdgcn_fence(__ATOMIC_ACQUIRE, "agent");
            xb_add(&bar[XB_XGEN(b.x)], 1u);
            asm volatile("s_waitcnt vmcnt(0)" ::: "memory");
        } else {
            XB_SPIN(xb_ld(&bar[XB_XGEN(b.x)]) == gen, bar);
            __builtin_amdgcn_fence(__ATOMIC_ACQUIRE, "agent");
            asm volatile("s_waitcnt vmcnt(0)" ::: "memory");
        }
    }
    __syncthreads();
}
constexpr int NWAVES = 8;
constexpr int T = 8192, D = 1024, M = 16384;
constexpr int NINP = 4352;
constexpr int NEXP = 32, NROWS2 = 40960, NTILE2 = NROWS2 / 256;
constexpr float LN_EPS = 1e-5f, RMS_EPS = 1e-6f, ALPHA = 1.6817928305074292f;
constexpr float QSCALE = 0.125f * 1.4426950408889634f;

constexpr size_t al256(size_t x) { return (x + 255) & ~(size_t)255; }
constexpr size_t WS_CTL = 0, CTL_ZERO_BYTES = 1u << 20;
constexpr size_t WS_WIN = WS_CTL + CTL_ZERO_BYTES;
constexpr size_t WS_WAOUT = WS_WIN + (size_t)2 * NINP * D * 2;
constexpr size_t WS_WQKV = WS_WAOUT + (size_t)2 * D * D * 2;
constexpr size_t WS_WQ3 = WS_WQKV + (size_t)3 * D * D * 2;
constexpr size_t WS_WBOUT = WS_WQ3 + (size_t)D * D * 2;
constexpr size_t WS_WR = WS_WBOUT + (size_t)2 * D * D * 2;
constexpr size_t WS_W13 = WS_WR + (size_t)4 * 48 * D * 2;
constexpr size_t WS_W2 = WS_W13 + (size_t)4 * 32 * 1024 * 1024 * 2;
constexpr size_t WS_H = WS_W2 + (size_t)4 * 32 * 1024 * 512 * 2;
constexpr size_t WS_HB = WS_H + (size_t)M * D * 4;
constexpr size_t WS_H1 = WS_HB + (size_t)M * D * 2;
constexpr size_t WS_H1B = WS_H1 + (size_t)M * D * 4;
constexpr size_t WS_PROJ = WS_H1B + (size_t)M * D * 2;
constexpr size_t WS_KB = WS_PROJ + (size_t)M * NINP * 2;
constexpr size_t WS_VB = WS_KB + (size_t)M * D * 2;
constexpr size_t WS_ON = WS_VB + (size_t)M * D * 2;
constexpr size_t WS_MIX = WS_ON + (size_t)M * D * 2;
constexpr size_t WS_EID = WS_MIX + (size_t)M * D * 4;
constexpr size_t WS_GATE = WS_EID + (size_t)2 * M * 4;
constexpr size_t WS_APOS = WS_GATE + (size_t)2 * M * 4;
constexpr size_t WS_XROWS = WS_APOS + (size_t)2 * M * 4;
constexpr size_t WS_HID = WS_XROWS + (size_t)NROWS2 * 1024 * 2;
constexpr size_t WS_YROWS = WS_HID + (size_t)NROWS2 * 512 * 2;
constexpr size_t WS_FAST_END = WS_YROWS + (size_t)NROWS2 * 1024 * 2;
constexpr int CW_BAR = 4096;
constexpr int CW_CNT = 64;
constexpr int LDS_BYTES = 147456, RING_BYTES = 131072, LDSCTL_OFF = RING_BYTES, MISC_OFF = LDSCTL_OFF + 320, TILEE_OFF = MISC_OFF + 128;
constexpr int PREP_SC_OFF = TILEE_OFF + 4 * NTILE2 + 64;
static_assert(PREP_SC_OFF + 8 * 768 <= LDS_BYTES, "LDS map");

#define PHASE_IDS int tid_o_ = F.wave * 64 + (int)__builtin_amdgcn_mbcnt_hi(~0u, __builtin_amdgcn_mbcnt_lo(~0u, 0u)); asm volatile("" : "+v"(tid_o_)); const int tid = tid_o_, lane = tid & 63; (void)tid; (void)lane;
struct Frame {
    LAS unsigned char* lds; volatile LAS unsigned* MISC; gu32* ctl;
    int wave, vcu, G;
    unsigned char* ws;
};
struct Args { const float* in[20]; float* out; unsigned char* ws; int ph_lo, ph_hi, bar_region, pad; float lam_init[2]; };

__device__ __forceinline__ float wave_sum(float v) {
#pragma unroll
    for (int o = 1; o < 64; o <<= 1) v += __shfl_xor(v, o);
    return v;
}
__device__ __forceinline__ void p0_transpose_item(const float* W, int ldw, int nvalid, bf16* WT, int ldt, int drow0, int k0, int n0, LAS float* scr, int lane) {
    const int nn = n0 + (lane & 31); const bool ok = nn < nvalid;
#pragma unroll 8
    for (int i = 0; i < 32; ++i) { const int kk = 2 * i + (lane >> 5); scr[kk * 33 + (lane & 31)] = ok ? W[(size_t)(k0 + kk) * ldw + nn] : 0.f; }
    LDS_WAIT(); asm volatile("" ::: "memory");
    const int c = lane & 7;
#pragma unroll
    for (int j = 0; j < 4; ++j) { const int n = (lane >> 3) + 8 * j; const LAS float* s = scr + (8 * c) * 33 + n;
        v4u o; o.x = pk2(s[0 * 33], s[1 * 33]); o.y = pk2(s[2 * 33], s[3 * 33]); o.z = pk2(s[4 * 33], s[5 * 33]); o.w = pk2(s[6 * 33], s[7 * 33]);
        *(GAS v4u*)(WT + (size_t)(drow0 + n) * ldt + k0 + 8 * c) = o; }
    LDS_WAIT(); asm volatile("" ::: "memory");
}
__device__ __forceinline__ bool p0_job(int& r, const float* W, int K, int N, int nblk, bf16* WT, int drow_base, bool w13perm, LAS float* scr, int lane) {
    const int items = (K / 64) * nblk;
    if (r >= items) { r -= items; return false; }
    const int kb = r / nblk, nb = r % nblk, n0 = nb * 32;
    int drow0 = drow_base + n0;
    if (w13perm) drow0 = drow_base + ((n0 & 511) >> 7) * 256 + (n0 >> 9) * 128 + (n0 & 127);
    p0_transpose_item(W, N, N, WT, K, drow0, kb * 64, n0, scr, lane);
    return true;
}
__device__ __forceinline__ void p0_prologue(Frame& F, const Args& a) {
    PHASE_IDS
    LAS float* scr = (LAS float*)(F.lds + F.wave * 16384);
    const int gw = F.vcu * NWAVES + F.wave, NGW = F.G * NWAVES;
    bf16* win = (bf16*)(F.ws + WS_WIN); bf16* waout = (bf16*)(F.ws + WS_WAOUT); bf16* wqkv = (bf16*)(F.ws + WS_WQKV); bf16* wq3 = (bf16*)(F.ws + WS_WQ3);
    bf16* wbout = (bf16*)(F.ws + WS_WBOUT); bf16* wr = (bf16*)(F.ws + WS_WR); bf16* w13 = (bf16*)(F.ws + WS_W13); bf16* w2 = (bf16*)(F.ws + WS_W2);
    constexpr int I_IN = 16 * 129, I_SQ = 16 * 32, I_KV = 16 * 64, I_W13 = 16 * 32, I_W2 = 8 * 32;
    constexpr int NSMALL = 2 * I_IN + 2 * I_SQ + I_KV + 2 * I_SQ + 2 * I_SQ;
    constexpr int NITEMS = NSMALL + 128 * I_W13 + 128 * I_W2;
    for (int it = gw; it < NITEMS; it += NGW) {
        int r = it;
        if (r < NSMALL) {
            bool done = false;
            for (int l = 0; l < 2 && !done; ++l) done = p0_job(r, a.in[1] + (size_t)l * D * 4112, D, 4112, 129, win + (size_t)l * NINP * D, 0, false, scr, lane);
            for (int l = 0; l < 2 && !done; ++l) done = p0_job(r, a.in[6] + (size_t)l * D * D, D, D, 32, waout + (size_t)l * D * D, 0, false, scr, lane);
            if (!done) done = p0_job(r, a.in[7], D, 2048, 64, wqkv, 1024, false, scr, lane);
            if (!done) done = p0_job(r, a.in[8], D, D, 32, wqkv, 0, false, scr, lane);
            if (!done) done = p0_job(r, a.in[8] + (size_t)D * D, D, D, 32, wq3, 0, false, scr, lane);
            for (int l = 0; l < 2 && !done; ++l) done = p0_job(r, a.in[11] + (size_t)l * D * D, D, D, 32, wbout + (size_t)l * D * D, 0, false, scr, lane);
        } else {
            r -= NSMALL;
            if (r < 128 * I_W13) { const int mat = r / I_W13; r -= mat * I_W13; p0_job(r, a.in[18] + (size_t)mat * 1024 * 1024, 1024, 1024, 32, w13 + (size_t)mat * 1024 * 1024, 0, true, scr, lane); }
            else { r -= 128 * I_W13; const int mat = r / I_W2; r -= mat * I_W2; p0_job(r, a.in[19] + (size_t)mat * 512 * 1024, 512, 1024, 32, w2 + (size_t)mat * 1024 * 512, 0, false, scr, lane); }
        }
    }
    { const int gt = (F.vcu * NWAVES + F.wave) * 64 + lane, NT = F.G * NWAVES * 64;
      for (int i = gt; i < 2 * 224 * (D / 8); i += NT) { const int l = i / (224 * (D / 8)), rr = (i / (D / 8)) % 224, c8 = i % (D / 8); *(GAS v4u*)(win + ((size_t)l * NINP + 4128 + rr) * D + c8 * 8) = (v4u){0u, 0u, 0u, 0u}; }
      for (int i = gt; i < 4 * 48 * D; i += NT) { const int l = i / (48 * D), n = (i / D) % 48, k = i % D;
          const float v = n < 4 ? a.in[16][((size_t)l * D + k) * 4 + n] : (n < 36 ? a.in[17][((size_t)l * D + k) * 32 + (n - 4)] : 0.f); wr[i] = (bf16)f2bf(v); }
      bf16* hb = (bf16*)(F.ws + WS_HB); const float* x = a.in[0];
      for (int i = gt; i < M * D / 8; i += NT) { const f32x4 p = *(const GAS f32x4*)(x + (size_t)i * 8), q = *(const GAS f32x4*)(x + (size_t)i * 8 + 4);
          *(GAS v4u*)(hb + (size_t)i * 8) = (v4u){pk2(p.x, p.y), pk2(p.z, p.w), pk2(q.x, q.y), pk2(q.z, q.w)}; } }
}

__device__ __forceinline__ void ln_rows8(Frame& F, const int lane, const float* hin, const float* mix, const float* g, const float* b, float* h1, bf16* h1b, int row0) {
    for (int rr = 0; rr < 8; ++rr) {
        const int row = row0 + rr;
        const GAS f32x4* hr = (const GAS f32x4*)(hin + (size_t)row * D) + lane; const GAS f32x4* mr = (const GAS f32x4*)(mix + (size_t)row * D) + lane;
        f32x4 v[4]; float s = 0.f;
#pragma unroll
        for (int j = 0; j < 4; ++j) { v[j] = hr[64 * j] * ALPHA + mr[64 * j]; s += (v[j].x + v[j].y) + (v[j].z + v[j].w); }
        const float mean = wave_sum(s) * (1.f / D); float s2 = 0.f;
#pragma unroll
        for (int j = 0; j < 4; ++j) { v[j] = v[j] - mean; s2 += (v[j].x * v[j].x + v[j].y * v[j].y) + (v[j].z * v[j].z + v[j].w * v[j].w); }
        const float rstd = 1.f / sqrtf(wave_sum(s2) * (1.f / D) + LN_EPS);
        GAS f32x4* o4 = (GAS f32x4*)(h1 + (size_t)row * D) + lane; GAS unsigned long long* o8 = (GAS unsigned long long*)(h1b + (size_t)row * D) + lane;
#pragma unroll
        for (int j = 0; j < 4; ++j) { const f32x4 gv = *((const GAS f32x4*)g + lane + 64 * j), bv = *((const GAS f32x4*)b + lane + 64 * j);
            const f32x4 y = v[j] * rstd * gv + bv; o4[64 * j] = y;
            o8[64 * j] = (unsigned long long)pk2(y.x, y.y) | ((unsigned long long)pk2(y.z, y.w) << 32); }
    }
}
__device__ __forceinline__ void phase_ln1_router(Frame& F, const float* hin, const float* mix, const float* g, const float* b, float* h1, bf16* h1b, const bf16* wr,
                                                 int* eid, float* gate, gu32* counts) {
    PHASE_IDS
    LAS float* lg = (LAS float*)(F.lds);
    LAS int* lcnt = (LAS int*)(F.lds + 16384);
    for (int blk = F.vcu; blk < M / 64; blk += F.G) {
        const int row0 = blk * 64;
        if (tid < 32) lcnt[tid] = 0;
        ln_rows8(F, lane, hin, mix, g, b, h1, h1b, row0 + F.wave * 8);
        VM_WAIT(); __syncthreads();
        if (F.wave < 4) {
            const int fr = lane & 15, fq = lane >> 4;
            const bf16* ap = h1b + (size_t)(row0 + F.wave * 16 + fr) * D + fq * 8;
            f32x4 acc[3]; acc[0] = (f32x4){0.f, 0.f, 0.f, 0.f}; acc[1] = acc[0]; acc[2] = acc[0];
#pragma unroll 4
            for (int ks = 0; ks < 32; ++ks) {
                const bf16x8 av = *(const GAS bf16x8*)(ap + ks * 32);
#pragma unroll
                for (int ct = 0; ct < 3; ++ct) { const bf16x8 bv = *(const GAS bf16x8*)(wr + (size_t)(ct * 16 + fr) * D + ks * 32 + fq * 8);
                    acc[ct] = __builtin_amdgcn_mfma_f32_16x16x32_bf16(av, bv, acc[ct], 0, 0, 0); }
            }
#pragma unroll
            for (int ct = 0; ct < 3; ++ct)
#pragma unroll
                for (int r = 0; r < 4; ++r) lg[(F.wave * 16 + 4 * fq + r) * 52 + ct * 16 + fr] = acc[ct][r];
            LDS_WAIT(); asm volatile("" ::: "memory");
            if (lane < 16) {
                const int rl = F.wave * 16 + lane; const LAS float* L = lg + rl * 52;
                int gi = 0; float gm = L[0];
                for (int q = 1; q < 4; ++q) if (L[q] > gm) { gm = L[q]; gi = q; }
                float gs = 0.f; for (int q = 0; q < 4; ++q) gs += __expf(L[q] - gm);
                const float pg = 1.f / gs; const LAS float* el = L + 4 + gi * 8;
                int i0 = 0; float v0 = el[0];
                for (int i = 1; i < 8; ++i) if (el[i] > v0) { v0 = el[i]; i0 = i; }
                int i1 = 0; float v1 = -INFINITY;
                for (int i = 0; i < 8; ++i) if (i != i0 && el[i] > v1) { v1 = el[i]; i1 = i; }
                const float e1 = __expf(v1 - v0); const int tok = row0 + rl, ea = gi * 8 + i0, eb = gi * 8 + i1;
                eid[2 * tok] = ea; eid[2 * tok + 1] = eb; gate[2 * tok] = pg / (1.f + e1); gate[2 * tok + 1] = pg * e1 / (1.f + e1);
                atomicAdd((int*)&lcnt[ea], 1); atomicAdd((int*)&lcnt[eb], 1);
            }
        }
        LDS_WAIT(); __syncthreads();
        if (tid < 32) { const int c = lcnt[tid]; if (c) __hip_atomic_fetch_add(counts + tid, (unsigned)c, __ATOMIC_RELAXED, __HIP_MEMORY_SCOPE_AGENT); }
        __syncthreads();
    }
}
__device__ __forceinline__ int moe_layout(Frame& F, const gu32* counts, LAS int* ps, LAS int* tile_e) {
    PHASE_IDS
    if (tid == 0) { int acc = 0; for (int e = 0; e < NEXP; ++e) { ps[e] = acc; const int c = (int)__hip_atomic_load(counts + e, __ATOMIC_RELAXED, __HIP_MEMORY_SCOPE_AGENT); const int nt = (c + 255) >> 8;
            for (int t = 0; t < nt; ++t) tile_e[(acc >> 8) + t] = e; acc += nt << 8; } ps[NEXP] = acc; }
    LDS_WAIT(); __syncthreads();
    return __builtin_amdgcn_readfirstlane(ps[NEXP]) >> 8;
}
__device__ __forceinline__ void phase_scatter(Frame& F, const gu32* counts, gu32* cursor, const int* eid, const bf16* h1b, bf16* xrows, int* apos) {
    PHASE_IDS
    LAS int* ps = (LAS int*)(F.lds + 20480); LAS int* tile_e = (LAS int*)(F.lds + TILEE_OFF);
    LAS int* lcnt = (LAS int*)(F.lds + 16384); LAS int* lbase = (LAS int*)(F.lds + 16384 + 256); LAS int* lpos = (LAS int*)(F.lds + 16384 + 512);
    (void)moe_layout(F, counts, ps, tile_e);
    for (int blk = F.vcu; blk < M / 64; blk += F.G) {
        if (tid < 32) lcnt[tid] = 0;
        __syncthreads();
        int e = 0, rk = 0;
        if (tid < 128) { e = eid[blk * 128 + tid]; rk = atomicAdd((int*)&lcnt[e], 1); }
        LDS_WAIT(); __syncthreads();
        if (tid < 32) { const int c = lcnt[tid]; lbase[tid] = c ? (int)__hip_atomic_fetch_add(cursor + tid, (unsigned)c, __ATOMIC_RELAXED, __HIP_MEMORY_SCOPE_AGENT) : 0; }
        LDS_WAIT(); __syncthreads();
        if (tid < 128) { const int pos = ps[e] + lbase[e] + rk; lpos[tid] = pos; apos[blk * 128 + tid] = pos; }
        LDS_WAIT(); __syncthreads();
        for (int a = F.wave; a < 128; a += NWAVES) {
            const int tok = blk * 64 + (a >> 1), pos = lpos[a];
            const GAS v4u* src = (const GAS v4u*)(h1b + (size_t)tok * D) + lane; GAS v4u* dst = (GAS v4u*)(xrows + (size_t)pos * D) + lane;
            const v4u p0 = src[0], p1 = src[64]; dst[0] = p0; dst[64] = p1;
        }
        __syncthreads();
    }
}
__device__ __forceinline__ void phase_combine_ln2(Frame& F, const float* h1, const bf16* yrows, const int* apos, const float* gate, const float* g, const float* b, float* hout, bf16* hb) {
    PHASE_IDS
    const int gw = F.vcu * NWAVES + F.wave, NGW = F.G * NWAVES;
    for (int row = gw; row < M; row += NGW) {
        const int p0 = apos[2 * row], p1 = apos[2 * row + 1]; const float g0 = gate[2 * row], g1 = gate[2 * row + 1];
        const GAS f32x4* hr = (const GAS f32x4*)(h1 + (size_t)row * D) + lane;
        const GAS unsigned long long* y0 = (const GAS unsigned long long*)(yrows + (size_t)p0 * D) + lane; const GAS unsigned long long* y1 = (const GAS unsigned long long*)(yrows + (size_t)p1 * D) + lane;
        f32x4 v[4]; float s = 0.f;
#pragma unroll
        for (int j = 0; j < 4; ++j) { const unsigned long long a = y0[64 * j], c = y1[64 * j];
            f32x4 ya, yc;
            ya.x = __uint_as_float(((unsigned)a) << 16); ya.y = __uint_as_float(((unsigned)a) & 0xffff0000u); ya.z = __uint_as_float(((unsigned)(a >> 32)) << 16); ya.w = __uint_as_float(((unsigned)(a >> 32)) & 0xffff0000u);
            yc.x = __uint_as_float(((unsigned)c) << 16); yc.y = __uint_as_float(((unsigned)c) & 0xffff0000u); yc.z = __uint_as_float(((unsigned)(c >> 32)) << 16); yc.w = __uint_as_float(((unsigned)(c >> 32)) & 0xffff0000u);
            v[j] = hr[64 * j] * ALPHA + ya * g0 + yc * g1; s += (v[j].x + v[j].y) + (v[j].z + v[j].w); }
        const float mean = wave_sum(s) * (1.f / D); float s2 = 0.f;
#pragma unroll
        for (int j = 0; j < 4; ++j) { v[j] = v[j] - mean; s2 += (v[j].x * v[j].x + v[j].y * v[j].y) + (v[j].z * v[j].z + v[j].w * v[j].w); }
        const float rstd = 1.f / sqrtf(wave_sum(s2) * (1.f / D) + LN_EPS);
        GAS f32x4* o4 = (GAS f32x4*)(hout + (size_t)row * D) + lane; GAS unsigned long long* o8 = (GAS unsigned long long*)(hb + (size_t)row * D) + lane;
#pragma unroll
        for (int j = 0; j < 4; ++j) { const f32x4 gv = *((const GAS f32x4*)g + lane + 64 * j), bv = *((const GAS f32x4*)b + lane + 64 * j);
            const f32x4 y = v[j] * rstd * gv + bv; o4[64 * j] = y;
            o8[64 * j] = (unsigned long long)pk2(y.x, y.y) | ((unsigned long long)pk2(y.z, y.w) << 32); }
    }
}

__device__ __forceinline__ void phase_attn_combine(Frame& F, const bf16* O1, const bf16* O2, const float* lam_p, const float* subln, float lam_init, bf16* on) {
    PHASE_IDS
    const float l01 = wave_sum(lam_p[lane] * lam_p[64 + lane]), l23 = wave_sum(lam_p[128 + lane] * lam_p[192 + lane]);
    const float lam = __expf(l01) - __expf(l23) + lam_init;
    float sw[16];
#pragma unroll
    for (int i = 0; i < 16; ++i) sw[i] = subln[(lane & 7) * 16 + i] * (1.f - lam_init);
    const int gw = F.vcu * NWAVES + F.wave, NGW = F.G * NWAVES;
    for (int row = gw; row < M; row += NGW) {
        const GAS v4u* p1 = (const GAS v4u*)(O1 + (size_t)row * D) + 2 * lane; const GAS v4u* p2 = (const GAS v4u*)(O2 + (size_t)row * D) + 2 * lane;
        const v4u a0 = p1[0], a1 = p1[1], b0 = p2[0], b1 = p2[1];
        const unsigned aw[8] = {a0.x, a0.y, a0.z, a0.w, a1.x, a1.y, a1.z, a1.w}, bw[8] = {b0.x, b0.y, b0.z, b0.w, b1.x, b1.y, b1.z, b1.w};
        float o[16]; float ss = 0.f;
#pragma unroll
        for (int i = 0; i < 8; ++i) { o[2 * i] = __uint_as_float(aw[i] << 16) - lam * __uint_as_float(bw[i] << 16); o[2 * i + 1] = __uint_as_float(aw[i] & 0xffff0000u) - lam * __uint_as_float(bw[i] & 0xffff0000u);
            ss += o[2 * i] * o[2 * i] + o[2 * i + 1] * o[2 * i + 1]; }
        ss += __shfl_xor(ss, 1); ss += __shfl_xor(ss, 2); ss += __shfl_xor(ss, 4);
        const float r = 1.f / sqrtf(ss * (1.f / 128.f) + RMS_EPS);
        v4u w0, w1;
        w0.x = pk2(o[0] * r * sw[0], o[1] * r * sw[1]); w0.y = pk2(o[2] * r * sw[2], o[3] * r * sw[3]); w0.z = pk2(o[4] * r * sw[4], o[5] * r * sw[5]); w0.w = pk2(o[6] * r * sw[6], o[7] * r * sw[7]);
        w1.x = pk2(o[8] * r * sw[8], o[9] * r * sw[9]); w1.y = pk2(o[10] * r * sw[10], o[11] * r * sw[11]); w1.z = pk2(o[12] * r * sw[12], o[13] * r * sw[13]); w1.w = pk2(o[14] * r * sw[14], o[15] * r * sw[15]);
        GAS v4u* q = (GAS v4u*)(on + (size_t)row * D) + 2 * lane; q[0] = w0; q[1] = w1;
    }
}

typedef short s16x4v __attribute__((ext_vector_type(4)));
typedef short v4i16_t __attribute__((ext_vector_type(4)));
constexpr size_t WS_WNEG = WS_FAST_END;
constexpr size_t WS_QDEC = WS_WNEG + (size_t)2048 * 64 * 128 * 2;
constexpr size_t WS_KDEC = WS_QDEC + (size_t)2048 * 64 * 128 * 2;
constexpr size_t WS_ATT = WS_KDEC + (size_t)2048 * 64 * 128 * 2;
constexpr size_t WS_U = WS_ATT + (size_t)2048 * 64 * 64 * 2;
constexpr size_t WS_GLAST = WS_U + (size_t)2048 * 64 * 128 * 4;
constexpr size_t WS_OB = WS_GLAST + 8192;
constexpr size_t WS_DN_END = WS_OB + (size_t)M * D * 2;

__device__ __forceinline__ float bf2f(unsigned short v) { return __uint_as_float((unsigned)v << 16); }
__device__ __forceinline__ float silu_f(float x) { return x / (1.f + __expf(-x)); }
__device__ __forceinline__ s16x4v pack4(const f32x4 v) { s16x4v r; const unsigned a = pk2(v[0], v[1]), b = pk2(v[2], v[3]); r[0] = (short)(a & 0xffff); r[1] = (short)(a >> 16); r[2] = (short)(b & 0xffff); r[3] = (short)(b >> 16); return r; }
__device__ __forceinline__ bf16x8 pack8(const f32x4 lo, const f32x4 hi) { const unsigned a = pk2(lo[0], lo[1]), b = pk2(lo[2], lo[3]), c = pk2(hi[0], hi[1]), d = pk2(hi[2], hi[3]); return __builtin_bit_cast(bf16x8, (v4u){a, b, c, d}); }
#define MFMA16(a, b, c) __builtin_amdgcn_mfma_f32_16x16x16bf16_1k((a), (b), (c), 0, 0, 0)
#define MFMA32(a, b, c) __builtin_amdgcn_mfma_f32_16x16x32_bf16((a), (b), (c), 0, 0, 0)

__device__ __forceinline__ void conv8(const bf16* projb, int row, int pos, int col, const float* cw, float (&out)[8]) {
#pragma unroll
    for (int e = 0; e < 8; ++e) out[e] = 0.f;
#pragma unroll
    for (int j = 0; j < 4; ++j) {
        const bool ok = (pos - 3 + j) >= 0;
        v4u x = *(const GAS v4u*)(projb + (size_t)(ok ? row - 3 + j : row) * NINP + col);
        if (!ok) x = (v4u){0u, 0u, 0u, 0u};
        const f32x4 w0 = *(const GAS f32x4*)(cw + j * 3072 + col), w1 = *(const GAS f32x4*)(cw + j * 3072 + col + 4);
        out[0] = fmaf(w0.x, __uint_as_float(x.x << 16), out[0]); out[1] = fmaf(w0.y, __uint_as_float(x.x & 0xffff0000u), out[1]);
        out[2] = fmaf(w0.z, __uint_as_float(x.y << 16), out[2]); out[3] = fmaf(w0.w, __uint_as_float(x.y & 0xffff0000u), out[3]);
        out[4] = fmaf(w1.x, __uint_as_float(x.z << 16), out[4]); out[5] = fmaf(w1.y, __uint_as_float(x.z & 0xffff0000u), out[5]);
        out[6] = fmaf(w1.z, __uint_as_float(x.w << 16), out[6]); out[7] = fmaf(w1.w, __uint_as_float(x.w & 0xffff0000u), out[7]);
    }
#pragma unroll
    for (int e = 0; e < 8; ++e) out[e] = silu_f(out[e]);
}
__device__ __forceinline__ f32x4 conv1x4(const bf16* projb, int rowb, int posb, int col, const float* cw) {
    float x[7];
#pragma unroll
    for (int i = 0; i < 7; ++i) { const bool ok = (posb - 3 + i) >= 0; const float v = bf2f(*(const GAS unsigned short*)(projb + (size_t)(ok ? rowb - 3 + i : rowb) * NINP + col)); x[i] = ok ? v : 0.f; }
    const float w0 = cw[col], w1 = cw[3072 + col], w2 = cw[2 * 3072 + col], w3 = cw[3 * 3072 + col];
    f32x4 o;
#pragma unroll
    for (int r = 0; r < 4; ++r) o[r] = silu_f(fmaf(w3, x[r + 3], fmaf(w2, x[r + 2], fmaf(w1, x[r + 1], w0 * x[r]))));
    return o;
}

__device__ __forceinline__ void phase_dn_prep(Frame& F, const bf16* projb_, const float* convw_, const float* a_log, const float* dt_bias,
                                              bf16* wneg_, bf16* qdec_, bf16* kdec_, bf16* attn_, float* ubuf_, float* glast) {
    const int hh = F.wave;
    { const int unit = F.vcu;
        const float A_h = __expf(a_log[hh]), dtb = dt_bias[hh];
        int lane_ = (int)__builtin_amdgcn_mbcnt_hi(~0u, __builtin_amdgcn_mbcnt_lo(~0u, 0u)); asm volatile("" : "+v"(lane_));
        const int lane = lane_, fr = lane & 15, fq = lane >> 4;
        const float* convw = convw_; asm volatile("" : "+s"(convw));
        const bf16* projb = projb_; asm volatile("" : "+s"(projb));
        bf16* wneg = wneg_; bf16* qdec = qdec_; bf16* kdec = kdec_; bf16* attn = attn_; float* ubuf = ubuf_; asm volatile("" : "+s"(wneg), "+s"(qdec), "+s"(kdec), "+s"(attn), "+s"(ubuf));
        unsigned ldsb = 0; asm volatile("" : "+s"(ldsb));
        LAS float* gcs = (LAS float*)(F.lds + ldsb + PREP_SC_OFF + F.wave * 768); LAS float* bes = gcs + 64; LAS float* rnk = gcs + 128;
        LAS unsigned char* tw = F.lds + ldsb + F.wave * 16384;
        const int b = unit >> 7, n = unit & 127, t0 = n * 64, row0 = b * T + t0, cid = (b * 8 + hh) * 128 + n;
        {
            const int row = row0 + lane;
            const float bl = bf2f(projb[(size_t)row * NINP + 4096 + hh]), al = bf2f(projb[(size_t)row * NINP + 4104 + hh]);
            const float x = al + dtb; const float sp = (x > 20.f) ? x : log1pf(__expf(x));
            float c = -A_h * sp;
#pragma unroll
            for (int o = 1; o < 64; o <<= 1) { const float t = __shfl_up(c, o); if (lane >= o) c += t; }
            gcs[lane] = c; bes[lane] = 1.f / (1.f + __expf(-bl));
        }
        LDS_WAIT(); asm volatile("" ::: "memory");
        const float gl = gcs[63];
        if (lane == 0) glast[cid] = __expf(gl);
#pragma unroll 1
        for (int t = 0; t < 4; ++t) {
            const int tok = 16 * t + fr; float v[4][8]; float ss = 0.f;
#pragma unroll
            for (int ks = 0; ks < 4; ++ks) { conv8(projb, row0 + tok, t0 + tok, 1024 + hh * 128 + 32 * ks + 8 * fq, convw, v[ks]);
#pragma unroll
                for (int e = 0; e < 8; ++e) ss = fmaf(v[ks][e], v[ks][e], ss); }
            ss += __shfl_xor(ss, 16); ss += __shfl_xor(ss, 32);
            const float rn = 1.f / sqrtf(ss + RMS_EPS);
            if (fq == 0) rnk[tok] = rn;
            const float kd = rn * __expf(gl - gcs[tok]);
#pragma unroll
            for (int ks = 0; ks < 4; ++ks) {
                *(LAS v4u*)(tw + tok * 256 + (((4 * ks + fq) ^ fr) << 4)) = (v4u){pk2(v[ks][0] * rn, v[ks][1] * rn), pk2(v[ks][2] * rn, v[ks][3] * rn), pk2(v[ks][4] * rn, v[ks][5] * rn), pk2(v[ks][6] * rn, v[ks][7] * rn)};
                *(GAS v4u*)(kdec + ((size_t)cid * 64 + tok) * 128 + 32 * ks + 8 * fq) = (v4u){pk2(v[ks][0] * kd, v[ks][1] * kd), pk2(v[ks][2] * kd, v[ks][3] * kd), pk2(v[ks][4] * kd, v[ks][5] * kd), pk2(v[ks][6] * kd, v[ks][7] * kd)};
            }
        }
        LDS_WAIT(); asm volatile("" ::: "memory");
#define KFRAG(t_, ks_) (*(const LAS bf16x8*)(tw + (16 * (t_) + fr) * 256 + (((4 * (ks_) + fq) ^ fr) << 4)))
        bf16* attc = attn + (size_t)cid * 64 * 64;
#pragma unroll 1
        for (int ti = 0; ti < 4; ++ti) {
            bf16x8 qf[4];
            { const int tok = 16 * ti + fr; float v[4][8]; float ss = 0.f;
#pragma unroll
              for (int ks = 0; ks < 4; ++ks) { conv8(projb, row0 + tok, t0 + tok, hh * 128 + 32 * ks + 8 * fq, convw, v[ks]);
#pragma unroll
                  for (int e = 0; e < 8; ++e) ss = fmaf(v[ks][e], v[ks][e], ss); }
              ss += __shfl_xor(ss, 16); ss += __shfl_xor(ss, 32);
              const float rn = 1.f / sqrtf(ss + RMS_EPS);
              const float qd = rn * 0.08838834764831845f * __expf(gcs[tok]);
#pragma unroll
              for (int ks = 0; ks < 4; ++ks) {
                  qf[ks] = __builtin_bit_cast(bf16x8, (v4u){pk2(v[ks][0] * rn, v[ks][1] * rn), pk2(v[ks][2] * rn, v[ks][3] * rn), pk2(v[ks][4] * rn, v[ks][5] * rn), pk2(v[ks][6] * rn, v[ks][7] * rn)});
                  *(GAS v4u*)(qdec + ((size_t)cid * 64 + tok) * 128 + 32 * ks + 8 * fq) = (v4u){pk2(v[ks][0] * qd, v[ks][1] * qd), pk2(v[ks][2] * qd, v[ks][3] * qd), pk2(v[ks][4] * qd, v[ks][5] * qd), pk2(v[ks][6] * qd, v[ks][7] * qd)};
              } }
#pragma unroll 1
            for (int tj = 0; tj <= ti; ++tj) {
                f32x4 acc = (f32x4){0.f, 0.f, 0.f, 0.f};
#pragma unroll
                for (int ks = 0; ks < 4; ++ks) acc = MFMA32(qf[ks], KFRAG(tj, ks), acc);
                const int j = 16 * tj + fr; const float gj = gcs[j];
#pragma unroll
                for (int r = 0; r < 4; ++r) { const int i = 16 * ti + 4 * fq + r; const float a = (i >= j) ? acc[r] * 0.08838834764831845f * __expf(gcs[i] - gj) : 0.f;
                    attc[i * 64 + j] = (bf16)f2bf(a); }
            }
            if ((ti & 1) == 0) {
#pragma unroll
                for (int r = 0; r < 4; ++r) attc[(16 * ti + 4 * fq + r) * 64 + 16 * (ti + 1) + fr] = (bf16)0;
            }
        }
        s16x4v nAoff[4][4];
        s16x4v P1n[4], P2[4], P4[4], P8[4];
#pragma unroll
        for (int ti = 0; ti < 4; ++ti)
#pragma unroll
            for (int tj = 0; tj <= ti; ++tj) {
                f32x4 acc = (f32x4){0.f, 0.f, 0.f, 0.f};
#pragma unroll
                for (int ks = 0; ks < 4; ++ks) acc = MFMA32(KFRAG(tj, ks), KFRAG(ti, ks), acc);
                const int i = 16 * ti + fr; const float bi = bes[i], gi = gcs[i];
                f32x4 aop;
#pragma unroll
                for (int r = 0; r < 4; ++r) { const int j = 16 * tj + 4 * fq + r; aop[r] = (i > j) ? bi * acc[r] * __expf(gi - gcs[j]) : 0.f; }
                if (tj < ti) { nAoff[ti][tj] = pack4(-aop); }
                else {
                    f32x4 bop;
#pragma unroll
                    for (int r = 0; r < 4; ++r) { const int rw = 16 * ti + 4 * fq + r; bop[r] = (rw > i) ? bes[rw] * acc[r] * __expf(gcs[rw] - gi) : 0.f; }
                    const s16x4v a1 = pack4(aop), b1 = pack4(bop);
                    const f32x4 z = (f32x4){0.f, 0.f, 0.f, 0.f};
                    const s16x4v a2 = pack4(MFMA16(b1, a1, z)), b2 = pack4(MFMA16(a1, b1, z));
                    const s16x4v a4 = pack4(MFMA16(b2, a2, z)), b4 = pack4(MFMA16(a2, b2, z));
                    const s16x4v a8 = pack4(MFMA16(b4, a4, z));
                    P1n[ti] = pack4(-aop); P2[ti] = a2; P4[ti] = a4; P8[ti] = a8;
                }
            }
#undef KFRAG
#pragma unroll 1
        for (int ct = 0; ct < 16; ++ct) {
            int lo_ = lane; asm volatile("" : "+v"(lo_)); const int fr = lo_ & 15, fq = lo_ >> 4;
            const bool isw = ct >= 8; const int ch = 16 * (ct & 7) + fr;
            const int col = (isw ? 1024 : 2048) + hh * 128 + ch;
            s16x4v Xb[4];
#pragma unroll
            for (int bi = 0; bi < 4; ++bi) {
                const int tokb = 16 * bi + 4 * fq;
                f32x4 Y = conv1x4(projb, row0 + tokb, t0 + tokb, col, convw);
#pragma unroll
                for (int r = 0; r < 4; ++r) { const int tok = tokb + r; float f = bes[tok]; if (isw) f *= rnk[tok] * __expf(gcs[tok]); Y[r] *= f; }
#pragma unroll
                for (int bj = 0; bj < 4; ++bj) if (bj < bi) Y = MFMA16(nAoff[bi][bj], Xb[bj], Y);
                Y = MFMA16(P8[bi], pack4(Y), Y); Y = MFMA16(P4[bi], pack4(Y), Y); Y = MFMA16(P2[bi], pack4(Y), Y); Y = MFMA16(P1n[bi], pack4(Y), Y);
                Xb[bi] = pack4(Y);
                if (!isw) {
#pragma unroll
                    for (int r = 0; r < 4; ++r) ubuf[((size_t)cid * 64 + tokb + r) * 128 + ch] = Y[r];
                } else {
#pragma unroll
                    for (int r = 0; r < 4; ++r) wneg[((size_t)cid * 64 + tokb + r) * 128 + ch] = (bf16)f2bf(-Y[r]);
                }
            }
        }
        LDS_WAIT(); asm volatile("" ::: "memory");
    }
}

constexpr int SC_W = 0, SC_Q = 17408, SC_K = 34816, SC_A = 53248, SC_SET = 62464;
__device__ __forceinline__ bf16x8 lds_a8(const LAS unsigned char* p) {
    const unsigned long long lo = *(const LAS unsigned long long*)p, hi = *(const LAS unsigned long long*)(p + 32);
    return __builtin_bit_cast(bf16x8, (v4u){(unsigned)lo, (unsigned)(lo >> 32), (unsigned)hi, (unsigned)(hi >> 32)});
}
__device__ __forceinline__ bf16x8 lds_tr8(const LAS unsigned char* p, int rowstride16) {
    const s16x4v lo = __builtin_bit_cast(s16x4v, __builtin_amdgcn_ds_read_tr16_b64_v4i16((LAS v4i16_t*)p));
    const s16x4v hi = __builtin_bit_cast(s16x4v, __builtin_amdgcn_ds_read_tr16_b64_v4i16((LAS v4i16_t*)(p + rowstride16)));
    return (bf16x8){lo[0], lo[1], lo[2], lo[3], hi[0], hi[1], hi[2], hi[3]};
}
__device__ __forceinline__ void phase_dn_scan(Frame& F, const bf16* wneg, const bf16* qdec, const bf16* kdec, const bf16* attn, const float* ubuf, const float* glast, bf16* obuf) {
    PHASE_IDS
    if (F.vcu >= 32) return;
    const int fr = lane & 15, fq = lane >> 4;
    const int bh = F.vcu >> 1, half = F.vcu & 1, b = bh >> 3, hh = bh & 7, cid0 = bh * 128;
    LAS unsigned char* L = F.lds;
    if (F.wave >= 4) {
        const int lt = (F.wave - 4) * 64 + lane;
        v4u ra[14], rb[14];
#define SC_LOAD(R, c) do { const size_t cb = (size_t)(cid0 + (c)) * 64 * 128; \
        _Pragma("unroll") for (int i = 0; i < 4; ++i) { const int p = lt + 256 * i; R[i] = *(const GAS v4u*)(wneg + cb + (size_t)p * 8); R[4 + i] = *(const GAS v4u*)(qdec + cb + (size_t)p * 8); R[8 + i] = *(const GAS v4u*)(kdec + cb + (size_t)p * 8); } \
        _Pragma("unroll") for (int i = 0; i < 2; ++i) { const int p = lt + 256 * i; R[12 + i] = *(const GAS v4u*)(attn + (size_t)(cid0 + (c)) * 64 * 64 + (size_t)p * 8); } } while (0)
#define SC_WRITE(R, set) do { LAS unsigned char* S_ = L + (set) * SC_SET; \
        _Pragma("unroll") for (int i = 0; i < 4; ++i) { const int p = lt + 256 * i, row = p >> 4, c16 = p & 15; *(LAS v4u*)(S_ + SC_W + row * 272 + c16 * 16) = R[i]; *(LAS v4u*)(S_ + SC_Q + row * 272 + c16 * 16) = R[4 + i]; *(LAS v4u*)(S_ + SC_K + row * 288 + c16 * 16) = R[8 + i]; } \
        _Pragma("unroll") for (int i = 0; i < 2; ++i) { const int p = lt + 256 * i, row = p >> 3, c16 = p & 7; *(LAS v4u*)(S_ + SC_A + row * 144 + c16 * 16) = R[12 + i]; } } while (0)
        SC_LOAD(ra, 0); SC_LOAD(rb, 1);
        SC_WRITE(ra, 0); SC_LOAD(ra, 2);
        LDS_WAIT(); __builtin_amdgcn_s_barrier();
#pragma unroll 1
        for (int n = 0; n < 128; n += 2) {
            SC_WRITE(rb, 1); if (n + 3 < 128) SC_LOAD(rb, n + 3);
            LDS_WAIT(); __builtin_amdgcn_s_barrier();
            if (n + 2 < 128) { SC_WRITE(ra, 0); if (n + 4 < 128) SC_LOAD(ra, n + 4); }
            LDS_WAIT(); __builtin_amdgcn_s_barrier();
        }
#undef SC_LOAD
#undef SC_WRITE
    } else {
        const int c0 = half * 64 + F.wave * 16;
        f32x4 S[8]; bf16x8 SB[4];
#pragma unroll
        for (int i = 0; i < 8; ++i) S[i] = (f32x4){0.f, 0.f, 0.f, 0.f};
#pragma unroll
        for (int i = 0; i < 4; ++i) SB[i] = (bf16x8){0, 0, 0, 0, 0, 0, 0, 0};
        f32x4 un[4]; float gln;
#define SC_ULOAD(c) do { const float* ub = ubuf + (size_t)(cid0 + (c)) * 64 * 128 + c0 + fr; \
        _Pragma("unroll") for (int mt = 0; mt < 4; ++mt) _Pragma("unroll") for (int r = 0; r < 4; ++r) un[mt][r] = ub[(16 * mt + 4 * fq + r) * 128]; gln = glast[cid0 + (c)]; } while (0)
        SC_ULOAD(0);
        __builtin_amdgcn_s_barrier();
#pragma unroll 1
        for (int n = 0; n < 128; ++n) {
            const LAS unsigned char* Sx = L + (n & 1) * SC_SET;
            f32x4 vn[4]; const float glc = gln;
#pragma unroll
            for (int mt = 0; mt < 4; ++mt) vn[mt] = un[mt];
            if (n + 1 < 128) SC_ULOAD(n + 1);
            f32x4 o[4];
#pragma unroll
            for (int mt = 0; mt < 4; ++mt) {
                o[mt] = (f32x4){0.f, 0.f, 0.f, 0.f};
#pragma unroll
                for (int s = 0; s < 4; ++s) {
                    vn[mt] = MFMA32(lds_a8(Sx + SC_W + (16 * mt + fr) * 272 + (32 * s + 4 * fq) * 2), SB[s], vn[mt]);
                    o[mt] = MFMA32(lds_a8(Sx + SC_Q + (16 * mt + fr) * 272 + (32 * s + 4 * fq) * 2), SB[s], o[mt]);
                }
            }
            bf16x8 VB[2]; VB[0] = pack8(vn[0], vn[1]); VB[1] = pack8(vn[2], vn[3]);
#pragma unroll
            for (int mt = 0; mt < 4; ++mt)
#pragma unroll
                for (int sp = 0; sp < 2; ++sp) if (sp <= (mt >> 1)) o[mt] = MFMA32(lds_a8(Sx + SC_A + (16 * mt + fr) * 144 + (32 * sp + 4 * fq) * 2), VB[sp], o[mt]);
            { bf16* ob = obuf + ((size_t)b * T + (size_t)n * 64) * D + hh * 128 + c0 + fr;
#pragma unroll
              for (int mt = 0; mt < 4; ++mt)
#pragma unroll
                  for (int r = 0; r < 4; ++r) ob[(size_t)(16 * mt + 4 * fq + r) * D] = (bf16)f2bf(o[mt][r]); }
#pragma unroll
            for (int dt = 0; dt < 8; ++dt) {
                S[dt] = S[dt] * glc;
#pragma unroll
                for (int sp = 0; sp < 2; ++sp) S[dt] = MFMA32(lds_tr8(Sx + SC_K + (32 * sp + 4 * fq + (fr >> 2)) * 288 + (16 * dt + 4 * (fr & 3)) * 2, 16 * 288), VB[sp], S[dt]);
            }
#pragma unroll
            for (int s = 0; s < 4; ++s) SB[s] = pack8(S[2 * s], S[2 * s + 1]);
            LDS_WAIT(); __builtin_amdgcn_s_barrier();
        }
#undef SC_ULOAD
    }
}
__device__ __forceinline__ void phase_dn_gate(Frame& F, const bf16* obuf, const bf16* projb, const float* norm_w, bf16* on) {
    PHASE_IDS
    float nw[16];
#pragma unroll
    for (int i = 0; i < 16; ++i) nw[i] = norm_w[(lane & 7) * 16 + i];
    const int gw = F.vcu * NWAVES + F.wave, NGW = F.G * NWAVES;
    for (int row = gw; row < M; row += NGW) {
        const GAS v4u* p1 = (const GAS v4u*)(obuf + (size_t)row * D) + 2 * lane; const GAS v4u* p2 = (const GAS v4u*)(projb + (size_t)row * NINP + 3072) + 2 * lane;
        const v4u a0 = p1[0], a1 = p1[1], b0 = p2[0], b1 = p2[1];
        const unsigned aw[8] = {a0.x, a0.y, a0.z, a0.w, a1.x, a1.y, a1.z, a1.w}, bw[8] = {b0.x, b0.y, b0.z, b0.w, b1.x, b1.y, b1.z, b1.w};
        float o[16], z[16]; float ss = 0.f;
#pragma unroll
        for (int i = 0; i < 8; ++i) { o[2 * i] = __uint_as_float(aw[i] << 16); o[2 * i + 1] = __uint_as_float(aw[i] & 0xffff0000u); z[2 * i] = __uint_as_float(bw[i] << 16); z[2 * i + 1] = __uint_as_float(bw[i] & 0xffff0000u);
            ss += o[2 * i] * o[2 * i] + o[2 * i + 1] * o[2 * i + 1]; }
        ss += __shfl_xor(ss, 1); ss += __shfl_xor(ss, 2); ss += __shfl_xor(ss, 4);
        const float r = 1.f / sqrtf(ss * (1.f / 128.f) + RMS_EPS);
        float y[16];
#pragma unroll
        for (int i = 0; i < 16; ++i) y[i] = o[i] * r * nw[i] * silu_f(z[i]);
        v4u w0, w1;
        w0.x = pk2(y[0], y[1]); w0.y = pk2(y[2], y[3]); w0.z = pk2(y[4], y[5]); w0.w = pk2(y[6], y[7]);
        w1.x = pk2(y[8], y[9]); w1.y = pk2(y[10], y[11]); w1.z = pk2(y[12], y[13]); w1.w = pk2(y[14], y[15]);
        GAS v4u* q = (GAS v4u*)(on + (size_t)row * D) + 2 * lane; q[0] = w0; q[1] = w1;
    }
}
#define PH(l, k) (1 + 16 * (l) + (k))
__global__ void __launch_bounds__(NWAVES * 64, 2) mega(Args args) {
    extern __shared__ __attribute__((aligned(16))) unsigned char lds[];
    Frame F;
    F.lds = (LAS unsigned char*)lds; F.MISC = (volatile LAS unsigned*)(F.lds + MISC_OFF);
    F.wave = __builtin_amdgcn_readfirstlane((int)threadIdx.x >> 6);
    F.G = gridDim.x; { const int bx = blockIdx.x; F.vcu = (F.G % 8 == 0) ? (bx % 8) * (F.G / 8) + bx / 8 : bx; }
    F.ws = args.ws; F.ctl = (gu32*)(args.ws + WS_CTL);
    for (int u = threadIdx.x; u < (LDS_BYTES - LDSCTL_OFF) / 4; u += NWAVES * 64) ((LAS unsigned*)(F.lds + LDSCTL_OFF))[u] = 0u;
    __syncthreads();
    const int lo = args.ph_lo, hi = args.ph_hi;
    XcdBarrier bar; bar.bar = (unsigned*)(F.ctl + CW_BAR) + args.bar_region * XCD_BAR_WORDS; bar.x = 0; bar.st = nullptr;
    if (hi - lo > 1) bar = xcd_barrier_post((unsigned*)(F.ctl + CW_BAR) + args.bar_region * XCD_BAR_WORDS, F.MISC + 8, F.wave);
    unsigned char* ws = args.ws;
    bf16* hb = (bf16*)(ws + WS_HB); float* hbuf = (float*)(ws + WS_H); float* h1 = (float*)(ws + WS_H1); bf16* h1b = (bf16*)(ws + WS_H1B);
    bf16* projb = (bf16*)(ws + WS_PROJ); bf16* Kb = (bf16*)(ws + WS_KB); bf16* Qb = Kb - (size_t)M * D; bf16* onb = (bf16*)(ws + WS_ON); float* mix = (float*)(ws + WS_MIX);
    int* eid = (int*)(ws + WS_EID); float* gate = (float*)(ws + WS_GATE); int* apos = (int*)(ws + WS_APOS);
    bf16* xrows = (bf16*)(ws + WS_XROWS); bf16* hid = (bf16*)(ws + WS_HID); bf16* yrows = (bf16*)(ws + WS_YROWS);
    LAS int* tile_e = (LAS int*)(F.lds + TILEE_OFF); LAS int* psl = (LAS int*)(F.lds + 20480);

#define IN(p) (lo <= (p) && (p) < hi)
#define SEAM(p) do { if ((p) + 1 < hi) xcd_barrier(bar, F.wave); } while (0)
    if (IN(0)) { p0_prologue(F, args); SEAM(0); }
#define LAYER(l) do { \
    gu32* counts = F.ctl + CW_CNT + 128 * (l); gu32* cursor = counts + 64; \
    if (IN(PH(l, 0))) { \
        if ((l) < 2) { pg8::Gemm g{hb, (const bf16*)(ws + WS_WIN) + (size_t)(l) * NINP * D, M, NINP, D}; pg8::StaticOrder S; S.init(M, NINP, F.G, (int)blockIdx.x); \
            pg8::EpiBf16<0> E{projb, NINP, nullptr, 0, 0, 1.f}; pg8::gemm_phase<pg8::EpiBf16<0>, pg8::StaticOrder, true, true>(F.lds, g, S, E, F.wave); } \
        else { const int NQ = ((l) == 2) ? 3 * D : D; pg8::Gemm g{hb, (const bf16*)(ws + ((l) == 2 ? WS_WQKV : WS_WQ3)), M, NQ, D}; pg8::StaticOrder S; S.init(M, NQ, F.G, (int)blockIdx.x); \
            pg8::EpiBf16<0> E{Qb, D, nullptr, D, (size_t)M * D, QSCALE}; pg8::gemm_phase<pg8::EpiBf16<0>, pg8::StaticOrder, true, true>(F.lds, g, S, E, F.wave); } \
        SEAM(PH(l, 0)); } \
    if ((l) < 2 && IN(PH(l, 1))) { \
        phase_dn_prep(F, projb, args.in[2] + (size_t)(l) * 4 * 3072, args.in[3] + (l) * 8, args.in[4] + (l) * 8, (bf16*)(ws + WS_WNEG), (bf16*)(ws + WS_QDEC), (bf16*)(ws + WS_KDEC), (bf16*)(ws + WS_ATT), (float*)(ws + WS_U), (float*)(ws + WS_GLAST)); SEAM(PH(l, 1)); } \
    if ((l) < 2 && IN(PH(l, 2))) { \
        phase_dn_scan(F, (const bf16*)(ws + WS_WNEG), (const bf16*)(ws + WS_QDEC), (const bf16*)(ws + WS_KDEC), (const bf16*)(ws + WS_ATT), (const float*)(ws + WS_U), (const float*)(ws + WS_GLAST), (bf16*)(ws + WS_OB)); SEAM(PH(l, 2)); } \
    if ((l) < 2 && IN(PH(l, 3))) { \
        phase_dn_gate(F, (const bf16*)(ws + WS_OB), projb, args.in[5] + (l) * 128, onb); SEAM(PH(l, 3)); } \
    if ((l) >= 2 && IN(PH(l, 1))) { \
        const attn_body::AttnTensors AT{(const attn_body::bf16*)Qb, (const attn_body::bf16*)Kb, (const attn_body::bf16*)(ws + WS_VB), (attn_body::bf16*)projb, (attn_body::bf16*)(projb + (size_t)M * D)}; \
        const attn_body::StaticOrder S((int)F.G, (int)blockIdx.x); \
        attn_body::attn_phase<attn_body::StaticOrder>((char*)lds, AT, S, F.wave); SEAM(PH(l, 1)); } \
    if ((l) >= 2 && IN(PH(l, 3))) { \
        phase_attn_combine(F, projb, projb + (size_t)M * D, args.in[9] + ((l) - 2) * 256, args.in[10] + ((l) - 2) * 128, args.lam_init[(l) & 1], onb); SEAM(PH(l, 3)); } \
    if (IN(PH(l, 4))) { \
        const bf16* W = ((l) < 2) ? (const bf16*)(ws + WS_WAOUT) + (size_t)(l) * D * D : (const bf16*)(ws + WS_WBOUT) + (size_t)((l) - 2) * D * D; \
        pg8::Gemm g{onb, W, M, D, D}; pg8::StaticOrder S; S.init(M, D, F.G, (int)blockIdx.x); \
        pg8::EpiF32 E{mix, D}; pg8::gemm_phase<pg8::EpiF32, pg8::StaticOrder, true, true>(F.lds, g, S, E, F.wave); SEAM(PH(l, 4)); } \
    if (IN(PH(l, 5))) { const float* hin = ((l) == 0) ? args.in[0] : hbuf; \
        phase_ln1_router(F, hin, mix, args.in[12] + (l) * D, args.in[13] + (l) * D, h1, h1b, (const bf16*)(ws + WS_WR) + (size_t)(l) * 48 * D, eid, gate, counts); SEAM(PH(l, 5)); } \
    if (IN(PH(l, 6))) { phase_scatter(F, counts, cursor, eid, h1b, xrows, apos); SEAM(PH(l, 6)); } \
    if (IN(PH(l, 7))) { const int ntiles = moe_layout(F, counts, psl, tile_e); \
        pg8::Gemm g{xrows, (const bf16*)(ws + WS_W13) + (size_t)(l) * 32 * 1024 * 1024, NROWS2, 1024, 1024}; pg8::MoeOrder S{ntiles * 4, F.G, F.vcu, tile_e}; \
        pg8::EpiSwiGLU E{hid, 512}; pg8::gemm_phase<pg8::EpiSwiGLU, pg8::MoeOrder, true, true>(F.lds, g, S, E, F.wave); SEAM(PH(l, 7)); } \
    if (IN(PH(l, 8))) { const int ntiles = moe_layout(F, counts, psl, tile_e); \
        pg8::Gemm g{hid, (const bf16*)(ws + WS_W2) + (size_t)(l) * 32 * 1024 * 512, NROWS2, 1024, 512}; pg8::MoeOrder S{ntiles * 4, F.G, F.vcu, tile_e}; \
        pg8::EpiBf16G E{yrows, 1024, 3}; pg8::gemm_phase<pg8::EpiBf16G, pg8::MoeOrder, true, true>(F.lds, g, S, E, F.wave); SEAM(PH(l, 8)); } \
    if (IN(PH(l, 9))) { float* hout = ((l) == 3) ? args.out : hbuf; \
        phase_combine_ln2(F, h1, yrows, apos, gate, args.in[14] + (l) * D, args.in[15] + (l) * D, hout, hb); SEAM(PH(l, 9)); } \
    } while (0)
    LAYER(0); LAYER(1); LAYER(2); LAYER(3);
#undef LAYER
#undef IN
#undef SEAM
}

__global__ __launch_bounds__(256) void b2f_k(const unsigned short* __restrict__ src, int lds_, float* __restrict__ dst, int ldd, int cols, float scale) {
    const int row = blockIdx.x; for (int c = threadIdx.x; c < cols; c += 256) dst[(size_t)row * ldd + c] = __uint_as_float((unsigned)src[(size_t)row * lds_ + c] << 16) * scale;
}
__global__ __launch_bounds__(256) void f2b_k(const float* __restrict__ src, int lds_, unsigned short* __restrict__ dst, int ldd, int cols) {
    const int row = blockIdx.x; for (int c = threadIdx.x; c < cols; c += 256) dst[(size_t)row * ldd + c] = (unsigned short)f2bf(src[(size_t)row * lds_ + c]);
}

extern "C" void kernel_launch(void* const* d_in, const int* in_sizes, int n_in, void* d_out, int out_size, void* d_ws, size_t ws_size, hipStream_t stream) {
    static int grid = 0;
    if (grid == 0) {
        int dev = 0, cus = 0;
        if (hipGetDevice(&dev) != hipSuccess || hipDeviceGetAttribute(&cus, hipDeviceAttributeMultiprocessorCount, dev) != hipSuccess) { fprintf(stderr, "kernel_launch: device query failed\n"); grid = -1; return; }
        if (hipFuncSetAttribute((const void*)mega, hipFuncAttributeMaxDynamicSharedMemorySize, LDS_BYTES) != hipSuccess) { fprintf(stderr, "kernel_launch: hipFuncSetAttribute failed\n"); grid = -1; return; }
        int per_cu = 0; (void)hipOccupancyMaxActiveBlocksPerMultiprocessor(&per_cu, (const void*)mega, NWAVES * 64, LDS_BYTES); (void)hipGetLastError();
        if (per_cu < 1) fprintf(stderr, "kernel_launch: occupancy query says %d blocks per CU\n", per_cu);
        grid = cus;
        if (grid != 256) { fprintf(stderr, "kernel_launch: this kernel is built for a 256-CU device (got %d CUs); nothing launched\n", grid); grid = -1; return; }
    }
    if (grid < 0) return;
    unsigned char* ws = (unsigned char*)d_ws;
    if (WS_DN_END > ws_size) { fprintf(stderr, "kernel_launch: workspace too small: need %zu have %zu\n", (size_t)WS_DN_END, ws_size); return; }
    (void)hipMemsetAsync(ws + WS_CTL, 0, CTL_ZERO_BYTES, stream);
    Args a{};
    for (int i = 0; i < 20; ++i) a.in[i] = (const float*)d_in[i];
    a.out = (float*)d_out; a.ws = ws; a.lam_init[0] = (float)(0.8 - 0.6 * exp(-0.3 * 2.0)); a.lam_init[1] = (float)(0.8 - 0.6 * exp(-0.3 * 3.0));
    int nlaunch = 0;
    auto mk = [&](int lo, int hi) { a.ph_lo = lo; a.ph_hi = hi; a.bar_region = nlaunch++; hipLaunchKernelGGL(mega, dim3(grid), dim3(NWAVES * 64), LDS_BYTES, stream, a); };
#ifndef MULTI_LAUNCH
    mk(0, PH(3, 9) + 1);
#else
    mk(0, 1);
    for (int l = 0; l < 4; ++l) mk(PH(l, 0), PH(l, 9) + 1);
#endif
}
```

```cpp
#include <hip/hip_runtime.h>
#include <stdint.h>
#include <stdio.h>
#include <math.h>
#include <cstdint>
namespace pg8 {
#define PG8_LAS __attribute__((address_space(3)))
typedef unsigned short bf16_t;
typedef short bf16x8 __attribute__((ext_vector_type(8)));
typedef float f32x4 __attribute__((ext_vector_type(4)));
typedef unsigned u32x4 __attribute__((ext_vector_type(4)));
constexpr int BM = 256, BK = 64, HALF = 128, HTB = HALF * BK * 2  , STAGE_BYTES = 8 * HTB, NXCD = 8, WGM = 8;

__host__ __device__ __forceinline__ int lds_byte(int r, int c) { const int st = (r >> 4) * 2 + (c >> 5), rr = r & 15, cc = c & 31, ob = rr * 64 + cc * 2; return st * 1024 + (ob ^ (((ob >> 9) & 1) << 5)); }
__host__ __device__ __forceinline__ void stage_rc(int b, int& R, int& C) { const int st = b / 1024, sb = b % 1024, swz = sb ^ (((sb >> 9) & 1) << 5); R = (st >> 1) * 16 + swz / 64; C = (st & 1) * 32 + (swz % 64) / 2; }
__host__ __device__ __forceinline__ int perm32(int rho) { const int n = rho >> 4, i = rho & 15; return 8 * (i >> 2) + 4 * n + (i & 3); }

struct Unit { int pm, pn; };
struct Gemm { const bf16_t* A; const bf16_t* Bt; int M, N, K; };

struct StaticOrder {
    int nM, nN, nwg, G, c;
    __host__ __device__ void init(int M, int N, int G_, int c_) { nM = M / BM; nN = N / BM; nwg = nM * nN; G = G_; c = c_; }
    __host__ __device__ bool next(int i, Unit& u) const {
        const long L = (long)i * G + c; if (L >= nwg) return false;
        int wgid = (int)L; { const int q = nwg / NXCD, r = nwg % NXCD, xcd = wgid % NXCD, off = wgid / NXCD; wgid = (xcd < r ? xcd * (q + 1) : r * (q + 1) + (xcd - r) * q) + off; }
        const int nig = WGM * nN, gid = wgid / nig, fm = gid * WGM, gsz = (nM - fm) < WGM ? (nM - fm) : WGM;
        u.pm = fm + ((wgid % nig) % gsz); u.pn = (wgid % nig) / gsz; return true;
    }
    __device__ __forceinline__ void a_ready(const Unit&) const {}
    __device__ __forceinline__ void done(const Unit&) const {}
};

__device__ __forceinline__ unsigned cvt_pk_bf16(float lo, float hi) { unsigned r; asm volatile("v_cvt_pk_bf16_f32 %0, %1, %2" : "=v"(r) : "v"(lo), "v"(hi)); return r; }
typedef float f32x2 __attribute__((ext_vector_type(2)));
__device__ __forceinline__ f32x2 gelu_pk(f32x2 v) {
    const f32x2 av = __builtin_elementwise_abs(v), d = av * 0.2316418882f + 1.0f;
    f32x2 t; t.x = __builtin_amdgcn_rcpf(d.x); t.y = __builtin_amdgcn_rcpf(d.y);
    f32x2 q = t * 0.5307027145f + (-0.7265760135f); q = q * t + 0.7107068705f; q = q * t + (-0.142248368f); q = q * t + 0.127414796f; q = q * t;
    const f32x2 s = (v * v) * (-0.72134752044f);
    f32x2 e; e.x = __builtin_amdgcn_exp2f(s.x); e.y = __builtin_amdgcn_exp2f(s.y);
    const f32x2 m = v * (q * e), r = v - m;
    f32x2 o; o.x = v.x < 0.f ? m.x : r.x; o.y = v.y < 0.f ? m.y : r.y; return o;
}

template <int ACT  > struct EpiBf16 {
    static constexpr bool PERM = true, AFTER_DRAIN = false; static_assert(ACT == 0 || ACT == 1, "EpiBf16: ACT is 0 (none) or 1 (gelu_pk)");
    bf16_t* O; int ldc; const float* bias; int split_cols; size_t split_stride; float scale0;
    __device__ __forceinline__ void operator()(const f32x4 (&acc)[2][2][4][2], const Unit& u, int wr, int wc, int fr, int fq) const {
        const int row0 = u.pm * BM + wr * 64 + fr; int colt = u.pn * BM; bf16_t* base = O;
        float sc = 1.f; if (split_cols) { const int t = colt / split_cols; base += (size_t)t * split_stride; colt -= t * split_cols; if (t == 0) sc = scale0; }
        const int col0 = colt + wc * 32 + 8 * fq, bcol0 = u.pn * BM + wc * 32 + 8 * fq;
        f32x4 bv[2][2];
#pragma unroll
        for (int bj = 0; bj < 2; ++bj)
#pragma unroll
            for (int n = 0; n < 2; ++n) bv[bj][n] = bias ? *(const f32x4*)(bias + bcol0 + bj * HALF + 4 * n) : (f32x4){0.f, 0.f, 0.f, 0.f};
#pragma unroll
        for (int ai = 0; ai < 2; ++ai)
#pragma unroll
            for (int m = 0; m < 4; ++m) { bf16_t* rowp = base + (size_t)(row0 + ai * HALF + m * 16) * ldc + col0;
#pragma unroll
                for (int bj = 0; bj < 2; ++bj) { f32x4 v0 = acc[ai][bj][m][0] + bv[bj][0], v1 = acc[ai][bj][m][1] + bv[bj][1];
                    if (ACT == 1) { f32x2 a = gelu_pk((f32x2){v0[0], v0[1]}), b = gelu_pk((f32x2){v0[2], v0[3]}), c = gelu_pk((f32x2){v1[0], v1[1]}), d = gelu_pk((f32x2){v1[2], v1[3]});
                        v0 = (f32x4){a.x, a.y, b.x, b.y}; v1 = (f32x4){c.x, c.y, d.x, d.y}; }
                    v0 = v0 * sc; v1 = v1 * sc; u32x4 w; w.x = cvt_pk_bf16(v0[0], v0[1]); w.y = cvt_pk_bf16(v0[2], v0[3]); w.z = cvt_pk_bf16(v1[0], v1[1]); w.w = cvt_pk_bf16(v1[2], v1[3]);
                    *(u32x4*)(rowp + bj * HALF) = w; } }
    }
};

struct PanelStats {
    unsigned* xbuf;
    unsigned* cnt;
    unsigned* tmo;
    int ntn; float eps;
    unsigned code;
    __device__ __forceinline__ bool run(const f32x4 (&v)[2][2][4][2], const Unit& u, int wr, int wc, int fr, int fq, PG8_LAS unsigned char* lds, int wid, int lane) const {
        typedef float f32x2v __attribute__((ext_vector_type(2)));
        PG8_LAS f32x2v* P = (PG8_LAS f32x2v*)lds;
        PG8_LAS f32x2v* S = (PG8_LAS f32x2v*)(lds + 8192);
        PG8_LAS unsigned* flag = (PG8_LAS unsigned*)(lds + 8192 + 2048);
#pragma unroll
        for (int ai = 0; ai < 2; ++ai)
#pragma unroll
            for (int m = 0; m < 4; ++m) {
                float s = 0.f;
#pragma unroll
                for (int bj = 0; bj < 2; ++bj)
#pragma unroll
                    for (int n = 0; n < 2; ++n) { const f32x4 x = v[ai][bj][m][n]; s += (x[0] + x[1]) + (x[2] + x[3]); }
                s += __shfl_xor(s, 16); s += __shfl_xor(s, 32);
                const float mw = s * (1.0f / 64.0f); float q = 0.f;
#pragma unroll
                for (int bj = 0; bj < 2; ++bj)
#pragma unroll
                    for (int n = 0; n < 2; ++n) { const f32x4 d = v[ai][bj][m][n] - mw; q += (d[0] * d[0] + d[1] * d[1]) + (d[2] * d[2] + d[3] * d[3]); }
                q += __shfl_xor(q, 16); q += __shfl_xor(q, 32);
                if (fq == 0) P[(ai * HALF + wr * 64 + m * 16 + fr) * 4 + wc] = (f32x2v){mw, q};
            }
        asm volatile("s_waitcnt lgkmcnt(0)" ::: "memory"); __builtin_amdgcn_s_barrier(); asm volatile("" ::: "memory");
#if defined(BROKEN_EXCHANGE_NO_WAIT)
#warning BROKEN CONTROL BUILD: the row-statistics exchange does not wait; results are wrong by design
        if (blockIdx.x >= 64) { const long long t0_ = clock64(); while (clock64() - t0_ < 60000) __builtin_amdgcn_s_sleep(8); }
#endif
        const int row = wid * 32 + (lane & 31);
        if (lane < 32) {
            const f32x2v a = P[row * 4 + 0], b = P[row * 4 + 1], c = P[row * 4 + 2], d = P[row * 4 + 3];
            const float mt = (a.x + b.x + c.x + d.x) * 0.25f;
            const float da = a.x - mt, db = b.x - mt, dc = c.x - mt, dd = d.x - mt;
            const float m2 = (a.y + b.y) + (c.y + d.y) + 64.0f * ((da * da + db * db) + (dc * dc + dd * dd));
            unsigned long long* slot = (unsigned long long*)xbuf + ((size_t)(u.pm * BM + row) * 4 + u.pn);
            __hip_atomic_store(slot, ((unsigned long long)__float_as_uint(m2) << 32) | __float_as_uint(mt), __ATOMIC_RELAXED, __HIP_MEMORY_SCOPE_AGENT);
        }
        asm volatile("s_waitcnt vmcnt(0)" ::: "memory");
        if (lane == 0) __hip_atomic_fetch_add(cnt + 64 * u.pm, 1u, __ATOMIC_RELAXED, __HIP_MEMORY_SCOPE_AGENT);
        if (wid == 0) {
            bool dead = false; const unsigned long long t0 = __builtin_amdgcn_s_memrealtime(); const unsigned want = 8u * (unsigned)ntn;
            for (;;) {
#if defined(BROKEN_EXCHANGE_NO_WAIT)
                break;
#endif
                if ((unsigned)__builtin_amdgcn_readfirstlane(__hip_atomic_load(cnt + 64 * u.pm, __ATOMIC_RELAXED, __HIP_MEMORY_SCOPE_AGENT)) >= want) break;
                if (__builtin_amdgcn_s_memrealtime() - t0 > 2000000ull) {
                    if (lane == 0) { unsigned expect = 0u; __hip_atomic_compare_exchange_strong(tmo + 1, &expect, code | (unsigned)(u.pm & 0xff), __ATOMIC_RELAXED, __ATOMIC_RELAXED, __HIP_MEMORY_SCOPE_AGENT);
                                     __hip_atomic_store(tmo, 1u, __ATOMIC_RELAXED, __HIP_MEMORY_SCOPE_AGENT); }
                    dead = true; break; }
                __builtin_amdgcn_s_sleep(2);
            }
            __builtin_amdgcn_fence(__ATOMIC_ACQUIRE, "agent");
            if (lane == 0) flag[0] = dead ? 1u : 0u;
        }
        asm volatile("s_waitcnt vmcnt(0) lgkmcnt(0)" ::: "memory"); __builtin_amdgcn_s_barrier(); asm volatile("" ::: "memory");
        const bool bad = flag[0] != 0u;
        if (lane < 32) {
            const unsigned long long* slot = (const unsigned long long*)xbuf + (size_t)(u.pm * BM + row) * 4; float mt[4], m2[4]; float ms = 0.f;
#pragma unroll
            for (int t = 0; t < 4; ++t) { if (t < ntn) { const unsigned long long w = __hip_atomic_load(slot + t, __ATOMIC_RELAXED, __HIP_MEMORY_SCOPE_AGENT); mt[t] = __uint_as_float((unsigned)w); m2[t] = __uint_as_float((unsigned)(w >> 32)); } else { mt[t] = 0.f; m2[t] = 0.f; } ms += mt[t]; }
            const float mean = ms / (float)ntn; float q = 0.f;
#pragma unroll
            for (int t = 0; t < 4; ++t) if (t < ntn) { const float dm = mt[t] - mean; q += m2[t] + 256.0f * dm * dm; }
            S[row] = (f32x2v){mean, 1.0f / sqrtf(q / (256.0f * (float)ntn) + eps)};
        }
        asm volatile("s_waitcnt lgkmcnt(0)" ::: "memory"); __builtin_amdgcn_s_barrier(); asm volatile("" ::: "memory");
        return bad;
    }
};
struct EpiLnRes {
    static constexpr bool PERM = false, AFTER_DRAIN = true;
    const float* base; float* out; int ldc; const float* bias; PanelStats st; unsigned poison;
    __device__ __forceinline__ void fused(f32x4 (&acc)[2][2][4][2], const Unit& u, int wr, int wc, int fr, int fq, PG8_LAS unsigned char* lds, int wid, int lane) const {
        typedef float f32x2v __attribute__((ext_vector_type(2)));
        const PG8_LAS f32x2v* S = (const PG8_LAS f32x2v*)(lds + 8192);
        const int col0 = u.pn * BM + wc * 32 + 4 * fq;
#pragma unroll
        for (int bj = 0; bj < 2; ++bj)
#pragma unroll
            for (int n = 0; n < 2; ++n) { const f32x4 bv = bias ? *(const f32x4*)(bias + col0 + bj * HALF + n * 16) : (f32x4){0.f, 0.f, 0.f, 0.f};
#pragma unroll
                for (int ai = 0; ai < 2; ++ai)
#pragma unroll
                    for (int m = 0; m < 4; ++m) acc[ai][bj][m][n] += bv; }
        f32x4 pre[4][2][2];
#pragma unroll
        for (int m = 0; m < 4; ++m) { const size_t off = (size_t)(u.pm * BM + wr * 64 + m * 16 + fr) * ldc + col0;
#pragma unroll
            for (int bj = 0; bj < 2; ++bj)
#pragma unroll
                for (int n = 0; n < 2; ++n) pre[m][bj][n] = *(const f32x4*)(base + off + bj * HALF + n * 16); }
        const bool bad = st.run(acc, u, wr, wc, fr, fq, lds, wid, lane) || poison != 0u;
        const float qnan = __builtin_nanf("");
#pragma unroll
        for (int ai = 0; ai < 2; ++ai)
#pragma unroll
            for (int m = 0; m < 4; ++m) { const int r = ai * HALF + wr * 64 + m * 16 + fr; const f32x2v sr = S[r]; const size_t off = (size_t)(u.pm * BM + r) * ldc + col0;
#pragma unroll
                for (int bj = 0; bj < 2; ++bj)
#pragma unroll
                    for (int n = 0; n < 2; ++n) { const f32x4 bs = ai == 0 ? pre[m][bj][n] : *(const f32x4*)(base + off + bj * HALF + n * 16); f32x4 o = bs + (acc[ai][bj][m][n] - sr.x) * sr.y;
                        if (bad) o = (f32x4){qnan, qnan, qnan, qnan}; *(f32x4*)(out + off + bj * HALF + n * 16) = o; }
                if (m & 1) asm volatile("" ::: "memory"); }
    }
};
struct EpiLnResLn {
    static constexpr bool PERM = false, AFTER_DRAIN = true;
    const float* base; float* out; bf16_t* xn; int ldc; const float* bias; PanelStats st1, st2; unsigned poison;
    __device__ __forceinline__ void fused(f32x4 (&acc)[2][2][4][2], const Unit& u, int wr, int wc, int fr, int fq, PG8_LAS unsigned char* lds, int wid, int lane) const {
        typedef float f32x2v __attribute__((ext_vector_type(2))); typedef unsigned u32x2v __attribute__((ext_vector_type(2)));
        const PG8_LAS f32x2v* S = (const PG8_LAS f32x2v*)(lds + 8192);
        const int col0 = u.pn * BM + wc * 32 + 4 * fq;
#pragma unroll
        for (int bj = 0; bj < 2; ++bj)
#pragma unroll
            for (int n = 0; n < 2; ++n) { const f32x4 bv = bias ? *(const f32x4*)(bias + col0 + bj * HALF + n * 16) : (f32x4){0.f, 0.f, 0.f, 0.f};
#pragma unroll
                for (int ai = 0; ai < 2; ++ai)
#pragma unroll
                    for (int m = 0; m < 4; ++m) acc[ai][bj][m][n] += bv; }
        bool bad = st1.run(acc, u, wr, wc, fr, fq, lds, wid, lane) || poison != 0u;
        const float qnan = __builtin_nanf("");
#pragma unroll
        for (int ai = 0; ai < 2; ++ai)
#pragma unroll
            for (int m = 0; m < 4; ++m) { const int r = ai * HALF + wr * 64 + m * 16 + fr; const f32x2v sr = S[r]; const size_t off = (size_t)(u.pm * BM + r) * ldc + col0;
#pragma unroll
                for (int bj = 0; bj < 2; ++bj)
#pragma unroll
                    for (int n = 0; n < 2; ++n) { const f32x4 bs = *(const f32x4*)(base + off + bj * HALF + n * 16); acc[ai][bj][m][n] = bs + (acc[ai][bj][m][n] - sr.x) * sr.y; }
                asm volatile("" : "+v"(acc[ai][0][m][0]), "+v"(acc[ai][0][m][1]), "+v"(acc[ai][1][m][0]), "+v"(acc[ai][1][m][1]));
                if (m & 1) asm volatile("" ::: "memory"); }
        const bool bad1 = bad;
        bad = st2.run(acc, u, wr, wc, fr, fq, lds, wid, lane) || bad;
#pragma unroll
        for (int ai = 0; ai < 2; ++ai)
#pragma unroll
            for (int m = 0; m < 4; ++m) { const int r = ai * HALF + wr * 64 + m * 16 + fr; const f32x2v sr = S[r]; const size_t off = (size_t)(u.pm * BM + r) * ldc + col0;
#pragma unroll
                for (int bj = 0; bj < 2; ++bj)
#pragma unroll
                    for (int n = 0; n < 2; ++n) { const f32x4 x1 = acc[ai][bj][m][n]; *(f32x4*)(out + off + bj * HALF + n * 16) = bad1 ? (f32x4){qnan, qnan, qnan, qnan} : x1;
                        const f32x4 o = (x1 - sr.x) * sr.y; u32x2v w; w.x = cvt_pk_bf16(o[0], o[1]); w.y = cvt_pk_bf16(o[2], o[3]);
                        if (bad) { w.x = 0x7fc07fc0u; w.y = 0x7fc07fc0u; } *(u32x2v*)(xn + off + bj * HALF + n * 16) = w; }
                asm volatile("" ::: "memory"); }
    }
};

template <class Epi, class Sched, bool ALIGN_EPI = false, bool SP2 = false>
__device__ __forceinline__ void gemm_phase(PG8_LAS unsigned char* lds, const Gemm g, const Sched& S, const Epi& E, const int wave_id) {
    int tid_ = wave_id * 64 + (int)__builtin_amdgcn_mbcnt_hi(~0u, __builtin_amdgcn_mbcnt_lo(~0u, 0u)); asm volatile("" : "+v"(tid_));
    const int tid = tid_, wid = __builtin_amdgcn_readfirstlane(tid >> 6), lane = tid & 63, wr = wid >> 2, wc = wid & 3, fr = lane & 15, fq = lane >> 4;
    const int K = g.K, nt = K / BK;
    unsigned voffA[2], voffB[2];
#pragma unroll
    for (int i = 0; i < 2; ++i) { int R, C; stage_rc(tid * 16 + i * 8192, R, C); const int Rb = Epi::PERM ? ((R & ~31) + perm32(R & 31)) : R;
        voffA[i] = (unsigned)(R * K + C) * 2u; voffB[i] = (unsigned)(Rb * K + C) * 2u; }
    const size_t kstep = (size_t)(BK * 2);
    const size_t hstep = (size_t)HALF * K * 2;
    const size_t tstep = 2 * hstep;
    const unsigned ldsw = (unsigned)wid * 1024u;
    const int aoff = lds_byte(wr * 64 + fr, fq * 8), boff = lds_byte(wc * 32 + fr, fq * 8);
#define PG8_SA(b, h) (((b) * 2 + (h)) * HTB)
#define PG8_SB(b, h) ((4 + (b) * 2 + (h)) * HTB)
#define PG8_STAGE(bufoff, gbase, voff) do { _Pragma("unroll") for (int _i = 0; _i < 2; ++_i) \
        __builtin_amdgcn_global_load_lds((const unsigned*)((const char*)(gbase) + (voff)[_i]), (PG8_LAS unsigned*)(lds + (bufoff) + ldsw + _i * 8192), 16, 0, 0); } while (0)
#define PG8_LDA(dst, b, h) do { _Pragma("unroll") for (int m = 0; m < 4; ++m) _Pragma("unroll") for (int k = 0; k < 2; ++k) dst[m][k] = *(const PG8_LAS bf16x8*)(lds + PG8_SA(b, h) + aoff + m * 2048 + k * 1024); } while (0)
#define PG8_LDB(dst, b, h) do { _Pragma("unroll") for (int n = 0; n < 2; ++n) _Pragma("unroll") for (int k = 0; k < 2; ++k) dst[n][k] = *(const PG8_LAS bf16x8*)(lds + PG8_SB(b, h) + boff + n * 2048 + k * 1024); } while (0)
#define PG8_MMA(ai, bj, At, Bt) do { __builtin_amdgcn_s_setprio(1); _Pragma("unroll") for (int m = 0; m < 4; ++m) _Pragma("unroll") for (int n = 0; n < 2; ++n) _Pragma("unroll") for (int k = 0; k < 2; ++k) \
        acc[ai][bj][m][n] = __builtin_amdgcn_mfma_f32_16x16x32_bf16(Bt[n][k], At[m][k], acc[ai][bj][m][n], 0, 0, 0); __builtin_amdgcn_s_setprio(0); } while (0)
#define PG8_WAIT_V(n) asm volatile("s_waitcnt vmcnt(" #n ")" ::: "memory")
#define PG8_WAIT_L(n) asm volatile("s_waitcnt lgkmcnt(" #n ")" ::: "memory")
#define PG8_BAR __builtin_amdgcn_s_barrier()
#define PG8_SCHED __builtin_amdgcn_sched_barrier(0)
    Unit cur, nxt; int ui = 0;
    if (!S.next(0, cur)) return;
    f32x4 acc[2][2][4][2];
#pragma unroll
    for (int a = 0; a < 2; ++a)
#pragma unroll
        for (int b = 0; b < 2; ++b)
#pragma unroll
            for (int m = 0; m < 4; ++m)
#pragma unroll
                for (int n = 0; n < 2; ++n) acc[a][b][m][n] = (f32x4){0.f, 0.f, 0.f, 0.f};
    bf16x8 At[4][2], B0[2][2], B1[2][2];
    const char* cA = (const char*)g.A + (size_t)cur.pm * tstep; const char* cB = (const char*)g.Bt + (size_t)cur.pn * tstep;
    S.a_ready(cur);
    if constexpr (SP2) {
        PG8_STAGE(PG8_SB(0, 0), cB, voffB); PG8_STAGE(PG8_SB(0, 1), cB + hstep, voffB); PG8_STAGE(PG8_SA(0, 0), cA, voffA); PG8_STAGE(PG8_SA(0, 1), cA + hstep, voffA);
        if (wr == 1) PG8_BAR;
        PG8_WAIT_V(2); PG8_BAR;
        PG8_STAGE(PG8_SB(1, 0), cB + kstep, voffB); PG8_STAGE(PG8_SA(1, 0), cA + kstep, voffA); PG8_STAGE(PG8_SB(1, 1), cB + hstep + kstep, voffB);
        PG8_WAIT_V(6); PG8_BAR;
    } else {
        PG8_STAGE(PG8_SB(0, 0), cB, voffB); PG8_STAGE(PG8_SA(0, 0), cA, voffA); PG8_STAGE(PG8_SB(0, 1), cB + hstep, voffB); PG8_STAGE(PG8_SA(0, 1), cA + hstep, voffA);
        if (wr == 1) PG8_BAR;
        PG8_WAIT_V(4); PG8_BAR;
        PG8_STAGE(PG8_SB(1, 0), cB + kstep, voffB); PG8_STAGE(PG8_SA(1, 0), cA + kstep, voffA); PG8_STAGE(PG8_SB(1, 1), cB + hstep + kstep, voffB);
        PG8_WAIT_V(6); PG8_BAR;
    }
    for (;;) {
        const bool has_next = S.next(ui + 1, nxt);
        const char* nA = has_next ? (const char*)g.A + (size_t)nxt.pm * tstep : cA; const char* nB = has_next ? (const char*)g.Bt + (size_t)nxt.pn * tstep : cB;
        for (int t = 0; t < nt; t += 2) {
            const bool last = (t == nt - 2);
            const char* a1 = cA + (size_t)(t + 1) * kstep;
            const char* a2 = last ? nA : cA + (size_t)(t + 2) * kstep; const char* b2 = last ? nB : cB + (size_t)(t + 2) * kstep;
            const char* a3 = a2 + kstep; const char* b3 = b2 + kstep;
            if (last && has_next) S.a_ready(nxt);
            if constexpr (SP2) {
            PG8_LDB(B0, 0, 0); PG8_LDB(B1, 0, 1); PG8_SCHED; PG8_LDA(At, 0, 0); PG8_STAGE(PG8_SA(1, 1), a1 + hstep, voffA);
            PG8_WAIT_V(8); PG8_WAIT_L(0); PG8_BAR; PG8_MMA(0, 0, At, B0); PG8_MMA(0, 1, At, B1); PG8_BAR; PG8_SCHED;
            PG8_LDA(At, 0, 1); PG8_STAGE(PG8_SB(0, 0), b2, voffB); PG8_STAGE(PG8_SB(0, 1), b2 + hstep, voffB); PG8_STAGE(PG8_SA(0, 0), a2, voffA);
            PG8_WAIT_V(8); PG8_WAIT_L(0); PG8_BAR; PG8_MMA(1, 0, At, B0); PG8_MMA(1, 1, At, B1); PG8_BAR; PG8_SCHED;
            PG8_LDB(B0, 1, 0); PG8_LDB(B1, 1, 1); PG8_SCHED; PG8_LDA(At, 1, 0); PG8_STAGE(PG8_SA(0, 1), a2 + hstep, voffA);
            PG8_WAIT_V(8); PG8_WAIT_L(0); PG8_BAR; PG8_MMA(0, 0, At, B0); PG8_MMA(0, 1, At, B1); PG8_BAR; PG8_SCHED;
            PG8_LDA(At, 1, 1); PG8_STAGE(PG8_SB(1, 0), b3, voffB); PG8_STAGE(PG8_SB(1, 1), b3 + hstep, voffB); PG8_STAGE(PG8_SA(1, 0), a3, voffA);
            PG8_WAIT_V(8); PG8_WAIT_L(0); PG8_BAR; PG8_MMA(1, 0, At, B0); PG8_MMA(1, 1, At, B1); PG8_BAR; PG8_SCHED;
            } else {
            PG8_LDB(B0, 0, 0); PG8_SCHED; PG8_LDA(At, 0, 0); PG8_STAGE(PG8_SA(1, 1), a1 + hstep, voffA);
            PG8_WAIT_L(8); PG8_BAR; PG8_WAIT_L(0); PG8_MMA(0, 0, At, B0); PG8_BAR; PG8_SCHED;
            PG8_LDB(B1, 0, 1); PG8_STAGE(PG8_SB(0, 0), b2, voffB);
            PG8_BAR; PG8_WAIT_L(0); PG8_MMA(0, 1, At, B1); PG8_BAR;
            PG8_LDA(At, 0, 1); PG8_STAGE(PG8_SA(0, 0), a2, voffA);
            PG8_BAR; PG8_WAIT_L(0); PG8_MMA(1, 0, At, B0); PG8_BAR; PG8_SCHED;
            PG8_STAGE(PG8_SB(0, 1), b2 + hstep, voffB);
            PG8_WAIT_V(6); PG8_BAR; PG8_MMA(1, 1, At, B1); PG8_BAR;
            PG8_LDB(B0, 1, 0); PG8_SCHED; PG8_LDA(At, 1, 0); PG8_STAGE(PG8_SA(0, 1), a2 + hstep, voffA);
            PG8_WAIT_L(8); PG8_BAR; PG8_WAIT_L(0); PG8_MMA(0, 0, At, B0); PG8_BAR; PG8_SCHED;
            PG8_LDB(B1, 1, 1); PG8_STAGE(PG8_SB(1, 0), b3, voffB);
            PG8_BAR; PG8_WAIT_L(0); PG8_MMA(0, 1, At, B1); PG8_BAR;
            PG8_LDA(At, 1, 1); PG8_STAGE(PG8_SA(1, 0), a3, voffA);
            PG8_BAR; PG8_WAIT_L(0); PG8_MMA(1, 0, At, B0); PG8_BAR; PG8_SCHED;
            PG8_STAGE(PG8_SB(1, 1), b3 + hstep, voffB);
            PG8_WAIT_V(6); PG8_BAR; PG8_MMA(1, 1, At, B1); PG8_BAR;
            }
        }
        if constexpr (ALIGN_EPI) { if (wr == 0) PG8_BAR; }
        if constexpr (!Epi::AFTER_DRAIN) { E(acc, cur, wr, wc, fr, fq); S.done(cur); }
        if (!has_next) break;
#pragma unroll
        for (int a = 0; a < 2; ++a)
#pragma unroll
            for (int b = 0; b < 2; ++b)
#pragma unroll
                for (int m = 0; m < 4; ++m)
#pragma unroll
                    for (int n = 0; n < 2; ++n) acc[a][b][m][n] = (f32x4){0.f, 0.f, 0.f, 0.f};
        cur = nxt; cA = nA; cB = nB; ++ui;
        if constexpr (ALIGN_EPI) { if (wr == 1) PG8_BAR; }
    }
    PG8_WAIT_V(0);
    if constexpr (!ALIGN_EPI) { if (wr == 0) PG8_BAR; }
    PG8_BAR;
    if constexpr (Epi::AFTER_DRAIN) { E.fused(acc, cur, wr, wc, fr, fq, lds, wid, lane); S.done(cur); }
#undef PG8_SA
#undef PG8_SB
#undef PG8_STAGE
#undef PG8_LDA
#undef PG8_LDB
#undef PG8_MMA
#undef PG8_WAIT_V
#undef PG8_WAIT_L
#undef PG8_BAR
#undef PG8_SCHED
}
}
namespace pg8 {
struct EpiF32 {
    static constexpr bool PERM = false, AFTER_DRAIN = false;
    float* C; int ldc;
    __device__ __forceinline__ void operator()(const f32x4 (&acc)[2][2][4][2], const Unit& u, int wr, int wc, int fr, int fq) const {
        const int row0 = u.pm * BM + wr * 64 + fr, col0 = u.pn * BM + wc * 32 + 4 * fq;
#pragma unroll
        for (int ai = 0; ai < 2; ++ai)
#pragma unroll
            for (int m = 0; m < 4; ++m) { float* rowp = C + (size_t)(row0 + ai * HALF + m * 16) * ldc + col0;
#pragma unroll
                for (int bj = 0; bj < 2; ++bj)
#pragma unroll
                    for (int n = 0; n < 2; ++n) *(f32x4*)(rowp + bj * HALF + n * 16) = acc[ai][bj][m][n]; }
    }
};
struct EpiBf16G {
    static constexpr bool PERM = true, AFTER_DRAIN = false;
    bf16_t* O; int ldc; int pnmask;
    __device__ __forceinline__ void operator()(const f32x4 (&acc)[2][2][4][2], const Unit& u, int wr, int wc, int fr, int fq) const {
        const int row0 = u.pm * BM + wr * 64 + fr, col0 = (u.pn & pnmask) * BM + wc * 32 + 8 * fq;
#pragma unroll
        for (int ai = 0; ai < 2; ++ai)
#pragma unroll
            for (int m = 0; m < 4; ++m) { bf16_t* rowp = O + (size_t)(row0 + ai * HALF + m * 16) * ldc + col0;
#pragma unroll
                for (int bj = 0; bj < 2; ++bj) { const f32x4 v0 = acc[ai][bj][m][0], v1 = acc[ai][bj][m][1];
                    u32x4 w; w.x = cvt_pk_bf16(v0[0], v0[1]); w.y = cvt_pk_bf16(v0[2], v0[3]); w.z = cvt_pk_bf16(v1[0], v1[1]); w.w = cvt_pk_bf16(v1[2], v1[3]);
                    *(u32x4*)(rowp + bj * HALF) = w; } }
    }
};
__device__ __forceinline__ float silu_fast(float x) { return x * __builtin_amdgcn_rcpf(1.f + __builtin_amdgcn_exp2f(-1.4426950408889634f * x)); }
struct EpiSwiGLU {
    static constexpr bool PERM = true, AFTER_DRAIN = false;
    bf16_t* O; int ldc;
    __device__ __forceinline__ void operator()(const f32x4 (&acc)[2][2][4][2], const Unit& u, int wr, int wc, int fr, int fq) const {
        const int row0 = u.pm * BM + wr * 64 + fr, col0 = (u.pn & 3) * HALF + wc * 32 + 8 * fq;
#pragma unroll
        for (int ai = 0; ai < 2; ++ai)
#pragma unroll
            for (int m = 0; m < 4; ++m) { bf16_t* rowp = O + (size_t)(row0 + ai * HALF + m * 16) * ldc + col0;
                const f32x4 a0 = acc[ai][0][m][0], a1 = acc[ai][0][m][1], g0 = acc[ai][1][m][0], g1 = acc[ai][1][m][1];
                u32x4 w; w.x = cvt_pk_bf16(silu_fast(a0[0]) * g0[0], silu_fast(a0[1]) * g0[1]); w.y = cvt_pk_bf16(silu_fast(a0[2]) * g0[2], silu_fast(a0[3]) * g0[3]);
                w.z = cvt_pk_bf16(silu_fast(a1[0]) * g1[0], silu_fast(a1[1]) * g1[1]); w.w = cvt_pk_bf16(silu_fast(a1[2]) * g1[2], silu_fast(a1[3]) * g1[3]);
                *(u32x4*)rowp = w; }
    }
};
struct MoeOrder {
    int nunits, G, v; const PG8_LAS int* tile_e;
    __device__ __forceinline__ bool next(int i, Unit& u) const { const int L = i * G + v; if (L >= nunits) return false; const int t = L >> 2; u.pm = t; u.pn = __builtin_amdgcn_readfirstlane(tile_e[t]) * 4 + (L & 3); return true; }
    __device__ __forceinline__ void a_ready(const Unit&) const {}
    __device__ __forceinline__ void done(const Unit&) const {}
};
}
#include <hip/hip_bf16.h>
#include <cmath>
namespace attn_body {
using bf16=__hip_bfloat16;
using bf16x8=__attribute__((ext_vector_type(8)))short;
using s16x4=__attribute__((ext_vector_type(4)))short;
using f32x16=__attribute__((ext_vector_type(16)))float;
using u32x4=__attribute__((ext_vector_type(4)))unsigned;
constexpr int BATCH=2,NHEAD=16,SEQ=8192,D=64,DM=NHEAD*D;
constexpr int NW=8,QBLK=32,QB=QBLK*NW,KVBLK=64,NQB=SEQ/QB;
constexpr int ATTN_PITCH=DM, ATTN_UNIT_ROWS=QB;
__device__ __forceinline__ int crow(int r,int hi){return (r&3)+8*(r>>2)+4*hi;}
#define SBAR() __builtin_amdgcn_sched_barrier(0)
__device__ __forceinline__ void cmask(f32x16&p0,f32x16&p1,int jb,int qrel,int hi){
  const float NEG=-INFINITY; int kb=64*jb+4*hi;
  #pragma unroll
  for(int r=0;r<16;++r){int kv=kb+(r&3)+8*(r>>2); if(kv>qrel)p0[r]=NEG; if(kv+32>qrel)p1[r]=NEG;}
}

constexpr int NSLOT=3, SLOTB=8192;
constexpr int LDS_K=0, LDS_V=NSLOT*SLOTB, LDS_WS=2*NSLOT*SLOTB, LDS_OST=LDS_WS+NW*64*4, LDS_BYTES=LDS_OST+NW*4096;
constexpr float C2=0.125f*1.4426950408889634f;
__device__ __forceinline__ void glds16(const void*gsrc,unsigned lds_dst){unsigned keep;
  asm volatile("s_mov_b32 %0, m0\n\ts_mov_b32 m0, %2\n\ts_nop 0\n\tglobal_load_lds_dwordx4 %1, off\n\ts_mov_b32 m0, %0":"=&s"(keep):"v"(gsrc),"s"(lds_dst):"memory");}
__device__ __forceinline__ float max3f(float a,float b,float c){float r;asm("v_max3_f32 %0, %1, %2, %3":"=v"(r):"v"(a),"v"(b),"v"(c));return r;}
__device__ __forceinline__ float max2f(float a,float b){float r;asm("v_max_f32_e32 %0, %1, %2":"=v"(r):"v"(a),"v"(b));return r;}
__device__ __forceinline__ float fadd_s(float a,float b){float r;asm("v_add_f32_e32 %0, %1, %2":"=v"(r):"v"(a),"v"(b));return r;}
__device__ __forceinline__ float fsub_s(float a,float b){float r;asm("v_sub_f32_e32 %0, %1, %2":"=v"(r):"v"(a),"v"(b));return r;}
typedef float f32x2_t __attribute__((ext_vector_type(2))); typedef __bf16 bf16x2_t __attribute__((ext_vector_type(2)));
__device__ __forceinline__ unsigned cvtpk_s(float lo,float hi){f32x2_t v={lo,hi};bf16x2_t b=__builtin_convertvector(v,bf16x2_t);return __builtin_bit_cast(unsigned,b);}
#define WAIT_BAR(N) asm volatile("s_waitcnt vmcnt(" #N ") lgkmcnt(0)\n\ts_barrier":::"memory")

__device__ __forceinline__ void qkt(f32x16&p0,f32x16&p1,const char*Kslot,const bf16x8*qr,const f32x16&negm,int r32,int hi){
  const char*kb=Kslot+hi*1024+r32*16;
  #pragma unroll
  for(int d0=0;d0<4;++d0){
    const bf16x8 b0=*reinterpret_cast<const bf16x8*>(kb+d0*2048);
    const bf16x8 b1=*reinterpret_cast<const bf16x8*>(kb+d0*2048+512);
    if(d0==0){p0=__builtin_amdgcn_mfma_f32_32x32x16_bf16(b0,qr[0],negm,0,0,0);p1=__builtin_amdgcn_mfma_f32_32x32x16_bf16(b1,qr[0],negm,0,0,0);}
    else{p0=__builtin_amdgcn_mfma_f32_32x32x16_bf16(b0,qr[d0],p0,0,0,0);p1=__builtin_amdgcn_mfma_f32_32x32x16_bf16(b1,qr[d0],p1,0,0,0);}}
}
typedef __attribute__((address_space(3))) const char* lds_cptr;
typedef short v4i16_t __attribute__((ext_vector_type(4)));
__device__ __forceinline__ void kload8(bf16x8*kf,lds_cptr kp){
  kf[0]=*(const __attribute__((address_space(3))) bf16x8*)(kp);      kf[1]=*(const __attribute__((address_space(3))) bf16x8*)(kp+512);
  kf[2]=*(const __attribute__((address_space(3))) bf16x8*)(kp+2048); kf[3]=*(const __attribute__((address_space(3))) bf16x8*)(kp+2560);
  kf[4]=*(const __attribute__((address_space(3))) bf16x8*)(kp+4096); kf[5]=*(const __attribute__((address_space(3))) bf16x8*)(kp+4608);
  kf[6]=*(const __attribute__((address_space(3))) bf16x8*)(kp+6144); kf[7]=*(const __attribute__((address_space(3))) bf16x8*)(kp+6656);
}
__device__ __forceinline__ void kload2(bf16x8*kf,lds_cptr kp,int j){ kf[2*j]=*(const __attribute__((address_space(3))) bf16x8*)(kp+j*2048); kf[2*j+1]=*(const __attribute__((address_space(3))) bf16x8*)(kp+j*2048+512); }
__device__ __forceinline__ s16x4 vtr(lds_cptr p){ return __builtin_bit_cast(s16x4,__builtin_amdgcn_ds_read_tr16_b64_v4i16((__attribute__((address_space(3))) v4i16_t*)p)); }
__device__ __forceinline__ float rowmax(const f32x16&p0,const f32x16&p1){
  float a=max3f(p0[0],p0[1],p1[0]),b=max3f(p0[2],p0[3],p1[1]);a=max3f(a,p1[2],p1[3]);
  #pragma unroll
  for(int r=4;r<16;r+=4){a=max3f(a,p0[r],p0[r+1]);b=max3f(b,p0[r+2],p0[r+3]);a=max3f(a,p1[r],p1[r+1]);b=max3f(b,p1[r+2],p1[r+3]);}
  const float m=max2f(a,b);
  auto rr=__builtin_amdgcn_permlane32_swap(__float_as_uint(m),__float_as_uint(m),false,false);
  return max2f(__uint_as_float(rr[0]),__uint_as_float(rr[1]));
}
__device__ __forceinline__ void pv(f32x16*o,int vb,bf16x8 pa0,bf16x8 pa1,bf16x8 pa2,bf16x8 pa3){
  #pragma unroll
  for(int d0=0;d0<2;++d0){s16x4 lo[4],hi[4];
    #pragma unroll
    for(int ks=0;ks<4;++ks){
      asm volatile("ds_read_b64_tr_b16 %0,%1 offset:%c2":"=&v"(lo[ks]):"v"(vb),"i"(d0*4096+ks*1024):"memory");
      asm volatile("ds_read_b64_tr_b16 %0,%1 offset:%c2":"=&v"(hi[ks]):"v"(vb),"i"(d0*4096+ks*1024+512):"memory");}
    asm volatile("s_waitcnt lgkmcnt(0)":::"memory");SBAR();
    #define PK(k) (bf16x8){lo[k][0],lo[k][1],lo[k][2],lo[k][3],hi[k][0],hi[k][1],hi[k][2],hi[k][3]}
    o[d0]=__builtin_amdgcn_mfma_f32_32x32x16_bf16(pa0,PK(0),o[d0],0,0,0);
    o[d0]=__builtin_amdgcn_mfma_f32_32x32x16_bf16(pa1,PK(1),o[d0],0,0,0);
    o[d0]=__builtin_amdgcn_mfma_f32_32x32x16_bf16(pa2,PK(2),o[d0],0,0,0);
    o[d0]=__builtin_amdgcn_mfma_f32_32x32x16_bf16(pa3,PK(3),o[d0],0,0,0);
    #undef PK
  }
}

#ifndef ATTN_STORE16
#define ATTN_STORE16(p,v) (*(u32x4*)(p)=(v))
#endif
template<int THRL> __device__ __forceinline__ void attn_unit(int b,int h,int hv,int qb,const bf16*Q,const bf16*__restrict__ K,const bf16*__restrict__ V,bf16*O,char*shm,const int wave_id){
  int tid_=wave_id*64+(int)__builtin_amdgcn_mbcnt_hi(~0u,__builtin_amdgcn_mbcnt_lo(~0u,0u)); asm volatile("":"+v"(tid_)); const int tid=tid_,lane=tid&63,r32=lane&31,hi=lane>>5; const int wid=__builtin_amdgcn_readfirstlane(tid>>6);
  const long rowbase=(long)b*SEQ; const int q0=qb*QB;
  const bf16*Qw=Q+(rowbase+q0+wid*QBLK)*DM+h*D;
  const bf16*Kh=K+rowbase*DM+h*D,*Vh=V+rowbase*DM+hv*D;
  const unsigned lds0=(unsigned)(uintptr_t)shm;
  float*wsf=(float*)(shm+LDS_WS)+wid*64;
  const bf16*ksrc=Kh+(long)lane*DM+wid*8;
  const bf16*vsrc=Vh+(long)(16*(wid&3)+(lane>>2))*DM+(wid>>2)*32+(lane&3)*8;
  const unsigned kdst=lds0+LDS_K+wid*1024, vdst=lds0+LDS_V+wid*1024;
  #define DMA_K(t,slot) glds16(ksrc+(long)(t)*KVBLK*DM,(unsigned)__builtin_amdgcn_readfirstlane(kdst+(slot)))
  #define DMA_V(t,slot) glds16(vsrc+(long)(t)*KVBLK*DM,(unsigned)__builtin_amdgcn_readfirstlane(vdst+(slot)))
  const int vb0=(int)(lds0+LDS_V)+((lane>>4)&1)*32+(lane&3)*8+(4*hi+((lane&15)>>2))*64;
  const char*Kbase=shm+LDS_K; bf16x8 kf[8];
  const lds_cptr shm3=(lds_cptr)shm; const lds_cptr kp0=shm3+LDS_K+hi*1024+r32*16; const lds_cptr vp0=shm3+LDS_V+((lane>>4)&1)*32+(lane&3)*8+(4*hi+((lane&15)>>2))*64;
  const int NT=(q0+QB)/KVBLK;
  DMA_K(0,0);DMA_V(0,0);DMA_K(1,SLOTB);
  bf16x8 qr[4];
  #pragma unroll
  for(int d0=0;d0<4;++d0)qr[d0]=*reinterpret_cast<const bf16x8*>(&Qw[(long)r32*DM+d0*16+hi*8]);
  float mhat=0.f,l_reg=0.f;f32x16 o[2];o[0]=f32x16{};o[1]=f32x16{};f32x16 negm=f32x16{};asm volatile("":"+v"(negm));
  const int qrel=wid*QBLK+r32;
  #define CMASK(P0,P1,t) do{int jb_=(t)-(NT-4); if(jb_>=0)cmask(P0,P1,jb_,qrel,hi);}while(0)
  bool resc=false;
  #define START(P0,P1) do{ const float rm=rowmax(P0,P1); resc=false; \
    { const float dl=rm; mhat=fadd_s(mhat,dl); \
      _Pragma("unroll") for(int r=0;r<16;++r){P0[r]=fsub_s(P0[r],dl);P1[r]=fsub_s(P1[r],dl);} \
      _Pragma("unroll") for(int r=0;r<16;++r)negm[r]=-mhat; asm volatile("":"+v"(negm)); } \
    _Pragma("unroll") for(int r=0;r<16;++r)P0[r]=__builtin_amdgcn_exp2f(P0[r]); }while(0)
  #define RESC() do{ if(resc){ asm volatile("s_waitcnt lgkmcnt(0)":::"memory"); \
      _Pragma("unroll") for(int d_=0;d_<2;++d_) _Pragma("unroll") for(int r=0;r<16;++r)o[d_][r]*=wsf[crow(r,hi)]; } }while(0)
  f32x16 pA0,pA1,pB0,pB1;
  int sl_prev=0,sl_cur=0,sl_next=SLOTB;
  #define ROT() do{sl_prev=sl_cur;sl_cur=sl_next;sl_next=(sl_next==(NSLOT-1)*SLOTB)?0:sl_next+SLOTB;}while(0)
  DMA_K(2,2*SLOTB);
  WAIT_BAR(3);
  qkt(pA0,pA1,Kbase,qr,negm,r32,hi);asm volatile("s_nop 15\n\ts_nop 7":"+v"(pA0),"+v"(pA1));CMASK(pA0,pA1,0);
  START(pA0,pA1);
  _Pragma("unroll") for(int r=0;r<16;++r)pA1[r]=__builtin_amdgcn_exp2f(pA1[r]);
  WAIT_BAR(0);
  DMA_K(3,0);DMA_V(1,SLOTB);
  ROT();
  kload8(kf,kp0+sl_cur);
  WAIT_BAR(2);
  s16x4 vlo[8],vhi[8]; u32x4 pw0,pw1,pw2,pw3;
  #define PKW(P,B) cvtpk_s(P[B],P[B+1])
  #define PAF(k) __builtin_bit_cast(bf16x8,pw##k)
  #define VFR(i) (bf16x8){vlo[i][0],vlo[i][1],vlo[i][2],vlo[i][3],vhi[i][0],vhi[i][1],vhi[i][2],vhi[i][3]}
  #define PIN(x) asm volatile("":"+v"(x))
  #define MX3(a,b,c) __builtin_fmaxf(__builtin_fmaxf((a),(b)),(c))
  #define GAPA(MF,A0,A1,A2,A3,W0,W1,PW) do{ MF; sacc+=A0; sacc+=A1; sacc+=A2; sacc+=A3; PIN(sacc); W0; W1; PIN(PW); SBAR(); }while(0)
  #define EX(v) __builtin_amdgcn_exp2f(v)
  #define GAPB(MF,X,B) do{ MF; X[B]=EX(X[B]); X[B+1]=EX(X[B+1]); X[B+2]=EX(X[B+2]); X[B+3]=EX(X[B+3]); PIN(X); SBAR(); }while(0)
  #define VRD(i) do{ vlo[i]=vtr(vp_+(((i)>>2)*4096+((i)&3)*1024)); vhi[i]=vtr(vp_+(((i)>>2)*4096+((i)&3)*1024+512)); }while(0)
  #define KRD(G,j) do{ if(G){ kload2(kf,kp0+sl_next,j); SBAR(); } }while(0)
  #define STEP(C0,C1,P0,P1,t,GK,GV,GL) do{ SBAR(); \
    const lds_cptr vp_=vp0+sl_prev; \
    VRD(0); SBAR(); float sacc=(P0[0]+P0[1]); \
    GAPA(C0=__builtin_amdgcn_mfma_f32_32x32x16_bf16(kf[0],qr[0],negm,0,0,0), P0[2],P0[3],P0[4],P0[5],     pw0[0]=PKW(P0,0), pw0[1]=PKW(P0,2), pw0); \
    VRD(4); SBAR(); GAPA(C1=__builtin_amdgcn_mfma_f32_32x32x16_bf16(kf[1],qr[0],negm,0,0,0), P0[6],P0[7],P0[8],P0[9],     pw0[2]=PKW(P0,4), pw0[3]=PKW(P0,6), pw0); \
    VRD(1); SBAR(); GAPA(C0=__builtin_amdgcn_mfma_f32_32x32x16_bf16(kf[2],qr[1],C0,0,0,0),   P0[10],P0[11],P0[12],P0[13], pw1[0]=PKW(P0,8), pw1[1]=PKW(P0,10), pw1); \
    VRD(5); SBAR(); GAPA(C1=__builtin_amdgcn_mfma_f32_32x32x16_bf16(kf[3],qr[1],C1,0,0,0),   P0[14],P0[15],P1[0],P1[1],   pw1[2]=PKW(P0,12),pw1[3]=PKW(P0,14), pw1); \
    VRD(2); SBAR(); GAPA(C0=__builtin_amdgcn_mfma_f32_32x32x16_bf16(kf[4],qr[2],C0,0,0,0),   P1[2],P1[3],P1[4],P1[5],     pw2[0]=PKW(P1,0), pw2[1]=PKW(P1,2), pw2); \
    VRD(6); SBAR(); GAPA(C1=__builtin_amdgcn_mfma_f32_32x32x16_bf16(kf[5],qr[2],C1,0,0,0),   P1[6],P1[7],P1[8],P1[9],     pw2[2]=PKW(P1,4), pw2[3]=PKW(P1,6), pw2); \
    VRD(3); SBAR(); GAPA(C0=__builtin_amdgcn_mfma_f32_32x32x16_bf16(kf[6],qr[3],C0,0,0,0),   P1[10],P1[11],P1[12],P1[13], pw3[0]=PKW(P1,8), pw3[1]=PKW(P1,10), pw3); \
    VRD(7); SBAR(); GAPA(C1=__builtin_amdgcn_mfma_f32_32x32x16_bf16(kf[7],qr[3],C1,0,0,0),   P1[14],P1[15],0.f,0.f,       pw3[2]=PKW(P1,12),pw3[3]=PKW(P1,14), pw3); \
    l_reg+=sacc; \
    if(GK){DMA_K((t)+3,sl_cur);} if(GV){DMA_V((t)+1,sl_next);} \
    CMASK(C0,C1,t); \
    { float a=MX3(C0[0],C0[1],C1[0]),b=MX3(C0[2],C0[3],C1[1]); a=MX3(a,C1[2],C1[3]); \
      _Pragma("unroll") for(int r=4;r<16;r+=4){a=MX3(a,C0[r],C0[r+1]);b=MX3(b,C0[r+2],C0[r+3]);a=MX3(a,C1[r],C1[r+1]);b=MX3(b,C1[r+2],C1[r+3]);} \
      float rm=__builtin_fmaxf(a,b); { auto rr=__builtin_amdgcn_permlane32_swap(__float_as_uint(rm),__float_as_uint(rm),false,false); rm=__builtin_fmaxf(__uint_as_float(rr[0]),__uint_as_float(rr[1])); } \
      resc=false; \
      if(__builtin_expect(__any(rm>(float)THRL),0)){ const float dl=__builtin_fmaxf(rm,0.f); mhat+=dl; \
        _Pragma("unroll") for(int r=0;r<16;++r){C0[r]-=dl;C1[r]-=dl;} \
        _Pragma("unroll") for(int r=0;r<16;++r)negm[r]=-mhat; asm volatile("":"+v"(negm)); \
        const float f=__builtin_amdgcn_exp2f(-dl); l_reg*=f; if(hi==0)wsf[r32]=f; resc=true; } } \
    SBAR(); \
    GAPB(o[0]=__builtin_amdgcn_mfma_f32_32x32x16_bf16(PAF(0),VFR(0),o[0],0,0,0), C0,0); \
    GAPB(o[1]=__builtin_amdgcn_mfma_f32_32x32x16_bf16(PAF(0),VFR(4),o[1],0,0,0), C0,4); \
    KRD(GL,0); GAPB(o[0]=__builtin_amdgcn_mfma_f32_32x32x16_bf16(PAF(1),VFR(1),o[0],0,0,0), C0,8); \
    KRD(GL,1); GAPB(o[1]=__builtin_amdgcn_mfma_f32_32x32x16_bf16(PAF(1),VFR(5),o[1],0,0,0), C0,12); \
    KRD(GL,2); GAPB(o[0]=__builtin_amdgcn_mfma_f32_32x32x16_bf16(PAF(2),VFR(2),o[0],0,0,0), C1,0); \
    KRD(GL,3); GAPB(o[1]=__builtin_amdgcn_mfma_f32_32x32x16_bf16(PAF(2),VFR(6),o[1],0,0,0), C1,4); \
    GAPB(o[0]=__builtin_amdgcn_mfma_f32_32x32x16_bf16(PAF(3),VFR(3),o[0],0,0,0), C1,8); \
    GAPB(o[1]=__builtin_amdgcn_mfma_f32_32x32x16_bf16(PAF(3),VFR(7),o[1],0,0,0), C1,12); \
    }while(0)
  int t=1;
  #undef CMASK
  #define CMASK(P0,P1,t) do{}while(0)
  for(;t+5<NT;t+=2){
    STEP(pB0,pB1,pA0,pA1,t,true,true,true);     WAIT_BAR(2); RESC(); ROT();
    STEP(pA0,pA1,pB0,pB1,t+1,true,true,true);   WAIT_BAR(2); RESC(); ROT();
  }
  #undef CMASK
  #define CMASK(P0,P1,t) do{int jb_=(t)-(NT-4); if(jb_>=0)cmask(P0,P1,jb_,qrel,hi);}while(0)
  #define ENDW(tt) do{ if((tt)+3<NT){WAIT_BAR(2);} else if((tt)+2<NT){WAIT_BAR(1);} else {WAIT_BAR(0);} }while(0)
  for(;t+1<NT;t+=2){
    STEP(pB0,pB1,pA0,pA1,t,(t+3<NT),(t+1<NT),(t+1<NT));       ENDW(t);   RESC(); ROT();
    STEP(pA0,pA1,pB0,pB1,t+1,(t+4<NT),(t+2<NT),(t+2<NT));     ENDW(t+1); RESC(); ROT();
  }
  STEP(pB0,pB1,pA0,pA1,NT-1,false,false,false); RESC();
  { float sacc=pB0[0]+pB0[1]; _Pragma("unroll") for(int r=2;r<16;++r)sacc+=pB0[r]; _Pragma("unroll") for(int r=0;r<16;++r)sacc+=pB1[r]; l_reg+=sacc;
    pw0=(u32x4){PKW(pB0,0),PKW(pB0,2),PKW(pB0,4),PKW(pB0,6)};pw1=(u32x4){PKW(pB0,8),PKW(pB0,10),PKW(pB0,12),PKW(pB0,14)};pw2=(u32x4){PKW(pB1,0),PKW(pB1,2),PKW(pB1,4),PKW(pB1,6)};pw3=(u32x4){PKW(pB1,8),PKW(pB1,10),PKW(pB1,12),PKW(pB1,14)};
    SBAR(); pv(o,vb0+sl_cur,PAF(0),PAF(1),PAF(2),PAF(3)); }
  #undef PKW
  #undef PAF
  #undef VFR
  #undef PIN
  #undef MX3
  #undef GAPA
  #undef GAPB
  #undef EX
  #undef VRD
  #undef KRD
  #undef STEP
  #undef ENDW
  {auto rr=__builtin_amdgcn_permlane32_swap(__float_as_uint(l_reg),__float_as_uint(l_reg),false,false);l_reg=__uint_as_float(rr[0])+__uint_as_float(rr[1]);}
  if(hi==0)wsf[32+r32]=l_reg;asm volatile("s_waitcnt lgkmcnt(0)":::"memory");
  float rli[16];
  #pragma unroll
  for(int r=0;r<16;++r)rli[r]=__builtin_amdgcn_rcpf(wsf[32+crow(r,hi)]);
  bf16*Ow=O+(rowbase+q0+wid*QBLK)*DM+hv*D;
  { bf16*stg=(bf16*)(shm+LDS_OST)+wid*2048;
    #pragma unroll
    for(int r=0;r<16;++r){const int orow=crow(r,hi);
      #pragma unroll
      for(int d0=0;d0<2;++d0)stg[orow*64+d0*32+r32]=__float2bfloat16(o[d0][r]*rli[r]);}
    asm volatile("s_waitcnt lgkmcnt(0)":::"memory");
    #pragma unroll
    for(int i=0;i<4;++i){const int row=i*8+(lane>>3),ch=lane&7; const u32x4 v=*(const u32x4*)(stg+row*64+ch*8); ATTN_STORE16(Ow+(long)row*DM+ch*8,v);} }
  asm volatile("s_waitcnt lgkmcnt(0)\n\ts_barrier":::"memory");
  #undef DMA_K
  #undef DMA_V
  #undef CMASK
  #undef START
  #undef RESC
  #undef ROT
}
constexpr int ATTN_LDS_BYTES=LDS_BYTES;
struct AttnTensors { const bf16* Q; const bf16* K; const bf16* V; bf16* O1; bf16* O2; };
struct AttnUnit { int vb; int qb; };
struct StaticOrder {
  int vcu;
  __device__ __forceinline__ explicit StaticOrder(int grid,int block):vcu((block%8)*(grid/8)+block/8){}
  __device__ __forceinline__ bool next(int i,AttnUnit&u)const{ if(i>=8)return false; const int s=vcu&7,j=i&3; u.vb=2*(vcu>>3)+(i>>2); u.qb=(j==0)?s:(j==1)?15-s:(j==2)?16+s:31-s; return true; }
  __device__ __forceinline__ void a_ready(const AttnUnit&)const{}
  __device__ __forceinline__ void done(const AttnUnit&)const{}
};
template<class Sched,int THRL=8> __device__ __forceinline__ void attn_phase(char*lds,const AttnTensors&T,const Sched&S,const int wave_id){
  AttnUnit u;
  for(int i=0;S.next(i,u);++i){ S.a_ready(u); const int c=u.vb&1,bhq=u.vb>>1,b=bhq>>4,hq=bhq&15; attn_unit<THRL>(b,hq,(hq>>1)*2+c,u.qb,T.Q,T.K,T.V,(hq&1)?T.O2:T.O1,lds,wave_id); S.done(u); }
}
#undef SBAR
#undef WAIT_BAR
}
#define GAS __attribute__((address_space(1)))
#define LAS __attribute__((address_space(3)))
typedef unsigned short bf16;
typedef unsigned v4u __attribute__((ext_vector_type(4)));
typedef float f32x4 __attribute__((ext_vector_type(4)));
typedef short bf16x8 __attribute__((ext_vector_type(8)));
typedef GAS unsigned gu32;
typedef GAS unsigned long long gu64;
#define RLX_AGENT __ATOMIC_RELAXED, __HIP_MEMORY_SCOPE_AGENT
#define LDS_WAIT() asm volatile("s_waitcnt lgkmcnt(0)" ::: "memory")
#define VM_WAIT() asm volatile("s_waitcnt vmcnt(0)" ::: "memory")
__device__ __forceinline__ unsigned long long rt() { return __builtin_amdgcn_s_memrealtime(); }
typedef float f32x2_hw __attribute__((ext_vector_type(2))); typedef __bf16 bf16x2_hw __attribute__((ext_vector_type(2)));
__device__ __forceinline__ unsigned pk2(float lo, float hi) { const f32x2_hw v = {lo, hi}; const bf16x2_hw b = __builtin_convertvector(v, bf16x2_hw); return __builtin_bit_cast(unsigned, b); }
__device__ __forceinline__ unsigned f2bf(float f) { return pk2(f, 0.f) & 0xffffu; }

#define XB_TMO      128
#define XB_XCNT(j)  (256  + 64 * (j))
#define XB_XSUB(j)  (1280 + 64 * (j))
#define XB_XGEN(j)  (2304 + 64 * (j))
#define XB_TOP      3328
#define XB_TOPGEN   3392
#define XCD_BAR_WORDS 3456
#define XB_SPIN_CAP (1u << 18)

__device__ __forceinline__ unsigned xb_ld(unsigned* p)              { return __hip_atomic_load(p, __ATOMIC_RELAXED, __HIP_MEMORY_SCOPE_AGENT); }
__device__ __forceinline__ unsigned xb_add(unsigned* p, unsigned v) { return __hip_atomic_fetch_add(p, v, __ATOMIC_RELAXED, __HIP_MEMORY_SCOPE_AGENT); }
__device__ __forceinline__ unsigned xb_xcc_id() { return (unsigned)__builtin_amdgcn_s_getreg((3 << 11) | 20) & 0xFu; }
#define XB_SPIN(cond, bar) do { unsigned _sp = 0; while (cond) { __builtin_amdgcn_s_sleep(1); \
    if ((++_sp & 255u) == 0u) { if (xb_ld(&(bar)[XB_TMO])) break; if (_sp > XB_SPIN_CAP) { atomicAdd(&(bar)[XB_TMO], 1u); break; } } } } while (0)

struct XcdBarrier {
    unsigned* bar; unsigned x;
    volatile LAS unsigned* st;
};

__device__ __forceinline__ XcdBarrier xcd_barrier_post(unsigned* bar, volatile LAS unsigned* st, const int wave_id) {
    XcdBarrier b; b.bar = bar; b.x = xb_xcc_id(); b.st = st;
    if (wave_id == 0 && __builtin_amdgcn_mbcnt_hi(~0u, __builtin_amdgcn_mbcnt_lo(~0u, 0u)) == 0u) (void)xb_add(&bar[XB_XCNT(b.x)], 1u);
    return b;
}
__device__ __forceinline__ void xcd_barrier_complete(unsigned* bar, unsigned x, unsigned& nloc, unsigned& nx) {
    const unsigned G = gridDim.x * gridDim.y * gridDim.z;
    unsigned sum, cnt, mine, sp = 0u;
    for (;;) {
        sum = 0u; cnt = 0u; mine = 0u;
#pragma unroll
        for (unsigned j = 0; j < 16; ++j) { const unsigned c = xb_ld(&bar[XB_XCNT(j)]); sum += c; cnt += (c > 0u) ? 1u : 0u; mine = (j == x) ? c : mine; }
        if (sum == G) break;
        __builtin_amdgcn_s_sleep(1);
        if ((++sp & 255u) == 0u) { if (xb_ld(&bar[XB_TMO])) break; if (sp > XB_SPIN_CAP) { atomicAdd(&bar[XB_TMO], 1u); break; } }
    }
    nloc = mine > 0u ? mine : 1u; nx = cnt > 0u ? cnt : 1u;
}

__device__ __forceinline__ void xcd_barrier(const XcdBarrier& b, const int wave_id) {
    asm volatile("s_waitcnt vmcnt(0)" ::: "memory");
    __syncthreads();
    if (wave_id == 0 && __builtin_amdgcn_mbcnt_hi(~0u, __builtin_amdgcn_mbcnt_lo(~0u, 0u)) == 0u) {
        unsigned* bar = b.bar;
        __builtin_amdgcn_s_waitcnt(0);
        unsigned nloc = b.st[0], nx = b.st[1];
        if (nloc == 0u) { xcd_barrier_complete(bar, b.x, nloc, nx); b.st[0] = nloc; b.st[1] = nx; }
        const unsigned old = xb_add(&bar[XB_XSUB(b.x)], 1u);
        const unsigned gen = old / nloc;
        if (old + 1u == (gen + 1u) * nloc) {
            __builtin_amdgcn_fence(__ATOMIC_RELEASE, "agent");
            asm volatile("s_waitcnt vmcnt(0)" ::: "memory");
            const unsigned og = xb_add(&bar[XB_TOP], 1u);
            const unsigned tg = og / nx;
            if (og + 1u == (tg + 1u) * nx) xb_add(&bar[XB_TOPGEN], 1u);
            else XB_SPIN(xb_ld(&bar[XB_TOPGEN]) == tg, bar);
            __builtin_amdgcn_fence(__ATOMIC_ACQUIRE, "agent");
            xb_add(&bar[XB_XGEN(b.x)], 1u);
            asm volatile("s_waitcnt vmcnt(0)" ::: "memory");
        } else {
            XB_SPIN(xb_ld(&bar[XB_XGEN(b.x)]) == gen, bar);
            __builtin_amdgcn_fence(__ATOMIC_ACQUIRE, "agent");
            asm volatile("s_waitcnt vmcnt(0)" ::: "memory");
        }
    }
    __syncthreads();
}
constexpr int NWAVES = 8;
constexpr int T = 8192, D = 1024, M = 16384;
constexpr int NINP = 4352;
constexpr int NEXP = 32, NROWS2 = 40960, NTILE2 = NROWS2 / 256;
constexpr float LN_EPS = 1e-5f, RMS_EPS = 1e-6f, ALPHA = 1.6817928305074292f;
constexpr float QSCALE = 0.125f * 1.4426950408889634f;

constexpr size_t al256(size_t x) { return (x + 255) & ~(size_t)255; }
constexpr size_t WS_CTL = 0, CTL_ZERO_BYTES = 1u << 20;
constexpr size_t WS_WIN = WS_CTL + CTL_ZERO_BYTES;
constexpr size_t WS_WAOUT = WS_WIN + (size_t)2 * NINP * D * 2;
constexpr size_t WS_WQKV = WS_WAOUT + (size_t)2 * D * D * 2;
constexpr size_t WS_WQ3 = WS_WQKV + (size_t)3 * D * D * 2;
constexpr size_t WS_WBOUT = WS_WQ3 + (size_t)D * D * 2;
constexpr size_t WS_WR = WS_WBOUT + (size_t)2 * D * D * 2;
constexpr size_t WS_W13 = WS_WR + (size_t)4 * 48 * D * 2;
constexpr size_t WS_W2 = WS_W13 + (size_t)4 * 32 * 1024 * 1024 * 2;
constexpr size_t WS_H = WS_W2 + (size_t)4 * 32 * 1024 * 512 * 2;
constexpr size_t WS_HB = WS_H + (size_t)M * D * 4;
constexpr size_t WS_H1 = WS_HB + (size_t)M * D * 2;
constexpr size_t WS_H1B = WS_H1 + (size_t)M * D * 4;
constexpr size_t WS_PROJ = WS_H1B + (size_t)M * D * 2;
constexpr size_t WS_KB = WS_PROJ + (size_t)M * NINP * 2;
constexpr size_t WS_VB = WS_KB + (size_t)M * D * 2;
constexpr size_t WS_ON = WS_VB + (size_t)M * D * 2;
constexpr size_t WS_MIX = WS_ON + (size_t)M * D * 2;
constexpr size_t WS_EID = WS_MIX + (size_t)M * D * 4;
constexpr size_t WS_GATE = WS_EID + (size_t)2 * M * 4;
constexpr size_t WS_APOS = WS_GATE + (size_t)2 * M * 4;
constexpr size_t WS_XROWS = WS_APOS + (size_t)2 * M * 4;
constexpr size_t WS_HID = WS_XROWS + (size_t)NROWS2 * 1024 * 2;
constexpr size_t WS_YROWS = WS_HID + (size_t)NROWS2 * 512 * 2;
constexpr size_t WS_FAST_END = WS_YROWS + (size_t)NROWS2 * 1024 * 2;
constexpr int CW_BAR = 4096;
constexpr int CW_CNT = 64;
constexpr int LDS_BYTES = 147456, RING_BYTES = 131072, LDSCTL_OFF = RING_BYTES, MISC_OFF = LDSCTL_OFF + 320, TILEE_OFF = MISC_OFF + 128;
constexpr int PREP_SC_OFF = TILEE_OFF + 4 * NTILE2 + 64;
constexpr int STAMP_OFF = PREP_SC_OFF + 8 * 768;
constexpr int SCAN_O_OFF = (STAMP_OFF + 48 * 8 + 15) & ~15;
static_assert(SCAN_O_OFF + 4 * 2048 <= LDS_BYTES, "LDS map");

#define PHASE_IDS int tid_o_ = F.wave * 64 + (int)__builtin_amdgcn_mbcnt_hi(~0u, __builtin_amdgcn_mbcnt_lo(~0u, 0u)); asm volatile("" : "+v"(tid_o_)); const int tid = tid_o_, lane = tid & 63; (void)tid; (void)lane;
struct Frame {
    LAS unsigned char* lds; volatile LAS unsigned* MISC; gu32* ctl;
    int wave, vcu, G;
    unsigned char* ws;
};
struct Args { const float* in[20]; float* out; unsigned char* ws; int ph_lo, ph_hi, bar_region, pad; float lam_init[2]; };

__device__ __forceinline__ float wave_sum(float v) {
#pragma unroll
    for (int o = 1; o < 64; o <<= 1) v += __shfl_xor(v, o);
    return v;
}
__device__ __forceinline__ void p0_transpose_item(const float* W, int ldw, int nvalid, bf16* WT, int ldt, int drow0, int k0, int n0, LAS float* scr, int lane) {
    const int c4 = lane & 7, kr = lane >> 3; const bool ok = (n0 + 4 * c4) < nvalid;
    f32x4 x[8];
#pragma unroll
    for (int i = 0; i < 8; ++i) x[i] = ok ? *(const GAS f32x4*)(W + (size_t)(k0 + kr + 8 * i) * ldw + n0 + 4 * c4) : (f32x4){0.f, 0.f, 0.f, 0.f};
#pragma unroll
    for (int i = 0; i < 8; ++i) *(LAS f32x4*)(scr + (kr + 8 * i) * 36 + ((4 * c4 + 4 * i) & 31)) = x[i];
    LDS_WAIT(); asm volatile("" ::: "memory");
    const int c = lane & 7;
#pragma unroll
    for (int j = 0; j < 4; ++j) { const int n = (lane >> 3) + 8 * j; const LAS float* sp = scr + (8 * c) * 36 + ((n + 4 * c) & 31);
        v4u o; o.x = pk2(sp[0 * 36], sp[1 * 36]); o.y = pk2(sp[2 * 36], sp[3 * 36]); o.z = pk2(sp[4 * 36], sp[5 * 36]); o.w = pk2(sp[6 * 36], sp[7 * 36]);
        *(GAS v4u*)(WT + (size_t)(drow0 + n) * ldt + k0 + 8 * c) = o; }
    LDS_WAIT(); asm volatile("" ::: "memory");
}
__device__ __forceinline__ bool p0_job(int& r, const float* W, int K, int N, int nblk, bf16* WT, int drow_base, bool w13perm, LAS float* scr, int lane) {
    const int items = (K / 64) * nblk;
    if (r >= items) { r -= items; return false; }
    const int kb = r / nblk, nb = r % nblk, n0 = nb * 32;
    int drow0 = drow_base + n0;
    if (w13perm) drow0 = drow_base + ((n0 & 511) >> 7) * 256 + (n0 >> 9) * 128 + (n0 & 127);
    p0_transpose_item(W, N, N, WT, K, drow0, kb * 64, n0, scr, lane);
    return true;
}
__device__ __forceinline__ void p0_prologue(Frame& F, const Args& a) {
    PHASE_IDS
    LAS float* scr = (LAS float*)(F.lds + F.wave * 16384);
    const int gw = F.vcu * NWAVES + F.wave, NGW = F.G * NWAVES;
    bf16* win = (bf16*)(F.ws + WS_WIN); bf16* waout = (bf16*)(F.ws + WS_WAOUT); bf16* wqkv = (bf16*)(F.ws + WS_WQKV); bf16* wq3 = (bf16*)(F.ws + WS_WQ3);
    bf16* wbout = (bf16*)(F.ws + WS_WBOUT); bf16* wr = (bf16*)(F.ws + WS_WR);
    constexpr int I_IN = 16 * 129, I_SQ = 16 * 32, I_KV = 16 * 64;
    constexpr int NSMALL = 2 * I_IN + 2 * I_SQ + I_KV + 2 * I_SQ + 2 * I_SQ;
    for (int it = gw; it < NSMALL; it += NGW) {
        int r = it;
        bool done = false;
        for (int l = 0; l < 2 && !done; ++l) done = p0_job(r, a.in[1] + (size_t)l * D * 4112, D, 4112, 129, win + (size_t)l * NINP * D, 0, false, scr, lane);
        for (int l = 0; l < 2 && !done; ++l) done = p0_job(r, a.in[6] + (size_t)l * D * D, D, D, 32, waout + (size_t)l * D * D, 0, false, scr, lane);
        if (!done) done = p0_job(r, a.in[7], D, 2048, 64, wqkv, 1024, false, scr, lane);
        if (!done) done = p0_job(r, a.in[8], D, D, 32, wqkv, 0, false, scr, lane);
        if (!done) done = p0_job(r, a.in[8] + (size_t)D * D, D, D, 32, wq3, 0, false, scr, lane);
        for (int l = 0; l < 2 && !done; ++l) done = p0_job(r, a.in[11] + (size_t)l * D * D, D, D, 32, wbout + (size_t)l * D * D, 0, false, scr, lane);
    }
    { const int gt = (F.vcu * NWAVES + F.wave) * 64 + lane, NT = F.G * NWAVES * 64;
      for (int i = gt; i < 2 * 224 * (D / 8); i += NT) { const int l = i / (224 * (D / 8)), rr = (i / (D / 8)) % 224, c8 = i % (D / 8); *(GAS v4u*)(win + ((size_t)l * NINP + 4128 + rr) * D + c8 * 8) = (v4u){0u, 0u, 0u, 0u}; }
      for (int i = gt; i < 4 * 48 * D; i += NT) { const int l = i / (48 * D), n = (i / D) % 48, k = i % D;
          const float v = n < 4 ? a.in[16][((size_t)l * D + k) * 4 + n] : (n < 36 ? a.in[17][((size_t)l * D + k) * 32 + (n - 4)] : 0.f); wr[i] = (bf16)f2bf(v); }
      bf16* hb = (bf16*)(F.ws + WS_HB); const float* x = a.in[0];
      for (int i = gt; i < M * D / 8; i += NT) { const f32x4 p = *(const GAS f32x4*)(x + (size_t)i * 8), q = *(const GAS f32x4*)(x + (size_t)i * 8 + 4);
          *(GAS v4u*)(hb + (size_t)i * 8) = (v4u){pk2(p.x, p.y), pk2(p.z, p.w), pk2(q.x, q.y), pk2(q.z, q.w)}; } }
}

__device__ __forceinline__ void p0_moe_weights(Frame& F, const Args& a, int l0, int wg_idx, int nwg) {
    PHASE_IDS
    LAS float* scr = (LAS float*)(F.lds + F.wave * 16384);
    bf16* w13 = (bf16*)(F.ws + WS_W13); bf16* w2 = (bf16*)(F.ws + WS_W2);
    constexpr int I_W13 = 16 * 32, I_W2 = 8 * 32;
    const int gw = wg_idx * NWAVES + F.wave, NGW = nwg * NWAVES;
    for (int it = gw; it < 64 * (I_W13 + I_W2); it += NGW) {
        int r = it;
        if (r < 64 * I_W13) { const int mat = l0 * 32 + r / I_W13; r = r % I_W13; p0_job(r, a.in[18] + (size_t)mat * 1024 * 1024, 1024, 1024, 32, w13 + (size_t)mat * 1024 * 1024, 0, true, scr, lane); }
        else { r -= 64 * I_W13; const int mat = l0 * 32 + r / I_W2; r = r % I_W2; p0_job(r, a.in[19] + (size_t)mat * 512 * 1024, 512, 1024, 32, w2 + (size_t)mat * 1024 * 512, 0, false, scr, lane); }
    }
}

__device__ __forceinline__ void ln_rows8(Frame& F, const int lane, const float* hin, const float* mix, const float* g, const float* b, float* h1, bf16* h1b, int row0) {
    for (int rr = 0; rr < 8; ++rr) {
        const int row = row0 + rr;
        const GAS f32x4* hr = (const GAS f32x4*)(hin + (size_t)row * D) + lane; const GAS f32x4* mr = (const GAS f32x4*)(mix + (size_t)row * D) + lane;
        f32x4 v[4]; float s = 0.f;
#pragma unroll
        for (int j = 0; j < 4; ++j) { v[j] = hr[64 * j] * ALPHA + mr[64 * j]; s += (v[j].x + v[j].y) + (v[j].z + v[j].w); }
        const float mean = wave_sum(s) * (1.f / D); float s2 = 0.f;
#pragma unroll
        for (int j = 0; j < 4; ++j) { v[j] = v[j] - mean; s2 += (v[j].x * v[j].x + v[j].y * v[j].y) + (v[j].z * v[j].z + v[j].w * v[j].w); }
        const float rstd = 1.f / sqrtf(wave_sum(s2) * (1.f / D) + LN_EPS);
        GAS f32x4* o4 = (GAS f32x4*)(h1 + (size_t)row * D) + lane; GAS unsigned long long* o8 = (GAS unsigned long long*)(h1b + (size_t)row * D) + lane;
#pragma unroll
        for (int j = 0; j < 4; ++j) { const f32x4 gv = *((const GAS f32x4*)g + lane + 64 * j), bv = *((const GAS f32x4*)b + lane + 64 * j);
            const f32x4 y = v[j] * rstd * gv + bv; o4[64 * j] = y;
            o8[64 * j] = (unsigned long long)pk2(y.x, y.y) | ((unsigned long long)pk2(y.z, y.w) << 32); }
    }
}
__device__ __forceinline__ void phase_ln1_router(Frame& F, const float* hin, const float* mix, const float* g, const float* b, float* h1, bf16* h1b, const bf16* wr,
                                                 int* eid, float* gate, gu32* counts) {
    PHASE_IDS
    LAS float* lg = (LAS float*)(F.lds);
    LAS int* lcnt = (LAS int*)(F.lds + 16384);
    for (int blk = F.vcu; blk < M / 64; blk += F.G) {
        const int row0 = blk * 64;
        if (tid < 32) lcnt[tid] = 0;
        ln_rows8(F, lane, hin, mix, g, b, h1, h1b, row0 + F.wave * 8);
        VM_WAIT(); __syncthreads();
        if (F.wave < 4) {
            const int fr = lane & 15, fq = lane >> 4;
            const bf16* ap = h1b + (size_t)(row0 + F.wave * 16 + fr) * D + fq * 8;
            f32x4 acc[3]; acc[0] = (f32x4){0.f, 0.f, 0.f, 0.f}; acc[1] = acc[0]; acc[2] = acc[0];
#pragma unroll 4
            for (int ks = 0; ks < 32; ++ks) {
                const bf16x8 av = *(const GAS bf16x8*)(ap + ks * 32);
#pragma unroll
                for (int ct = 0; ct < 3; ++ct) { const bf16x8 bv = *(const GAS bf16x8*)(wr + (size_t)(ct * 16 + fr) * D + ks * 32 + fq * 8);
                    acc[ct] = __builtin_amdgcn_mfma_f32_16x16x32_bf16(av, bv, acc[ct], 0, 0, 0); }
            }
#pragma unroll
            for (int ct = 0; ct < 3; ++ct)
#pragma unroll
                for (int r = 0; r < 4; ++r) lg[(F.wave * 16 + 4 * fq + r) * 52 + ct * 16 + fr] = acc[ct][r];
            LDS_WAIT(); asm volatile("" ::: "memory");
            if (lane < 16) {
                const int rl = F.wave * 16 + lane; const LAS float* L = lg + rl * 52;
                int gi = 0; float gm = L[0];
                for (int q = 1; q < 4; ++q) if (L[q] > gm) { gm = L[q]; gi = q; }
                float gs = 0.f; for (int q = 0; q < 4; ++q) gs += __expf(L[q] - gm);
                const float pg = 1.f / gs; const LAS float* el = L + 4 + gi * 8;
                int i0 = 0; float v0 = el[0];
                for (int i = 1; i < 8; ++i) if (el[i] > v0) { v0 = el[i]; i0 = i; }
                int i1 = 0; float v1 = -INFINITY;
                for (int i = 0; i < 8; ++i) if (i != i0 && el[i] > v1) { v1 = el[i]; i1 = i; }
                const float e1 = __expf(v1 - v0); const int tok = row0 + rl, ea = gi * 8 + i0, eb = gi * 8 + i1;
                eid[2 * tok] = ea; eid[2 * tok + 1] = eb; gate[2 * tok] = pg / (1.f + e1); gate[2 * tok + 1] = pg * e1 / (1.f + e1);
                atomicAdd((int*)&lcnt[ea], 1); atomicAdd((int*)&lcnt[eb], 1);
            }
        }
        LDS_WAIT(); __syncthreads();
        if (tid < 32) { const int c = lcnt[tid]; if (c) __hip_atomic_fetch_add(counts + tid, (unsigned)c, __ATOMIC_RELAXED, __HIP_MEMORY_SCOPE_AGENT); }
        __syncthreads();
    }
}
__device__ __forceinline__ int moe_layout(Frame& F, const gu32* counts, LAS int* ps, LAS int* tile_e) {
    PHASE_IDS
    if (tid == 0) { int acc = 0; for (int e = 0; e < NEXP; ++e) { ps[e] = acc; const int c = (int)__hip_atomic_load(counts + e, __ATOMIC_RELAXED, __HIP_MEMORY_SCOPE_AGENT); const int nt = (c + 255) >> 8;
            for (int t = 0; t < nt; ++t) tile_e[(acc >> 8) + t] = e; acc += nt << 8; } ps[NEXP] = acc; }
    LDS_WAIT(); __syncthreads();
    return __builtin_amdgcn_readfirstlane(ps[NEXP]) >> 8;
}
__device__ __forceinline__ void phase_scatter(Frame& F, const gu32* counts, gu32* cursor, const int* eid, const bf16* h1b, bf16* xrows, int* apos) {
    PHASE_IDS
    LAS int* ps = (LAS int*)(F.lds + 20480); LAS int* tile_e = (LAS int*)(F.lds + TILEE_OFF);
    LAS int* lcnt = (LAS int*)(F.lds + 16384); LAS int* lbase = (LAS int*)(F.lds + 16384 + 256); LAS int* lpos = (LAS int*)(F.lds + 16384 + 512);
    (void)moe_layout(F, counts, ps, tile_e);
    for (int blk = F.vcu; blk < M / 64; blk += F.G) {
        if (tid < 32) lcnt[tid] = 0;
        __syncthreads();
        int e = 0, rk = 0;
        if (tid < 128) { e = eid[blk * 128 + tid]; rk = atomicAdd((int*)&lcnt[e], 1); }
        LDS_WAIT(); __syncthreads();
        if (tid < 32) { const int c = lcnt[tid]; lbase[tid] = c ? (int)__hip_atomic_fetch_add(cursor + tid, (unsigned)c, __ATOMIC_RELAXED, __HIP_MEMORY_SCOPE_AGENT) : 0; }
        LDS_WAIT(); __syncthreads();
        if (tid < 128) { const int pos = ps[e] + lbase[e] + rk; lpos[tid] = pos; apos[blk * 128 + tid] = pos; }
        LDS_WAIT(); __syncthreads();
        for (int a = F.wave; a < 128; a += NWAVES) {
            const int tok = blk * 64 + (a >> 1), pos = lpos[a];
            const GAS v4u* src = (const GAS v4u*)(h1b + (size_t)tok * D) + lane; GAS v4u* dst = (GAS v4u*)(xrows + (size_t)pos * D) + lane;
            const v4u p0 = src[0], p1 = src[64]; dst[0] = p0; dst[64] = p1;
        }
        __syncthreads();
    }
}
__device__ __forceinline__ void phase_combine_ln2(Frame& F, const float* h1, const bf16* yrows, const int* apos, const float* gate, const float* g, const float* b, float* hout, bf16* hb) {
    PHASE_IDS
    const int gw = F.vcu * NWAVES + F.wave, NGW = F.G * NWAVES;
    for (int row = gw; row < M; row += NGW) {
        const int p0 = apos[2 * row], p1 = apos[2 * row + 1]; const float g0 = gate[2 * row], g1 = gate[2 * row + 1];
        const GAS f32x4* hr = (const GAS f32x4*)(h1 + (size_t)row * D) + lane;
        const GAS unsigned long long* y0 = (const GAS unsigned long long*)(yrows + (size_t)p0 * D) + lane; const GAS unsigned long long* y1 = (const GAS unsigned long long*)(yrows + (size_t)p1 * D) + lane;
        f32x4 v[4]; float s = 0.f;
#pragma unroll
        for (int j = 0; j < 4; ++j) { const unsigned long long a = y0[64 * j], c = y1[64 * j];
            f32x4 ya, yc;
            ya.x = __uint_as_float(((unsigned)a) << 16); ya.y = __uint_as_float(((unsigned)a) & 0xffff0000u); ya.z = __uint_as_float(((unsigned)(a >> 32)) << 16); ya.w = __uint_as_float(((unsigned)(a >> 32)) & 0xffff0000u);
            yc.x = __uint_as_float(((unsigned)c) << 16); yc.y = __uint_as_float(((unsigned)c) & 0xffff0000u); yc.z = __uint_as_float(((unsigned)(c >> 32)) << 16); yc.w = __uint_as_float(((unsigned)(c >> 32)) & 0xffff0000u);
            v[j] = hr[64 * j] * ALPHA + ya * g0 + yc * g1; s += (v[j].x + v[j].y) + (v[j].z + v[j].w); }
        const float mean = wave_sum(s) * (1.f / D); float s2 = 0.f;
#pragma unroll
        for (int j = 0; j < 4; ++j) { v[j] = v[j] - mean; s2 += (v[j].x * v[j].x + v[j].y * v[j].y) + (v[j].z * v[j].z + v[j].w * v[j].w); }
        const float rstd = 1.f / sqrtf(wave_sum(s2) * (1.f / D) + LN_EPS);
        GAS f32x4* o4 = (GAS f32x4*)(hout + (size_t)row * D) + lane; GAS unsigned long long* o8 = (GAS unsigned long long*)(hb + (size_t)row * D) + lane;
#pragma unroll
        for (int j = 0; j < 4; ++j) { const f32x4 gv = *((const GAS f32x4*)g + lane + 64 * j), bv = *((const GAS f32x4*)b + lane + 64 * j);
            const f32x4 y = v[j] * rstd * gv + bv; o4[64 * j] = y;
            o8[64 * j] = (unsigned long long)pk2(y.x, y.y) | ((unsigned long long)pk2(y.z, y.w) << 32); }
    }
}

__device__ __forceinline__ void phase_attn_combine(Frame& F, const bf16* O1, const bf16* O2, const float* lam_p, const float* subln, float lam_init, bf16* on) {
    PHASE_IDS
    const float l01 = wave_sum(lam_p[lane] * lam_p[64 + lane]), l23 = wave_sum(lam_p[128 + lane] * lam_p[192 + lane]);
    const float lam = __expf(l01) - __expf(l23) + lam_init;
    float sw[16];
#pragma unroll
    for (int i = 0; i < 16; ++i) sw[i] = subln[(lane & 7) * 16 + i] * (1.f - lam_init);
    const int gw = F.vcu * NWAVES + F.wave, NGW = F.G * NWAVES;
    for (int row = gw; row < M; row += NGW) {
        const GAS v4u* p1 = (const GAS v4u*)(O1 + (size_t)row * D) + 2 * lane; const GAS v4u* p2 = (const GAS v4u*)(O2 + (size_t)row * D) + 2 * lane;
        const v4u a0 = p1[0], a1 = p1[1], b0 = p2[0], b1 = p2[1];
        const unsigned aw[8] = {a0.x, a0.y, a0.z, a0.w, a1.x, a1.y, a1.z, a1.w}, bw[8] = {b0.x, b0.y, b0.z, b0.w, b1.x, b1.y, b1.z, b1.w};
        float o[16]; float ss = 0.f;
#pragma unroll
        for (int i = 0; i < 8; ++i) { o[2 * i] = __uint_as_float(aw[i] << 16) - lam * __uint_as_float(bw[i] << 16); o[2 * i + 1] = __uint_as_float(aw[i] & 0xffff0000u) - lam * __uint_as_float(bw[i] & 0xffff0000u);
            ss += o[2 * i] * o[2 * i] + o[2 * i + 1] * o[2 * i + 1]; }
        ss += __shfl_xor(ss, 1); ss += __shfl_xor(ss, 2); ss += __shfl_xor(ss, 4);
        const float r = 1.f / sqrtf(ss * (1.f / 128.f) + RMS_EPS);
        v4u w0, w1;
        w0.x = pk2(o[0] * r * sw[0], o[1] * r * sw[1]); w0.y = pk2(o[2] * r * sw[2], o[3] * r * sw[3]); w0.z = pk2(o[4] * r * sw[4], o[5] * r * sw[5]); w0.w = pk2(o[6] * r * sw[6], o[7] * r * sw[7]);
        w1.x = pk2(o[8] * r * sw[8], o[9] * r * sw[9]); w1.y = pk2(o[10] * r * sw[10], o[11] * r * sw[11]); w1.z = pk2(o[12] * r * sw[12], o[13] * r * sw[13]); w1.w = pk2(o[14] * r * sw[14], o[15] * r * sw[15]);
        GAS v4u* q = (GAS v4u*)(on + (size_t)row * D) + 2 * lane; q[0] = w0; q[1] = w1;
    }
}

typedef short s16x4v __attribute__((ext_vector_type(4)));
typedef short v4i16_t __attribute__((ext_vector_type(4)));
constexpr size_t WS_WNEG = WS_FAST_END;
constexpr size_t WS_QDEC = WS_WNEG + (size_t)2048 * 64 * 128 * 2;
constexpr size_t WS_KDEC = WS_QDEC + (size_t)2048 * 64 * 128 * 2;
constexpr size_t WS_ATT = WS_KDEC + (size_t)2048 * 64 * 128 * 2;
constexpr size_t WS_U = WS_ATT + (size_t)2048 * 64 * 64 * 2;
constexpr size_t WS_GLAST = WS_U + (size_t)2048 * 64 * 128 * 4;
constexpr size_t WS_OB = WS_GLAST + 8192;
constexpr size_t WS_DN_END = WS_OB + (size_t)M * D * 2;

__device__ __forceinline__ float bf2f(unsigned short v) { return __uint_as_float((unsigned)v << 16); }
__device__ __forceinline__ float silu_f(float x) { return x / (1.f + __expf(-x)); }
__device__ __forceinline__ s16x4v pack4(const f32x4 v) { s16x4v r; const unsigned a = pk2(v[0], v[1]), b = pk2(v[2], v[3]); r[0] = (short)(a & 0xffff); r[1] = (short)(a >> 16); r[2] = (short)(b & 0xffff); r[3] = (short)(b >> 16); return r; }
__device__ __forceinline__ bf16x8 pack8(const f32x4 lo, const f32x4 hi) { const unsigned a = pk2(lo[0], lo[1]), b = pk2(lo[2], lo[3]), c = pk2(hi[0], hi[1]), d = pk2(hi[2], hi[3]); return __builtin_bit_cast(bf16x8, (v4u){a, b, c, d}); }
#define MFMA16(a, b, c) __builtin_amdgcn_mfma_f32_16x16x16bf16_1k((a), (b), (c), 0, 0, 0)
#define MFMA32(a, b, c) __builtin_amdgcn_mfma_f32_16x16x32_bf16((a), (b), (c), 0, 0, 0)

__device__ __forceinline__ void conv8(const bf16* projb, int row, int pos, int col, const float* cw, float (&out)[8]) {
#pragma unroll
    for (int e = 0; e < 8; ++e) out[e] = 0.f;
#pragma unroll
    for (int j = 0; j < 4; ++j) {
        const bool ok = (pos - 3 + j) >= 0;
        v4u x = *(const GAS v4u*)(projb + (size_t)(ok ? row - 3 + j : row) * NINP + col);
        if (!ok) x = (v4u){0u, 0u, 0u, 0u};
        const f32x4 w0 = *(const GAS f32x4*)(cw + j * 3072 + col), w1 = *(const GAS f32x4*)(cw + j * 3072 + col + 4);
        out[0] = fmaf(w0.x, __uint_as_float(x.x << 16), out[0]); out[1] = fmaf(w0.y, __uint_as_float(x.x & 0xffff0000u), out[1]);
        out[2] = fmaf(w0.z, __uint_as_float(x.y << 16), out[2]); out[3] = fmaf(w0.w, __uint_as_float(x.y & 0xffff0000u), out[3]);
        out[4] = fmaf(w1.x, __uint_as_float(x.z << 16), out[4]); out[5] = fmaf(w1.y, __uint_as_float(x.z & 0xffff0000u), out[5]);
        out[6] = fmaf(w1.z, __uint_as_float(x.w << 16), out[6]); out[7] = fmaf(w1.w, __uint_as_float(x.w & 0xffff0000u), out[7]);
    }
#pragma unroll
    for (int e = 0; e < 8; ++e) out[e] = silu_f(out[e]);
}
__device__ __forceinline__ f32x4 conv1x4(const bf16* projb, int rowb, int posb, int col, const float* cw) {
    float x[7];
#pragma unroll
    for (int i = 0; i < 7; ++i) { const bool ok = (posb - 3 + i) >= 0; const float v = bf2f(*(const GAS unsigned short*)(projb + (size_t)(ok ? rowb - 3 + i : rowb) * NINP + col)); x[i] = ok ? v : 0.f; }
    const float w0 = cw[col], w1 = cw[3072 + col], w2 = cw[2 * 3072 + col], w3 = cw[3 * 3072 + col];
    f32x4 o;
#pragma unroll
    for (int r = 0; r < 4; ++r) o[r] = silu_f(fmaf(w3, x[r + 3], fmaf(w2, x[r + 2], fmaf(w1, x[r + 1], w0 * x[r]))));
    return o;
}

__device__ __forceinline__ void phase_dn_prep(Frame& F, const bf16* projb_, const float* convw_, const float* a_log, const float* dt_bias,
                                              bf16* wneg_, bf16* qdec_, bf16* kdec_, bf16* attn_, float* ubuf_, float* glast) {
    const int hh = F.wave;
    { const int unit = F.vcu;
        const float A_h = __expf(a_log[hh]), dtb = dt_bias[hh];
        int lane_ = (int)__builtin_amdgcn_mbcnt_hi(~0u, __builtin_amdgcn_mbcnt_lo(~0u, 0u)); asm volatile("" : "+v"(lane_));
        const int lane = lane_, fr = lane & 15, fq = lane >> 4;
        const float* convw = convw_; asm volatile("" : "+s"(convw));
        const bf16* projb = projb_; asm volatile("" : "+s"(projb));
        bf16* wneg = wneg_; bf16* qdec = qdec_; bf16* kdec = kdec_; bf16* attn = attn_; float* ubuf = ubuf_; asm volatile("" : "+s"(wneg), "+s"(qdec), "+s"(kdec), "+s"(attn), "+s"(ubuf));
        unsigned ldsb = 0; asm volatile("" : "+s"(ldsb));
        LAS float* gcs = (LAS float*)(F.lds + ldsb + PREP_SC_OFF + F.wave * 768); LAS float* bes = gcs + 64; LAS float* rnk = gcs + 128;
        LAS unsigned char* tw = F.lds + ldsb + F.wave * 16384;
        const int b = unit >> 7, n = unit & 127, t0 = n * 64, row0 = b * T + t0, cid = (b * 8 + hh) * 128 + n;
        {
            const int row = row0 + lane;
            const float bl = bf2f(projb[(size_t)row * NINP + 4096 + hh]), al = bf2f(projb[(size_t)row * NINP + 4104 + hh]);
            const float x = al + dtb; const float sp = (x > 20.f) ? x : log1pf(__expf(x));
            float c = -A_h * sp;
#pragma unroll
            for (int o = 1; o < 64; o <<= 1) { const float t = __shfl_up(c, o); if (lane >= o) c += t; }
            gcs[lane] = c; bes[lane] = 1.f / (1.f + __expf(-bl));
        }
        LDS_WAIT(); asm volatile("" ::: "memory");
        const float gl = gcs[63];
        if (lane == 0) glast[cid] = __expf(gl);
#pragma unroll 1
        for (int t = 0; t < 4; ++t) {
            int lb_ = lane; asm volatile("" : "+v"(lb_)); const int fr = lb_ & 15, fq = lb_ >> 4;
            const int tok = 16 * t + fr; float v[4][8]; float ss = 0.f;
#pragma unroll
            for (int ks = 0; ks < 4; ++ks) { conv8(projb, row0 + tok, t0 + tok, 1024 + hh * 128 + 32 * ks + 8 * fq, convw, v[ks]);
#pragma unroll
                for (int e = 0; e < 8; ++e) ss = fmaf(v[ks][e], v[ks][e], ss); }
            ss += __shfl_xor(ss, 16); ss += __shfl_xor(ss, 32);
            const float rn = 1.f / sqrtf(ss + RMS_EPS);
            if (fq == 0) rnk[tok] = rn;
            const float kd = rn * __expf(gl - gcs[tok]);
#pragma unroll
            for (int ks = 0; ks < 4; ++ks) {
                *(LAS v4u*)(tw + tok * 256 + (((4 * ks + fq) ^ fr) << 4)) = (v4u){pk2(v[ks][0] * rn, v[ks][1] * rn), pk2(v[ks][2] * rn, v[ks][3] * rn), pk2(v[ks][4] * rn, v[ks][5] * rn), pk2(v[ks][6] * rn, v[ks][7] * rn)};
                *(GAS v4u*)(kdec + ((size_t)cid * 64 + tok) * 128 + 32 * ks + 8 * fq) = (v4u){pk2(v[ks][0] * kd, v[ks][1] * kd), pk2(v[ks][2] * kd, v[ks][3] * kd), pk2(v[ks][4] * kd, v[ks][5] * kd), pk2(v[ks][6] * kd, v[ks][7] * kd)};
            }
        }
        LDS_WAIT(); asm volatile("" ::: "memory");
#define KFRAG(t_, ks_) (*(const LAS bf16x8*)(tw + (16 * (t_) + fr) * 256 + (((4 * (ks_) + fq) ^ fr) << 4)))
        bf16* attc = attn + (size_t)cid * 64 * 64;
#pragma unroll 1
        for (int ti = 0; ti < 4; ++ti) {
            int lc_ = lane; asm volatile("" : "+v"(lc_)); const int fr = lc_ & 15, fq = lc_ >> 4;
            bf16x8 qf[4];
            { const int tok = 16 * ti + fr; float v[4][8]; float ss = 0.f;
#pragma unroll
              for (int ks = 0; ks < 4; ++ks) { conv8(projb, row0 + tok, t0 + tok, hh * 128 + 32 * ks + 8 * fq, convw, v[ks]);
#pragma unroll
                  for (int e = 0; e < 8; ++e) ss = fmaf(v[ks][e], v[ks][e], ss); }
              ss += __shfl_xor(ss, 16); ss += __shfl_xor(ss, 32);
              const float rn = 1.f / sqrtf(ss + RMS_EPS);
              const float qd = rn * 0.08838834764831845f * __expf(gcs[tok]);
#pragma unroll
              for (int ks = 0; ks < 4; ++ks) {
                  qf[ks] = __builtin_bit_cast(bf16x8, (v4u){pk2(v[ks][0] * rn, v[ks][1] * rn), pk2(v[ks][2] * rn, v[ks][3] * rn), pk2(v[ks][4] * rn, v[ks][5] * rn), pk2(v[ks][6] * rn, v[ks][7] * rn)});
                  *(GAS v4u*)(qdec + ((size_t)cid * 64 + tok) * 128 + 32 * ks + 8 * fq) = (v4u){pk2(v[ks][0] * qd, v[ks][1] * qd), pk2(v[ks][2] * qd, v[ks][3] * qd), pk2(v[ks][4] * qd, v[ks][5] * qd), pk2(v[ks][6] * qd, v[ks][7] * qd)};
              } }
#pragma unroll 1
            for (int tj = 0; tj <= ti; ++tj) {
                f32x4 acc = (f32x4){0.f, 0.f, 0.f, 0.f};
#pragma unroll
                for (int ks = 0; ks < 4; ++ks) acc = MFMA32(qf[ks], KFRAG(tj, ks), acc);
                const int j = 16 * tj + fr; const float gj = gcs[j];
#pragma unroll
                for (int r = 0; r < 4; ++r) { const int i = 16 * ti + 4 * fq + r; const float a = (i >= j) ? acc[r] * 0.08838834764831845f * __expf(gcs[i] - gj) : 0.f;
                    attc[i * 64 + j] = (bf16)f2bf(a); }
            }
            if ((ti & 1) == 0) {
#pragma unroll
                for (int r = 0; r < 4; ++r) attc[(16 * ti + 4 * fq + r) * 64 + 16 * (ti + 1) + fr] = (bf16)0;
            }
        }
        s16x4v nAoff[4][4];
        s16x4v P1n[4], P2[4], P4[4], P8[4];
#pragma unroll
        for (int ti = 0; ti < 4; ++ti)
#pragma unroll
            for (int tj = 0; tj <= ti; ++tj) {
                int le_ = lane; asm volatile("" : "+v"(le_)); const int fr = le_ & 15, fq = le_ >> 4;
                f32x4 acc = (f32x4){0.f, 0.f, 0.f, 0.f};
#pragma unroll
                for (int ks = 0; ks < 4; ++ks) acc = MFMA32(KFRAG(tj, ks), KFRAG(ti, ks), acc);
                const int i = 16 * ti + fr; const float bi = bes[i], gi = gcs[i];
                f32x4 aop;
#pragma unroll
                for (int r = 0; r < 4; ++r) { const int j = 16 * tj + 4 * fq + r; aop[r] = (i > j) ? bi * acc[r] * __expf(gi - gcs[j]) : 0.f; }
                if (tj < ti) { nAoff[ti][tj] = pack4(-aop); }
                else {
                    f32x4 bop;
#pragma unroll
                    for (int r = 0; r < 4; ++r) { const int rw = 16 * ti + 4 * fq + r; bop[r] = (rw > i) ? bes[rw] * acc[r] * __expf(gcs[rw] - gi) : 0.f; }
                    const s16x4v a1 = pack4(aop), b1 = pack4(bop);
                    const f32x4 z = (f32x4){0.f, 0.f, 0.f, 0.f};
                    const s16x4v a2 = pack4(MFMA16(b1, a1, z)), b2 = pack4(MFMA16(a1, b1, z));
                    const s16x4v a4 = pack4(MFMA16(b2, a2, z)), b4 = pack4(MFMA16(a2, b2, z));
                    const s16x4v a8 = pack4(MFMA16(b4, a4, z));
                    P1n[ti] = pack4(-aop); P2[ti] = a2; P4[ti] = a4; P8[ti] = a8;
                }
            }
#undef KFRAG
#define TILE_EL(tok_, ch_) bf2f(*(const LAS unsigned short*)(tw + (tok_) * 256 + (((((ch_) >> 3)) ^ ((tok_) & 15)) << 4) + ((ch_) & 7) * 2))
#define SOLVE_PASS(PASS) do { \
        _Pragma("unroll 1") for (int c8 = 0; c8 < 8; ++c8) { \
            int lo2_ = lane; asm volatile("" : "+v"(lo2_)); const int fr = lo2_ & 15, fq = lo2_ >> 4; \
            const int ch = 16 * c8 + fr; \
            s16x4v Xb[4]; \
            _Pragma("unroll") for (int bi = 0; bi < 4; ++bi) { \
                const int tokb = 16 * bi + 4 * fq; \
                f32x4 Y; \
                _Pragma("unroll") for (int r = 0; r < 4; ++r) { const int tok = tokb + r; float f = bes[tok]; if ((PASS) == 0) f *= __expf(gcs[tok]); Y[r] = TILE_EL(tok, ch) * f; } \
                _Pragma("unroll") for (int bj = 0; bj < 4; ++bj) if (bj < bi) Y = MFMA16(nAoff[bi][bj], Xb[bj], Y); \
                Y = MFMA16(P8[bi], pack4(Y), Y); Y = MFMA16(P4[bi], pack4(Y), Y); Y = MFMA16(P2[bi], pack4(Y), Y); Y = MFMA16(P1n[bi], pack4(Y), Y); \
                Xb[bi] = pack4(Y); \
                if ((PASS) == 1) { *(GAS f32x4*)(ubuf + (size_t)cid * 64 * 128 + (size_t)((c8 * 4 + bi) * 64 + lo2_) * 4) = Y; } \
                else { _Pragma("unroll") for (int r = 0; r < 4; ++r) wneg[((size_t)cid * 64 + tokb + r) * 128 + ch] = (bf16)f2bf(-Y[r]); } \
            } } } while (0)
        SOLVE_PASS(0);
        LDS_WAIT(); asm volatile("" ::: "memory");
        {
            int lo3_ = lane; asm volatile("" : "+v"(lo3_)); const int fr = lo3_ & 15, fq = lo3_ >> 4;
#pragma unroll 1
            for (int t = 0; t < 4; ++t) {
                const int tok = 16 * t + fr;
#pragma unroll
                for (int ks = 0; ks < 4; ++ks) { float v[8]; conv8(projb, row0 + tok, t0 + tok, 2048 + hh * 128 + 32 * ks + 8 * fq, convw, v);
                    *(LAS v4u*)(tw + tok * 256 + (((4 * ks + fq) ^ fr) << 4)) = (v4u){pk2(v[0], v[1]), pk2(v[2], v[3]), pk2(v[4], v[5]), pk2(v[6], v[7])}; }
            }
        }
        LDS_WAIT(); asm volatile("" ::: "memory");
        SOLVE_PASS(1);
#undef SOLVE_PASS
#undef TILE_EL
        LDS_WAIT(); asm volatile("" ::: "memory");
    }
}

constexpr int SC_W = 0, SC_Q = 16384, SC_K = 32768, SC_A = 51200, SC_SET = 60416;
__device__ __forceinline__ bf16x8 lds_a8(const LAS unsigned char* p) {
    const unsigned long long lo = *(const LAS unsigned long long*)p, hi = *(const LAS unsigned long long*)(p + 32);
    return __builtin_bit_cast(bf16x8, (v4u){(unsigned)lo, (unsigned)(lo >> 32), (unsigned)hi, (unsigned)(hi >> 32)});
}
__device__ __forceinline__ bf16x8 lds_tr8(const LAS unsigned char* p, int rowstride16) {
    const s16x4v lo = __builtin_bit_cast(s16x4v, __builtin_amdgcn_ds_read_tr16_b64_v4i16((LAS v4i16_t*)p));
    const s16x4v hi = __builtin_bit_cast(s16x4v, __builtin_amdgcn_ds_read_tr16_b64_v4i16((LAS v4i16_t*)(p + rowstride16)));
    return (bf16x8){lo[0], lo[1], lo[2], lo[3], hi[0], hi[1], hi[2], hi[3]};
}
__device__ __forceinline__ void phase_dn_scan(Frame& F, const bf16* wneg, const bf16* qdec, const bf16* kdec, const bf16* attn, const float* ubuf, const float* glast, bf16* obuf) {
    PHASE_IDS
    const int fr = lane & 15, fq = lane >> 4;
    const int bh = F.vcu >> 1, half = F.vcu & 1, b = bh >> 3, hh = bh & 7, cid0 = bh * 128;
    LAS unsigned char* L = F.lds;
    if (F.wave >= 4) {
        const int lt = (F.wave - 4) * 64 + lane;
        v4u ra[14], rb[14], rc[14];
#define SC_LOAD(R, c) do { const size_t cb = (size_t)(cid0 + (c)) * 64 * 128; \
        _Pragma("unroll") for (int i = 0; i < 4; ++i) { const int p = lt + 256 * i; R[i] = *(const GAS v4u*)(wneg + cb + (size_t)p * 8); R[4 + i] = *(const GAS v4u*)(qdec + cb + (size_t)p * 8); R[8 + i] = *(const GAS v4u*)(kdec + cb + (size_t)p * 8); } \
        _Pragma("unroll") for (int i = 0; i < 2; ++i) { const int p = lt + 256 * i; R[12 + i] = *(const GAS v4u*)(attn + (size_t)(cid0 + (c)) * 64 * 64 + (size_t)p * 8); } } while (0)
#define SC_WRITE(R, set) do { LAS unsigned char* S_ = L + (set) * SC_SET; \
        _Pragma("unroll") for (int i = 0; i < 4; ++i) { const int p = lt + 256 * i, row = p >> 4, c16 = p & 15, sb = c16 >> 2, c = c16 & 3; \
            const int o0 = row * 256 + ((((4 * sb + ((2 * c) & 3)) ^ (row & 15)) << 4) | ((c >> 1) << 3)), o1 = row * 256 + ((((4 * sb + ((2 * c + 1) & 3)) ^ (row & 15)) << 4) | ((c >> 1) << 3)); \
            *(LAS unsigned long long*)(S_ + SC_W + o0) = (unsigned long long)R[i].x | ((unsigned long long)R[i].y << 32); *(LAS unsigned long long*)(S_ + SC_W + o1) = (unsigned long long)R[i].z | ((unsigned long long)R[i].w << 32); \
            *(LAS unsigned long long*)(S_ + SC_Q + o0) = (unsigned long long)R[4 + i].x | ((unsigned long long)R[4 + i].y << 32); *(LAS unsigned long long*)(S_ + SC_Q + o1) = (unsigned long long)R[4 + i].z | ((unsigned long long)R[4 + i].w << 32); \
            *(LAS v4u*)(S_ + SC_K + row * 288 + c16 * 16) = R[8 + i]; } \
        _Pragma("unroll") for (int i = 0; i < 2; ++i) { const int p = lt + 256 * i, row = p >> 3, c16 = p & 7, sb = c16 >> 2, c = c16 & 3; \
            const int o0 = row * 144 + 64 * sb + 16 * ((2 * c) & 3) + 8 * (c >> 1), o1 = row * 144 + 64 * sb + 16 * ((2 * c + 1) & 3) + 8 * (c >> 1); \
            *(LAS unsigned long long*)(S_ + SC_A + o0) = (unsigned long long)R[12 + i].x | ((unsigned long long)R[12 + i].y << 32); *(LAS unsigned long long*)(S_ + SC_A + o1) = (unsigned long long)R[12 + i].z | ((unsigned long long)R[12 + i].w << 32); } } while (0)
#define SC_LSTEP(R, set, n) do { if ((n) + 1 < 128) SC_WRITE(R, set); if ((n) + 4 < 128) SC_LOAD(R, (n) + 4); LDS_WAIT(); __builtin_amdgcn_s_barrier(); } while (0)
        SC_LOAD(ra, 0); SC_LOAD(rb, 1); SC_LOAD(rc, 2);
        SC_WRITE(ra, 0); SC_LOAD(ra, 3);
        LDS_WAIT(); __builtin_amdgcn_s_barrier();
#pragma unroll 1
        for (int n = 0; n < 126; n += 6) {
            SC_LSTEP(rb, 1, n); SC_LSTEP(rc, 0, n + 1); SC_LSTEP(ra, 1, n + 2); SC_LSTEP(rb, 0, n + 3); SC_LSTEP(rc, 1, n + 4); SC_LSTEP(ra, 0, n + 5);
        }
        SC_LSTEP(rb, 1, 126); SC_LSTEP(rc, 0, 127);
#undef SC_LOAD
#undef SC_WRITE
#undef SC_LSTEP
    } else {
        const int c0 = half * 64 + F.wave * 16, dvt = c0 >> 4;
        LAS unsigned char* oslab = F.lds + SCAN_O_OFF + F.wave * 2048;
        f32x4 S[8]; bf16x8 SB[4];
#pragma unroll
        for (int i = 0; i < 8; ++i) S[i] = (f32x4){0.f, 0.f, 0.f, 0.f};
#pragma unroll
        for (int i = 0; i < 4; ++i) SB[i] = (bf16x8){0, 0, 0, 0, 0, 0, 0, 0};
        f32x4 ua[4], ub2[4]; float gla, glb;
#define SC_ULOAD(UN, GL, c) do { const float* ub_ = ubuf + (size_t)(cid0 + (c)) * 64 * 128 + (size_t)(dvt * 4 * 64 + lane) * 4; \
        _Pragma("unroll") for (int mt = 0; mt < 4; ++mt) UN[mt] = *(const GAS f32x4*)(ub_ + mt * 256); GL = glast[cid0 + (c)]; } while (0)
        SC_ULOAD(ua, gla, 0); SC_ULOAD(ub2, glb, 1);
        __builtin_amdgcn_s_barrier();
#define SC_RD(f, base, stride, mt0) do { _Pragma("unroll") for (int m_ = 0; m_ < 2; ++m_) _Pragma("unroll") for (int s_ = 0; s_ < 4; ++s_) f[m_ * 4 + s_] = *(const LAS bf16x8*)(Sx + (base) + (16 * ((mt0) + m_) + fr) * 256 + (((4 * s_ + fq) ^ fr) << 4)); } while (0)
#define SC_MM(acc, f, mt0) do { _Pragma("unroll") for (int m_ = 0; m_ < 2; ++m_) _Pragma("unroll") for (int s_ = 0; s_ < 4; ++s_) acc[(mt0) + m_] = MFMA32(f[m_ * 4 + s_], SB[s_], acc[(mt0) + m_]); } while (0)
#define SC_SB() __builtin_amdgcn_sched_barrier(0)
#define SC_RDK(f, dt0) do { _Pragma("unroll") for (int d_ = 0; d_ < 4; ++d_) _Pragma("unroll") for (int p_ = 0; p_ < 2; ++p_) f[d_ * 2 + p_] = lds_tr8(Sx + SC_K + (32 * p_ + 4 * fq + (fr >> 2)) * 288 + (16 * ((dt0) + d_) + 4 * (fr & 3)) * 2, 16 * 288); } while (0)
#define SC_STEP(UN, GL) do {             const LAS unsigned char* Sx = L + (n & 1) * SC_SET; \
            f32x4 vn[4]; const float glc = GL; \
_Pragma("unroll") \
            for (int mt = 0; mt < 4; ++mt) vn[mt] = UN[mt]; \
            if (n + 2 < 128) SC_ULOAD(UN, GL, n + 2); \
            f32x4 o[4]; \
_Pragma("unroll") \
            for (int mt = 0; mt < 4; ++mt) o[mt] = (f32x4){0.f, 0.f, 0.f, 0.f}; \
            bf16x8 fa[8], fb[8]; \
            SC_RD(fa, SC_W, 256, 0); SC_RD(fb, SC_W, 256, 2); SC_SB(); \
            SC_MM(vn, fa, 0); SC_RD(fa, SC_Q, 256, 0); SC_SB(); \
            SC_MM(vn, fb, 2); SC_RD(fb, SC_Q, 256, 2); SC_SB(); \
            SC_MM(o, fa, 0); \
            fa[0] = *(const LAS bf16x8*)(Sx + SC_A + (0 + fr) * 144 + 16 * fq); fa[1] = *(const LAS bf16x8*)(Sx + SC_A + (16 + fr) * 144 + 16 * fq); \
            fa[2] = *(const LAS bf16x8*)(Sx + SC_A + (32 + fr) * 144 + 16 * fq); fa[3] = *(const LAS bf16x8*)(Sx + SC_A + (32 + fr) * 144 + 64 + 16 * fq); \
            fa[4] = *(const LAS bf16x8*)(Sx + SC_A + (48 + fr) * 144 + 16 * fq); fa[5] = *(const LAS bf16x8*)(Sx + SC_A + (48 + fr) * 144 + 64 + 16 * fq); SC_SB(); \
            SC_MM(o, fb, 2); \
            bf16x8 VB[2]; VB[0] = pack8(vn[0], vn[1]); VB[1] = pack8(vn[2], vn[3]); \
            SC_RDK(fb, 0); SC_SB(); \
            o[0] = MFMA32(fa[0], VB[0], o[0]); o[1] = MFMA32(fa[1], VB[0], o[1]); o[2] = MFMA32(fa[2], VB[0], o[2]); o[2] = MFMA32(fa[3], VB[1], o[2]); o[3] = MFMA32(fa[4], VB[0], o[3]); o[3] = MFMA32(fa[5], VB[1], o[3]); \
            SC_RDK(fa, 4); SC_SB(); \
_Pragma("unroll") \
            for (int dt = 0; dt < 8; ++dt) S[dt] = S[dt] * glc; \
_Pragma("unroll") \
            for (int dt = 0; dt < 4; ++dt) { S[dt] = MFMA32(fb[dt * 2], VB[0], S[dt]); S[dt] = MFMA32(fb[dt * 2 + 1], VB[1], S[dt]); } \
            SC_SB(); \
_Pragma("unroll") \
            for (int dt = 0; dt < 4; ++dt) { S[4 + dt] = MFMA32(fa[dt * 2], VB[0], S[4 + dt]); S[4 + dt] = MFMA32(fa[dt * 2 + 1], VB[1], S[4 + dt]); } \
_Pragma("unroll") \
            for (int mt = 0; mt < 4; ++mt) \
_Pragma("unroll") \
                for (int r = 0; r < 4; ++r) *(LAS unsigned short*)(oslab + (16 * mt + 4 * fq + r) * 32 + fr * 2) = (unsigned short)f2bf(o[mt][r]); \
            LDS_WAIT(); asm volatile("" ::: "memory"); \
            { bf16* ob = obuf + ((size_t)b * T + (size_t)n * 64) * D + hh * 128 + c0; \
_Pragma("unroll") \
              for (int i = 0; i < 2; ++i) { const int p = lane + 64 * i, tok = p >> 1, hf = p & 1; *(GAS v4u*)(ob + (size_t)tok * D + hf * 8) = *(const LAS v4u*)(oslab + p * 16); } } \
_Pragma("unroll") \
            for (int s = 0; s < 4; ++s) SB[s] = pack8(S[2 * s], S[2 * s + 1]); \
            LDS_WAIT(); __builtin_amdgcn_s_barrier(); } while (0)
#pragma unroll 1
        for (int n2 = 0; n2 < 128; n2 += 2) {
#pragma unroll
            for (int par = 0; par < 2; ++par) {
                const int n = n2 + par;
                if (par == 0) { SC_STEP(ua, gla); } else { SC_STEP(ub2, glb); }
            }
        }
#undef SC_STEP
#undef SC_RD
#undef SC_MM
#undef SC_RDK
#undef SC_ULOAD
    }
}
__device__ __forceinline__ void phase_dn_gate(Frame& F, const bf16* obuf, const bf16* projb, const float* norm_w, bf16* on) {
    PHASE_IDS
    float nw[16];
#pragma unroll
    for (int i = 0; i < 16; ++i) nw[i] = norm_w[(lane & 7) * 16 + i];
    const int gw = F.vcu * NWAVES + F.wave, NGW = F.G * NWAVES;
    for (int row = gw; row < M; row += NGW) {
        const GAS v4u* p1 = (const GAS v4u*)(obuf + (size_t)row * D) + 2 * lane; const GAS v4u* p2 = (const GAS v4u*)(projb + (size_t)row * NINP + 3072) + 2 * lane;
        const v4u a0 = p1[0], a1 = p1[1], b0 = p2[0], b1 = p2[1];
        const unsigned aw[8] = {a0.x, a0.y, a0.z, a0.w, a1.x, a1.y, a1.z, a1.w}, bw[8] = {b0.x, b0.y, b0.z, b0.w, b1.x, b1.y, b1.z, b1.w};
        float o[16], z[16]; float ss = 0.f;
#pragma unroll
        for (int i = 0; i < 8; ++i) { o[2 * i] = __uint_as_float(aw[i] << 16); o[2 * i + 1] = __uint_as_float(aw[i] & 0xffff0000u); z[2 * i] = __uint_as_float(bw[i] << 16); z[2 * i + 1] = __uint_as_float(bw[i] & 0xffff0000u);
            ss += o[2 * i] * o[2 * i] + o[2 * i + 1] * o[2 * i + 1]; }
        ss += __shfl_xor(ss, 1); ss += __shfl_xor(ss, 2); ss += __shfl_xor(ss, 4);
        const float r = 1.f / sqrtf(ss * (1.f / 128.f) + RMS_EPS);
        float y[16];
#pragma unroll
        for (int i = 0; i < 16; ++i) y[i] = o[i] * r * nw[i] * silu_f(z[i]);
        v4u w0, w1;
        w0.x = pk2(y[0], y[1]); w0.y = pk2(y[2], y[3]); w0.z = pk2(y[4], y[5]); w0.w = pk2(y[6], y[7]);
        w1.x = pk2(y[8], y[9]); w1.y = pk2(y[10], y[11]); w1.z = pk2(y[12], y[13]); w1.w = pk2(y[14], y[15]);
        GAS v4u* q = (GAS v4u*)(on + (size_t)row * D) + 2 * lane; q[0] = w0; q[1] = w1;
    }
}
#define PH(l, k) (1 + 16 * (l) + (k))
__global__ void __launch_bounds__(NWAVES * 64, 2) mega(Args args) {
    extern __shared__ __attribute__((aligned(16))) unsigned char lds[];
    Frame F;
    F.lds = (LAS unsigned char*)lds; F.MISC = (volatile LAS unsigned*)(F.lds + MISC_OFF);
    F.wave = __builtin_amdgcn_readfirstlane((int)threadIdx.x >> 6);
    F.G = gridDim.x; { const int bx = blockIdx.x; F.vcu = (F.G % 8 == 0) ? (bx % 8) * (F.G / 8) + bx / 8 : bx; }
    F.ws = args.ws; F.ctl = (gu32*)(args.ws + WS_CTL);
    for (int u = threadIdx.x; u < (LDS_BYTES - LDSCTL_OFF) / 4; u += NWAVES * 64) ((LAS unsigned*)(F.lds + LDSCTL_OFF))[u] = 0u;
    __syncthreads();
    const int lo = args.ph_lo, hi = args.ph_hi;
    XcdBarrier bar; bar.bar = (unsigned*)(F.ctl + CW_BAR) + args.bar_region * XCD_BAR_WORDS; bar.x = 0; bar.st = nullptr;
    if (hi - lo > 1) bar = xcd_barrier_post((unsigned*)(F.ctl + CW_BAR) + args.bar_region * XCD_BAR_WORDS, F.MISC + 8, F.wave);
    unsigned char* ws = args.ws;
    bf16* hb = (bf16*)(ws + WS_HB); float* hbuf = (float*)(ws + WS_H); float* h1 = (float*)(ws + WS_H1); bf16* h1b = (bf16*)(ws + WS_H1B);
    bf16* projb = (bf16*)(ws + WS_PROJ); bf16* Kb = (bf16*)(ws + WS_KB); bf16* Qb = Kb - (size_t)M * D; bf16* onb = (bf16*)(ws + WS_ON); float* mix = (float*)(ws + WS_MIX);
    int* eid = (int*)(ws + WS_EID); float* gate = (float*)(ws + WS_GATE); int* apos = (int*)(ws + WS_APOS);
    bf16* xrows = (bf16*)(ws + WS_XROWS); bf16* hid = (bf16*)(ws + WS_HID); bf16* yrows = (bf16*)(ws + WS_YROWS);
    LAS int* tile_e = (LAS int*)(F.lds + TILEE_OFF); LAS int* psl = (LAS int*)(F.lds + 20480);

#ifndef REPSEL
#define REPSEL(p) 0
#endif
#define IN(p) (lo <= (p) && (p) < hi)
#ifdef PROBE_A
#define STAMP() do { if (blockIdx.x == 0 && F.wave == 0 && __builtin_amdgcn_mbcnt_hi(~0u, __builtin_amdgcn_mbcnt_lo(~0u, 0u)) == 0u) { const unsigned n_ = F.MISC[12]; ((volatile LAS unsigned long long*)(F.lds + STAMP_OFF))[n_] = rt(); F.MISC[12] = n_ + 1; } } while (0)
#else
#define STAMP() do { } while (0)
#endif
#define SEAM(p) do { if ((p) + 1 < hi) xcd_barrier(bar, F.wave); STAMP(); } while (0)
#define DO_PHASE(p, cond, ...) do { if ((cond) && IN(p)) { { const int rep_ = 0; (void)rep_; __VA_ARGS__ } SEAM(p); if (REPSEL(p)) { { const int rep_ = REPSEL(p); (void)rep_; __VA_ARGS__ } if ((p) + 1 < hi) xcd_barrier(bar, F.wave); } } } while (0)
    STAMP();
    DO_PHASE(0, true, p0_prologue(F, args););
#define LAYER(l) do { \
    gu32* counts = F.ctl + CW_CNT + 128 * (l); gu32* cursor = counts + 64; \
    DO_PHASE(PH(l, 0), true, \
        if ((l) < 2) { pg8::Gemm g{hb, (const bf16*)(ws + WS_WIN) + (size_t)(l) * NINP * D, M, NINP, D}; pg8::StaticOrder S; S.init(M, NINP, F.G, (int)blockIdx.x); \
            pg8::EpiBf16<0> E{projb, NINP, nullptr, 0, 0, 1.f}; pg8::gemm_phase<pg8::EpiBf16<0>, pg8::StaticOrder, true, true>(F.lds, g, S, E, F.wave); } \
        else { const int NQ = ((l) == 2) ? 3 * D : D; pg8::Gemm g{hb, (const bf16*)(ws + ((l) == 2 ? WS_WQKV : WS_WQ3)), M, NQ, D}; pg8::StaticOrder S; S.init(M, NQ, F.G, (int)blockIdx.x); \
            pg8::EpiBf16<0> E{Qb, D, nullptr, D, (size_t)M * D, QSCALE}; pg8::gemm_phase<pg8::EpiBf16<0>, pg8::StaticOrder, true, true>(F.lds, g, S, E, F.wave); } ); \
    DO_PHASE(PH(l, 1), (l) < 2, \
        phase_dn_prep(F, projb, args.in[2] + (size_t)(l) * 4 * 3072, args.in[3] + (l) * 8, args.in[4] + (l) * 8, (bf16*)(ws + WS_WNEG), (bf16*)(ws + WS_QDEC), (bf16*)(ws + WS_KDEC), (bf16*)(ws + WS_ATT), (float*)(ws + WS_U), (float*)(ws + WS_GLAST)); ); \
    DO_PHASE(PH(l, 2), (l) < 2, \
        if (F.vcu >= 32) { if (rep_ != 1) p0_moe_weights(F, args, 2 * (l), F.vcu - 32, F.G - 32); } \
        else if (rep_ != 2) phase_dn_scan(F, (const bf16*)(ws + WS_WNEG), (const bf16*)(ws + WS_QDEC), (const bf16*)(ws + WS_KDEC), (const bf16*)(ws + WS_ATT), (const float*)(ws + WS_U), (const float*)(ws + WS_GLAST), (bf16*)(ws + WS_OB)); ); \
    DO_PHASE(PH(l, 3), (l) < 2, \
        phase_dn_gate(F, (const bf16*)(ws + WS_OB), projb, args.in[5] + (l) * 128, onb); ); \
    DO_PHASE(PH(l, 1), (l) >= 2, \
        const attn_body::AttnTensors AT{(const attn_body::bf16*)Qb, (const attn_body::bf16*)Kb, (const attn_body::bf16*)(ws + WS_VB), (attn_body::bf16*)projb, (attn_body::bf16*)(projb + (size_t)M * D)}; \
        const attn_body::StaticOrder S((int)F.G, (int)blockIdx.x); \
        attn_body::attn_phase<attn_body::StaticOrder>((char*)lds, AT, S, F.wave); ); \
    DO_PHASE(PH(l, 3), (l) >= 2, \
        phase_attn_combine(F, projb, projb + (size_t)M * D, args.in[9] + ((l) - 2) * 256, args.in[10] + ((l) - 2) * 128, args.lam_init[(l) & 1], onb); ); \
    DO_PHASE(PH(l, 4), true, \
        const bf16* W = ((l) < 2) ? (const bf16*)(ws + WS_WAOUT) + (size_t)(l) * D * D : (const bf16*)(ws + WS_WBOUT) + (size_t)((l) - 2) * D * D; \
        pg8::Gemm g{onb, W, M, D, D}; pg8::StaticOrder S; S.init(M, D, F.G, (int)blockIdx.x); \
        pg8::EpiF32 E{mix, D}; pg8::gemm_phase<pg8::EpiF32, pg8::StaticOrder, true, true>(F.lds, g, S, E, F.wave); ); \
    DO_PHASE(PH(l, 5), true, const float* hin = ((l) == 0) ? args.in[0] : hbuf; \
        phase_ln1_router(F, hin, mix, args.in[12] + (l) * D, args.in[13] + (l) * D, h1, h1b, (const bf16*)(ws + WS_WR) + (size_t)(l) * 48 * D, eid, gate, counts); ); \
    DO_PHASE(PH(l, 6), true, phase_scatter(F, counts, cursor, eid, h1b, xrows, apos); ); \
    DO_PHASE(PH(l, 7), true, const int ntiles = moe_layout(F, counts, psl, tile_e); \
        pg8::Gemm g{xrows, (const bf16*)(ws + WS_W13) + (size_t)(l) * 32 * 1024 * 1024, NROWS2, 1024, 1024}; pg8::MoeOrder S{ntiles * 4, F.G, F.vcu, tile_e}; \
        pg8::EpiSwiGLU E{hid, 512}; pg8::gemm_phase<pg8::EpiSwiGLU, pg8::MoeOrder, true, true>(F.lds, g, S, E, F.wave); ); \
    DO_PHASE(PH(l, 8), true, const int ntiles = moe_layout(F, counts, psl, tile_e); \
        pg8::Gemm g{hid, (const bf16*)(ws + WS_W2) + (size_t)(l) * 32 * 1024 * 512, NROWS2, 1024, 512}; pg8::MoeOrder S{ntiles * 4, F.G, F.vcu, tile_e}; \
        pg8::EpiBf16G E{yrows, 1024, 3}; pg8::gemm_phase<pg8::EpiBf16G, pg8::MoeOrder, true, true>(F.lds, g, S, E, F.wave); ); \
    DO_PHASE(PH(l, 9), true, float* hout = ((l) == 3) ? args.out : hbuf; \
        phase_combine_ln2(F, h1, yrows, apos, gate, args.in[14] + (l) * D, args.in[15] + (l) * D, hout, hb); ); \
    } while (0)
    LAYER(0); LAYER(1); LAYER(2); LAYER(3);
#ifdef PROBE_A
    if (blockIdx.x == 0 && F.wave == 0 && __builtin_amdgcn_mbcnt_hi(~0u, __builtin_amdgcn_mbcnt_lo(~0u, 0u)) == 0u) {
        asm volatile("s_waitcnt vmcnt(0)" ::: "memory");
        volatile LAS unsigned long long* st = (volatile LAS unsigned long long*)(F.lds + STAMP_OFF);
        const float da = (PROBE_A >= 0) ? (float)(st[PROBE_A + 1] - st[PROBE_A]) * 0.01f : 1000.f;
        const float db = (PROBE_B >= 0) ? (float)(st[PROBE_B + 1] - st[PROBE_B]) * 0.01f : 0.f;
        args.out[0] = da; args.out[1] = db;
    }
#endif
#undef LAYER
#undef IN
#undef SEAM
#undef DO_PHASE
#undef STAMP
}

__global__ __launch_bounds__(256) void b2f_k(const unsigned short* __restrict__ src, int lds_, float* __restrict__ dst, int ldd, int cols, float scale) {
    const int row = blockIdx.x; for (int c = threadIdx.x; c < cols; c += 256) dst[(size_t)row * ldd + c] = __uint_as_float((unsigned)src[(size_t)row * lds_ + c] << 16) * scale;
}
__global__ __launch_bounds__(256) void f2b_k(const float* __restrict__ src, int lds_, unsigned short* __restrict__ dst, int ldd, int cols) {
    const int row = blockIdx.x; for (int c = threadIdx.x; c < cols; c += 256) dst[(size_t)row * ldd + c] = (unsigned short)f2bf(src[(size_t)row * lds_ + c]);
}

extern "C" void kernel_launch(void* const* d_in, const int* in_sizes, int n_in, void* d_out, int out_size, void* d_ws, size_t ws_size, hipStream_t stream) {
    static int grid = 0;
    if (grid == 0) {
        int dev = 0, cus = 0;
        if (hipGetDevice(&dev) != hipSuccess || hipDeviceGetAttribute(&cus, hipDeviceAttributeMultiprocessorCount, dev) != hipSuccess) { fprintf(stderr, "kernel_launch: device query failed\n"); grid = -1; return; }
        if (hipFuncSetAttribute((const void*)mega, hipFuncAttributeMaxDynamicSharedMemorySize, LDS_BYTES) != hipSuccess) { fprintf(stderr, "kernel_launch: hipFuncSetAttribute failed\n"); grid = -1; return; }
        int per_cu = 0; (void)hipOccupancyMaxActiveBlocksPerMultiprocessor(&per_cu, (const void*)mega, NWAVES * 64, LDS_BYTES); (void)hipGetLastError();
        if (per_cu < 1) fprintf(stderr, "kernel_launch: occupancy query says %d blocks per CU\n", per_cu);
        grid = cus;
        if (grid != 256) { fprintf(stderr, "kernel_launch: this kernel is built for a 256-CU device (got %d CUs); nothing launched\n", grid); grid = -1; return; }
    }
    if (grid < 0) return;
    unsigned char* ws = (unsigned char*)d_ws;
    if (WS_DN_END > ws_size) { fprintf(stderr, "kernel_launch: workspace too small: need %zu have %zu\n", (size_t)WS_DN_END, ws_size); return; }
    (void)hipMemsetAsync(ws + WS_CTL, 0, CTL_ZERO_BYTES, stream);
    Args a{};
    for (int i = 0; i < 20; ++i) a.in[i] = (const float*)d_in[i];
    a.out = (float*)d_out; a.ws = ws; a.lam_init[0] = (float)(0.8 - 0.6 * exp(-0.3 * 2.0)); a.lam_init[1] = (float)(0.8 - 0.6 * exp(-0.3 * 3.0));
    int nlaunch = 0;
    auto mk = [&](int lo, int hi) { a.ph_lo = lo; a.ph_hi = hi; a.bar_region = nlaunch++; hipLaunchKernelGGL(mega, dim3(grid), dim3(NWAVES * 64), LDS_BYTES, stream, a); };
#ifndef MULTI_LAUNCH
    mk(0, PH(3, 9) + 1);
#else
    mk(0, 1);
    for (int l = 0; l < 4; ++l) mk(PH(l, 0), PH(l, 9) + 1);
#endif
}
```

```cpp
#include <hip/hip_runtime.h>
#include <stdint.h>
#include <stdio.h>
#include <math.h>
#include <cstdint>
namespace pg8 {
#define PG8_LAS __attribute__((address_space(3)))
typedef unsigned short bf16_t;
typedef short bf16x8 __attribute__((ext_vector_type(8)));
typedef float f32x4 __attribute__((ext_vector_type(4)));
typedef unsigned u32x4 __attribute__((ext_vector_type(4)));
constexpr int BM = 256, BK = 64, HALF = 128, HTB = HALF * BK * 2  , STAGE_BYTES = 8 * HTB, NXCD = 8, WGM = 8;

__host__ __device__ __forceinline__ int lds_byte(int r, int c) { const int st = (r >> 4) * 2 + (c >> 5), rr = r & 15, cc = c & 31, ob = rr * 64 + cc * 2; return st * 1024 + (ob ^ (((ob >> 9) & 1) << 5)); }
__host__ __device__ __forceinline__ void stage_rc(int b, int& R, int& C) { const int st = b / 1024, sb = b % 1024, swz = sb ^ (((sb >> 9) & 1) << 5); R = (st >> 1) * 16 + swz / 64; C = (st & 1) * 32 + (swz % 64) / 2; }
__host__ __device__ __forceinline__ int perm32(int rho) { const int n = rho >> 4, i = rho & 15; return 8 * (i >> 2) + 4 * n + (i & 3); }

struct Unit { int pm, pn; };
struct Gemm { const bf16_t* A; const bf16_t* Bt; int M, N, K; };

struct StaticOrder {
    int nM, nN, nwg, G, c;
    __host__ __device__ void init(int M, int N, int G_, int c_) { nM = M / BM; nN = N / BM; nwg = nM * nN; G = G_; c = c_; }
    __host__ __device__ bool next(int i, Unit& u) const {
        const long L = (long)i * G + c; if (L >= nwg) return false;
        int wgid = (int)L; { const int q = nwg / NXCD, r = nwg % NXCD, xcd = wgid % NXCD, off = wgid / NXCD; wgid = (xcd < r ? xcd * (q + 1) : r * (q + 1) + (xcd - r) * q) + off; }
        const int nig = WGM * nN, gid = wgid / nig, fm = gid * WGM, gsz = (nM - fm) < WGM ? (nM - fm) : WGM;
        u.pm = fm + ((wgid % nig) % gsz); u.pn = (wgid % nig) / gsz; return true;
    }
    __device__ __forceinline__ void a_ready(const Unit&) const {}
    __device__ __forceinline__ void done(const Unit&) const {}
};

__device__ __forceinline__ unsigned cvt_pk_bf16(float lo, float hi) { unsigned r; asm volatile("v_cvt_pk_bf16_f32 %0, %1, %2" : "=v"(r) : "v"(lo), "v"(hi)); return r; }
typedef float f32x2 __attribute__((ext_vector_type(2)));
__device__ __forceinline__ f32x2 gelu_pk(f32x2 v) {
    const f32x2 av = __builtin_elementwise_abs(v), d = av * 0.2316418882f + 1.0f;
    f32x2 t; t.x = __builtin_amdgcn_rcpf(d.x); t.y = __builtin_amdgcn_rcpf(d.y);
    f32x2 q = t * 0.5307027145f + (-0.7265760135f); q = q * t + 0.7107068705f; q = q * t + (-0.142248368f); q = q * t + 0.127414796f; q = q * t;
    const f32x2 s = (v * v) * (-0.72134752044f);
    f32x2 e; e.x = __builtin_amdgcn_exp2f(s.x); e.y = __builtin_amdgcn_exp2f(s.y);
    const f32x2 m = v * (q * e), r = v - m;
    f32x2 o; o.x = v.x < 0.f ? m.x : r.x; o.y = v.y < 0.f ? m.y : r.y; return o;
}

template <int ACT  > struct EpiBf16 {
    static constexpr bool PERM = true, AFTER_DRAIN = false; static_assert(ACT == 0 || ACT == 1, "EpiBf16: ACT is 0 (none) or 1 (gelu_pk)");
    bf16_t* O; int ldc; const float* bias; int split_cols; size_t split_stride; float scale0;
    __device__ __forceinline__ void operator()(const f32x4 (&acc)[2][2][4][2], const Unit& u, int wr, int wc, int fr, int fq) const {
        const int row0 = u.pm * BM + wr * 64 + fr; int colt = u.pn * BM; bf16_t* base = O;
        float sc = 1.f; if (split_cols) { const int t = colt / split_cols; base += (size_t)t * split_stride; colt -= t * split_cols; if (t == 0) sc = scale0; }
        const int col0 = colt + wc * 32 + 8 * fq, bcol0 = u.pn * BM + wc * 32 + 8 * fq;
        f32x4 bv[2][2];
#pragma unroll
        for (int bj = 0; bj < 2; ++bj)
#pragma unroll
            for (int n = 0; n < 2; ++n) bv[bj][n] = bias ? *(const f32x4*)(bias + bcol0 + bj * HALF + 4 * n) : (f32x4){0.f, 0.f, 0.f, 0.f};
#pragma unroll
        for (int ai = 0; ai < 2; ++ai)
#pragma unroll
            for (int m = 0; m < 4; ++m) { bf16_t* rowp = base + (size_t)(row0 + ai * HALF + m * 16) * ldc + col0;
#pragma unroll
                for (int bj = 0; bj < 2; ++bj) { f32x4 v0 = acc[ai][bj][m][0] + bv[bj][0], v1 = acc[ai][bj][m][1] + bv[bj][1];
                    if (ACT == 1) { f32x2 a = gelu_pk((f32x2){v0[0], v0[1]}), b = gelu_pk((f32x2){v0[2], v0[3]}), c = gelu_pk((f32x2){v1[0], v1[1]}), d = gelu_pk((f32x2){v1[2], v1[3]});
                        v0 = (f32x4){a.x, a.y, b.x, b.y}; v1 = (f32x4){c.x, c.y, d.x, d.y}; }
                    v0 = v0 * sc; v1 = v1 * sc; u32x4 w; w.x = cvt_pk_bf16(v0[0], v0[1]); w.y = cvt_pk_bf16(v0[2], v0[3]); w.z = cvt_pk_bf16(v1[0], v1[1]); w.w = cvt_pk_bf16(v1[2], v1[3]);
                    *(u32x4*)(rowp + bj * HALF) = w; } }
    }
};

struct PanelStats {
    unsigned* xbuf;
    unsigned* cnt;
    unsigned* tmo;
    int ntn; float eps;
    unsigned code;
    __device__ __forceinline__ bool run(const f32x4 (&v)[2][2][4][2], const Unit& u, int wr, int wc, int fr, int fq, PG8_LAS unsigned char* lds, int wid, int lane) const {
        typedef float f32x2v __attribute__((ext_vector_type(2)));
        PG8_LAS f32x2v* P = (PG8_LAS f32x2v*)lds;
        PG8_LAS f32x2v* S = (PG8_LAS f32x2v*)(lds + 8192);
        PG8_LAS unsigned* flag = (PG8_LAS unsigned*)(lds + 8192 + 2048);
#pragma unroll
        for (int ai = 0; ai < 2; ++ai)
#pragma unroll
            for (int m = 0; m < 4; ++m) {
                float s = 0.f;
#pragma unroll
                for (int bj = 0; bj < 2; ++bj)
#pragma unroll
                    for (int n = 0; n < 2; ++n) { const f32x4 x = v[ai][bj][m][n]; s += (x[0] + x[1]) + (x[2] + x[3]); }
                s += __shfl_xor(s, 16); s += __shfl_xor(s, 32);
                const float mw = s * (1.0f / 64.0f); float q = 0.f;
#pragma unroll
                for (int bj = 0; bj < 2; ++bj)
#pragma unroll
                    for (int n = 0; n < 2; ++n) { const f32x4 d = v[ai][bj][m][n] - mw; q += (d[0] * d[0] + d[1] * d[1]) + (d[2] * d[2] + d[3] * d[3]); }
                q += __shfl_xor(q, 16); q += __shfl_xor(q, 32);
                if (fq == 0) P[(ai * HALF + wr * 64 + m * 16 + fr) * 4 + wc] = (f32x2v){mw, q};
            }
        asm volatile("s_waitcnt lgkmcnt(0)" ::: "memory"); __builtin_amdgcn_s_barrier(); asm volatile("" ::: "memory");
#if defined(BROKEN_EXCHANGE_NO_WAIT)
#warning BROKEN CONTROL BUILD: the row-statistics exchange does not wait; results are wrong by design
        if (blockIdx.x >= 64) { const long long t0_ = clock64(); while (clock64() - t0_ < 60000) __builtin_amdgcn_s_sleep(8); }
#endif
        const int row = wid * 32 + (lane & 31);
        if (lane < 32) {
            const f32x2v a = P[row * 4 + 0], b = P[row * 4 + 1], c = P[row * 4 + 2], d = P[row * 4 + 3];
            const float mt = (a.x + b.x + c.x + d.x) * 0.25f;
            const float da = a.x - mt, db = b.x - mt, dc = c.x - mt, dd = d.x - mt;
            const float m2 = (a.y + b.y) + (c.y + d.y) + 64.0f * ((da * da + db * db) + (dc * dc + dd * dd));
            unsigned long long* slot = (unsigned long long*)xbuf + ((size_t)(u.pm * BM + row) * 4 + u.pn);
            __hip_atomic_store(slot, ((unsigned long long)__float_as_uint(m2) << 32) | __float_as_uint(mt), __ATOMIC_RELAXED, __HIP_MEMORY_SCOPE_AGENT);
        }
        asm volatile("s_waitcnt vmcnt(0)" ::: "memory");
        if (lane == 0) __hip_atomic_fetch_add(cnt + 64 * u.pm, 1u, __ATOMIC_RELAXED, __HIP_MEMORY_SCOPE_AGENT);
        if (wid == 0) {
            bool dead = false; const unsigned long long t0 = __builtin_amdgcn_s_memrealtime(); const unsigned want = 8u * (unsigned)ntn;
            for (;;) {
#if defined(BROKEN_EXCHANGE_NO_WAIT)
                break;
#endif
                if ((unsigned)__builtin_amdgcn_readfirstlane(__hip_atomic_load(cnt + 64 * u.pm, __ATOMIC_RELAXED, __HIP_MEMORY_SCOPE_AGENT)) >= want) break;
                if (__builtin_amdgcn_s_memrealtime() - t0 > 2000000ull) {
                    if (lane == 0) { unsigned expect = 0u; __hip_atomic_compare_exchange_strong(tmo + 1, &expect, code | (unsigned)(u.pm & 0xff), __ATOMIC_RELAXED, __ATOMIC_RELAXED, __HIP_MEMORY_SCOPE_AGENT);
                                     __hip_atomic_store(tmo, 1u, __ATOMIC_RELAXED, __HIP_MEMORY_SCOPE_AGENT); }
                    dead = true; break; }
                __builtin_amdgcn_s_sleep(2);
            }
            __builtin_amdgcn_fence(__ATOMIC_ACQUIRE, "agent");
            if (lane == 0) flag[0] = dead ? 1u : 0u;
        }
        asm volatile("s_waitcnt vmcnt(0) lgkmcnt(0)" ::: "memory"); __builtin_amdgcn_s_barrier(); asm volatile("" ::: "memory");
        const bool bad = flag[0] != 0u;
        if (lane < 32) {
            const unsigned long long* slot = (const unsigned long long*)xbuf + (size_t)(u.pm * BM + row) * 4; float mt[4], m2[4]; float ms = 0.f;
#pragma unroll
            for (int t = 0; t < 4; ++t) { if (t < ntn) { const unsigned long long w = __hip_atomic_load(slot + t, __ATOMIC_RELAXED, __HIP_MEMORY_SCOPE_AGENT); mt[t] = __uint_as_float((unsigned)w); m2[t] = __uint_as_float((unsigned)(w >> 32)); } else { mt[t] = 0.f; m2[t] = 0.f; } ms += mt[t]; }
            const float mean = ms / (float)ntn; float q = 0.f;
#pragma unroll
            for (int t = 0; t < 4; ++t) if (t < ntn) { const float dm = mt[t] - mean; q += m2[t] + 256.0f * dm * dm; }
            S[row] = (f32x2v){mean, 1.0f / sqrtf(q / (256.0f * (float)ntn) + eps)};
        }
        asm volatile("s_waitcnt lgkmcnt(0)" ::: "memory"); __builtin_amdgcn_s_barrier(); asm volatile("" ::: "memory");
        return bad;
    }
};
struct EpiLnRes {
    static constexpr bool PERM = false, AFTER_DRAIN = true;
    const float* base; float* out; int ldc; const float* bias; PanelStats st; unsigned poison;
    __device__ __forceinline__ void fused(f32x4 (&acc)[2][2][4][2], const Unit& u, int wr, int wc, int fr, int fq, PG8_LAS unsigned char* lds, int wid, int lane) const {
        typedef float f32x2v __attribute__((ext_vector_type(2)));
        const PG8_LAS f32x2v* S = (const PG8_LAS f32x2v*)(lds + 8192);
        const int col0 = u.pn * BM + wc * 32 + 4 * fq;
#pragma unroll
        for (int bj = 0; bj < 2; ++bj)
#pragma unroll
            for (int n = 0; n < 2; ++n) { const f32x4 bv = bias ? *(const f32x4*)(bias + col0 + bj * HALF + n * 16) : (f32x4){0.f, 0.f, 0.f, 0.f};
#pragma unroll
                for (int ai = 0; ai < 2; ++ai)
#pragma unroll
                    for (int m = 0; m < 4; ++m) acc[ai][bj][m][n] += bv; }
        f32x4 pre[4][2][2];
#pragma unroll
        for (int m = 0; m < 4; ++m) { const size_t off = (size_t)(u.pm * BM + wr * 64 + m * 16 + fr) * ldc + col0;
#pragma unroll
            for (int bj = 0; bj < 2; ++bj)
#pragma unroll
                for (int n = 0; n < 2; ++n) pre[m][bj][n] = *(const f32x4*)(base + off + bj * HALF + n * 16); }
        const bool bad = st.run(acc, u, wr, wc, fr, fq, lds, wid, lane) || poison != 0u;
        const float qnan = __builtin_nanf("");
#pragma unroll
        for (int ai = 0; ai < 2; ++ai)
#pragma unroll
            for (int m = 0; m < 4; ++m) { const int r = ai * HALF + wr * 64 + m * 16 + fr; const f32x2v sr = S[r]; const size_t off = (size_t)(u.pm * BM + r) * ldc + col0;
#pragma unroll
                for (int bj = 0; bj < 2; ++bj)
#pragma unroll
                    for (int n = 0; n < 2; ++n) { const f32x4 bs = ai == 0 ? pre[m][bj][n] : *(const f32x4*)(base + off + bj * HALF + n * 16); f32x4 o = bs + (acc[ai][bj][m][n] - sr.x) * sr.y;
                        if (bad) o = (f32x4){qnan, qnan, qnan, qnan}; *(f32x4*)(out + off + bj * HALF + n * 16) = o; }
                if (m & 1) asm volatile("" ::: "memory"); }
    }
};
struct EpiLnResLn {
    static constexpr bool PERM = false, AFTER_DRAIN = true;
    const float* base; float* out; bf16_t* xn; int ldc; const float* bias; PanelStats st1, st2; unsigned poison;
    __device__ __forceinline__ void fused(f32x4 (&acc)[2][2][4][2], const Unit& u, int wr, int wc, int fr, int fq, PG8_LAS unsigned char* lds, int wid, int lane) const {
        typedef float f32x2v __attribute__((ext_vector_type(2))); typedef unsigned u32x2v __attribute__((ext_vector_type(2)));
        const PG8_LAS f32x2v* S = (const PG8_LAS f32x2v*)(lds + 8192);
        const int col0 = u.pn * BM + wc * 32 + 4 * fq;
#pragma unroll
        for (int bj = 0; bj < 2; ++bj)
#pragma unroll
            for (int n = 0; n < 2; ++n) { const f32x4 bv = bias ? *(const f32x4*)(bias + col0 + bj * HALF + n * 16) : (f32x4){0.f, 0.f, 0.f, 0.f};
#pragma unroll
                for (int ai = 0; ai < 2; ++ai)
#pragma unroll
                    for (int m = 0; m < 4; ++m) acc[ai][bj][m][n] += bv; }
        bool bad = st1.run(acc, u, wr, wc, fr, fq, lds, wid, lane) || poison != 0u;
        const float qnan = __builtin_nanf("");
#pragma unroll
        for (int ai = 0; ai < 2; ++ai)
#pragma unroll
            for (int m = 0; m < 4; ++m) { const int r = ai * HALF + wr * 64 + m * 16 + fr; const f32x2v sr = S[r]; const size_t off = (size_t)(u.pm * BM + r) * ldc + col0;
#pragma unroll
                for (int bj = 0; bj < 2; ++bj)
#pragma unroll
                    for (int n = 0; n < 2; ++n) { const f32x4 bs = *(const f32x4*)(base + off + bj * HALF + n * 16); acc[ai][bj][m][n] = bs + (acc[ai][bj][m][n] - sr.x) * sr.y; }
                asm volatile("" : "+v"(acc[ai][0][m][0]), "+v"(acc[ai][0][m][1]), "+v"(acc[ai][1][m][0]), "+v"(acc[ai][1][m][1]));
                if (m & 1) asm volatile("" ::: "memory"); }
        const bool bad1 = bad;
        bad = st2.run(acc, u, wr, wc, fr, fq, lds, wid, lane) || bad;
#pragma unroll
        for (int ai = 0; ai < 2; ++ai)
#pragma unroll
            for (int m = 0; m < 4; ++m) { const int r = ai * HALF + wr * 64 + m * 16 + fr; const f32x2v sr = S[r]; const size_t off = (size_t)(u.pm * BM + r) * ldc + col0;
#pragma unroll
                for (int bj = 0; bj < 2; ++bj)
#pragma unroll
                    for (int n = 0; n < 2; ++n) { const f32x4 x1 = acc[ai][bj][m][n]; *(f32x4*)(out + off + bj * HALF + n * 16) = bad1 ? (f32x4){qnan, qnan, qnan, qnan} : x1;
                        const f32x4 o = (x1 - sr.x) * sr.y; u32x2v w; w.x = cvt_pk_bf16(o[0], o[1]); w.y = cvt_pk_bf16(o[2], o[3]);
                        if (bad) { w.x = 0x7fc07fc0u; w.y = 0x7fc07fc0u; } *(u32x2v*)(xn + off + bj * HALF + n * 16) = w; }
                asm volatile("" ::: "memory"); }
    }
};

template <class Epi, class Sched, bool ALIGN_EPI = false, bool SP2 = false>
__device__ __forceinline__ void gemm_phase(PG8_LAS unsigned char* lds, const Gemm g, const Sched& S, const Epi& E, const int wave_id) {
    int tid_ = wave_id * 64 + (int)__builtin_amdgcn_mbcnt_hi(~0u, __builtin_amdgcn_mbcnt_lo(~0u, 0u)); asm volatile("" : "+v"(tid_));
    const int tid = tid_, wid = __builtin_amdgcn_readfirstlane(tid >> 6), lane = tid & 63, wr = wid >> 2, wc = wid & 3, fr = lane & 15, fq = lane >> 4;
    const int K = g.K, nt = K / BK;
    unsigned voffA[2], voffB[2];
#pragma unroll
    for (int i = 0; i < 2; ++i) { int R, C; stage_rc(tid * 16 + i * 8192, R, C); const int Rb = Epi::PERM ? ((R & ~31) + perm32(R & 31)) : R;
        voffA[i] = (unsigned)(R * K + C) * 2u; voffB[i] = (unsigned)(Rb * K + C) * 2u; }
    const size_t kstep = (size_t)(BK * 2);
    const size_t hstep = (size_t)HALF * K * 2;
    const size_t tstep = 2 * hstep;
    const unsigned ldsw = (unsigned)wid * 1024u;
    const int aoff = lds_byte(wr * 64 + fr, fq * 8), boff = lds_byte(wc * 32 + fr, fq * 8);
#define PG8_SA(b, h) (((b) * 2 + (h)) * HTB)
#define PG8_SB(b, h) ((4 + (b) * 2 + (h)) * HTB)
#define PG8_STAGE(bufoff, gbase, voff) do { _Pragma("unroll") for (int _i = 0; _i < 2; ++_i) \
        __builtin_amdgcn_global_load_lds((const unsigned*)((const char*)(gbase) + (voff)[_i]), (PG8_LAS unsigned*)(lds + (bufoff) + ldsw + _i * 8192), 16, 0, 0); } while (0)
#define PG8_LDA(dst, b, h) do { _Pragma("unroll") for (int m = 0; m < 4; ++m) _Pragma("unroll") for (int k = 0; k < 2; ++k) dst[m][k] = *(const PG8_LAS bf16x8*)(lds + PG8_SA(b, h) + aoff + m * 2048 + k * 1024); } while (0)
#define PG8_LDB(dst, b, h) do { _Pragma("unroll") for (int n = 0; n < 2; ++n) _Pragma("unroll") for (int k = 0; k < 2; ++k) dst[n][k] = *(const PG8_LAS bf16x8*)(lds + PG8_SB(b, h) + boff + n * 2048 + k * 1024); } while (0)
#define PG8_MMA(ai, bj, At, Bt) do { __builtin_amdgcn_s_setprio(1); _Pragma("unroll") for (int m = 0; m < 4; ++m) _Pragma("unroll") for (int n = 0; n < 2; ++n) _Pragma("unroll") for (int k = 0; k < 2; ++k) \
        acc[ai][bj][m][n] = __builtin_amdgcn_mfma_f32_16x16x32_bf16(Bt[n][k], At[m][k], acc[ai][bj][m][n], 0, 0, 0); __builtin_amdgcn_s_setprio(0); } while (0)
#define PG8_WAIT_V(n) asm volatile("s_waitcnt vmcnt(" #n ")" ::: "memory")
#define PG8_WAIT_L(n) asm volatile("s_waitcnt lgkmcnt(" #n ")" ::: "memory")
#define PG8_BAR __builtin_amdgcn_s_barrier()
#define PG8_SCHED __builtin_amdgcn_sched_barrier(0)
    Unit cur, nxt; int ui = 0;
    if (!S.next(0, cur)) return;
    f32x4 acc[2][2][4][2];
#pragma unroll
    for (int a = 0; a < 2; ++a)
#pragma unroll
        for (int b = 0; b < 2; ++b)
#pragma unroll
            for (int m = 0; m < 4; ++m)
#pragma unroll
                for (int n = 0; n < 2; ++n) acc[a][b][m][n] = (f32x4){0.f, 0.f, 0.f, 0.f};
    bf16x8 At[4][2], B0[2][2], B1[2][2];
    const char* cA = (const char*)g.A + (size_t)cur.pm * tstep; const char* cB = (const char*)g.Bt + (size_t)cur.pn * tstep;
    S.a_ready(cur);
    if constexpr (SP2) {
        PG8_STAGE(PG8_SB(0, 0), cB, voffB); PG8_STAGE(PG8_SB(0, 1), cB + hstep, voffB); PG8_STAGE(PG8_SA(0, 0), cA, voffA); PG8_STAGE(PG8_SA(0, 1), cA + hstep, voffA);
        if (wr == 1) PG8_BAR;
        PG8_WAIT_V(2); PG8_BAR;
        PG8_STAGE(PG8_SB(1, 0), cB + kstep, voffB); PG8_STAGE(PG8_SA(1, 0), cA + kstep, voffA); PG8_STAGE(PG8_SB(1, 1), cB + hstep + kstep, voffB);
        PG8_WAIT_V(6); PG8_BAR;
    } else {
        PG8_STAGE(PG8_SB(0, 0), cB, voffB); PG8_STAGE(PG8_SA(0, 0), cA, voffA); PG8_STAGE(PG8_SB(0, 1), cB + hstep, voffB); PG8_STAGE(PG8_SA(0, 1), cA + hstep, voffA);
        if (wr == 1) PG8_BAR;
        PG8_WAIT_V(4); PG8_BAR;
        PG8_STAGE(PG8_SB(1, 0), cB + kstep, voffB); PG8_STAGE(PG8_SA(1, 0), cA + kstep, voffA); PG8_STAGE(PG8_SB(1, 1), cB + hstep + kstep, voffB);
        PG8_WAIT_V(6); PG8_BAR;
    }
    for (;;) {
        const bool has_next = S.next(ui + 1, nxt);
        const char* nA = has_next ? (const char*)g.A + (size_t)nxt.pm * tstep : cA; const char* nB = has_next ? (const char*)g.Bt + (size_t)nxt.pn * tstep : cB;
        for (int t = 0; t < nt; t += 2) {
            const bool last = (t == nt - 2);
            const char* a1 = cA + (size_t)(t + 1) * kstep;
            const char* a2 = last ? nA : cA + (size_t)(t + 2) * kstep; const char* b2 = last ? nB : cB + (size_t)(t + 2) * kstep;
            const char* a3 = a2 + kstep; const char* b3 = b2 + kstep;
            if (last && has_next) S.a_ready(nxt);
            if constexpr (SP2) {
            PG8_LDB(B0, 0, 0); PG8_LDB(B1, 0, 1); PG8_SCHED; PG8_LDA(At, 0, 0); PG8_STAGE(PG8_SA(1, 1), a1 + hstep, voffA);
            PG8_WAIT_V(8); PG8_WAIT_L(0); PG8_BAR; PG8_MMA(0, 0, At, B0); PG8_MMA(0, 1, At, B1); PG8_BAR; PG8_SCHED;
            PG8_LDA(At, 0, 1); PG8_STAGE(PG8_SB(0, 0), b2, voffB); PG8_STAGE(PG8_SB(0, 1), b2 + hstep, voffB); PG8_STAGE(PG8_SA(0, 0), a2, voffA);
            PG8_WAIT_V(8); PG8_WAIT_L(0); PG8_BAR; PG8_MMA(1, 0, At, B0); PG8_MMA(1, 1, At, B1); PG8_BAR; PG8_SCHED;
            PG8_LDB(B0, 1, 0); PG8_LDB(B1, 1, 1); PG8_SCHED; PG8_LDA(At, 1, 0); PG8_STAGE(PG8_SA(0, 1), a2 + hstep, voffA);
            PG8_WAIT_V(8); PG8_WAIT_L(0); PG8_BAR; PG8_MMA(0, 0, At, B0); PG8_MMA(0, 1, At, B1); PG8_BAR; PG8_SCHED;
            PG8_LDA(At, 1, 1); PG8_STAGE(PG8_SB(1, 0), b3, voffB); PG8_STAGE(PG8_SB(1, 1), b3 + hstep, voffB); PG8_STAGE(PG8_SA(1, 0), a3, voffA);
            PG8_WAIT_V(8); PG8_WAIT_L(0); PG8_BAR; PG8_MMA(1, 0, At, B0); PG8_MMA(1, 1, At, B1); PG8_BAR; PG8_SCHED;
            } else {
            PG8_LDB(B0, 0, 0); PG8_SCHED; PG8_LDA(At, 0, 0); PG8_STAGE(PG8_SA(1, 1), a1 + hstep, voffA);
            PG8_WAIT_L(8); PG8_BAR; PG8_WAIT_L(0); PG8_MMA(0, 0, At, B0); PG8_BAR; PG8_SCHED;
            PG8_LDB(B1, 0, 1); PG8_STAGE(PG8_SB(0, 0), b2, voffB);
            PG8_BAR; PG8_WAIT_L(0); PG8_MMA(0, 1, At, B1); PG8_BAR;
            PG8_LDA(At, 0, 1); PG8_STAGE(PG8_SA(0, 0), a2, voffA);
            PG8_BAR; PG8_WAIT_L(0); PG8_MMA(1, 0, At, B0); PG8_BAR; PG8_SCHED;
            PG8_STAGE(PG8_SB(0, 1), b2 + hstep, voffB);
            PG8_WAIT_V(6); PG8_BAR; PG8_MMA(1, 1, At, B1); PG8_BAR;
            PG8_LDB(B0, 1, 0); PG8_SCHED; PG8_LDA(At, 1, 0); PG8_STAGE(PG8_SA(0, 1), a2 + hstep, voffA);
            PG8_WAIT_L(8); PG8_BAR; PG8_WAIT_L(0); PG8_MMA(0, 0, At, B0); PG8_BAR; PG8_SCHED;
            PG8_LDB(B1, 1, 1); PG8_STAGE(PG8_SB(1, 0), b3, voffB);
            PG8_BAR; PG8_WAIT_L(0); PG8_MMA(0, 1, At, B1); PG8_BAR;
            PG8_LDA(At, 1, 1); PG8_STAGE(PG8_SA(1, 0), a3, voffA);
            PG8_BAR; PG8_WAIT_L(0); PG8_MMA(1, 0, At, B0); PG8_BAR; PG8_SCHED;
            PG8_STAGE(PG8_SB(1, 1), b3 + hstep, voffB);
            PG8_WAIT_V(6); PG8_BAR; PG8_MMA(1, 1, At, B1); PG8_BAR;
            }
        }
        if constexpr (ALIGN_EPI) { if (wr == 0) PG8_BAR; }
        if constexpr (!Epi::AFTER_DRAIN) { E(acc, cur, wr, wc, fr, fq); S.done(cur); }
        if (!has_next) break;
#pragma unroll
        for (int a = 0; a < 2; ++a)
#pragma unroll
            for (int b = 0; b < 2; ++b)
#pragma unroll
                for (int m = 0; m < 4; ++m)
#pragma unroll
                    for (int n = 0; n < 2; ++n) acc[a][b][m][n] = (f32x4){0.f, 0.f, 0.f, 0.f};
        cur = nxt; cA = nA; cB = nB; ++ui;
        if constexpr (ALIGN_EPI) { if (wr == 1) PG8_BAR; }
    }
    PG8_WAIT_V(0);
    if constexpr (!ALIGN_EPI) { if (wr == 0) PG8_BAR; }
    PG8_BAR;
    if constexpr (Epi::AFTER_DRAIN) { E.fused(acc, cur, wr, wc, fr, fq, lds, wid, lane); S.done(cur); }
#undef PG8_SA
#undef PG8_SB
#undef PG8_STAGE
#undef PG8_LDA
#undef PG8_LDB
#undef PG8_MMA
#undef PG8_WAIT_V
#undef PG8_WAIT_L
#undef PG8_BAR
#undef PG8_SCHED
}
}
namespace pg8 {
struct EpiF32 {
    static constexpr bool PERM = false, AFTER_DRAIN = false;
    float* C; int ldc;
    __device__ __forceinline__ void operator()(const f32x4 (&acc)[2][2][4][2], const Unit& u, int wr, int wc, int fr, int fq) const {
        const int row0 = u.pm * BM + wr * 64 + fr, col0 = u.pn * BM + wc * 32 + 4 * fq;
#pragma unroll
        for (int ai = 0; ai < 2; ++ai)
#pragma unroll
            for (int m = 0; m < 4; ++m) { float* rowp = C + (size_t)(row0 + ai * HALF + m * 16) * ldc + col0;
#pragma unroll
                for (int bj = 0; bj < 2; ++bj)
#pragma unroll
                    for (int n = 0; n < 2; ++n) *(f32x4*)(rowp + bj * HALF + n * 16) = acc[ai][bj][m][n]; }
    }
};
struct EpiBf16G {
    static constexpr bool PERM = true, AFTER_DRAIN = false;
    bf16_t* O; int ldc; int pnmask;
    __device__ __forceinline__ void operator()(const f32x4 (&acc)[2][2][4][2], const Unit& u, int wr, int wc, int fr, int fq) const {
        const int row0 = u.pm * BM + wr * 64 + fr, col0 = (u.pn & pnmask) * BM + wc * 32 + 8 * fq;
#pragma unroll
        for (int ai = 0; ai < 2; ++ai)
#pragma unroll
            for (int m = 0; m < 4; ++m) { bf16_t* rowp = O + (size_t)(row0 + ai * HALF + m * 16) * ldc + col0;
#pragma unroll
                for (int bj = 0; bj < 2; ++bj) { const f32x4 v0 = acc[ai][bj][m][0], v1 = acc[ai][bj][m][1];
                    u32x4 w; w.x = cvt_pk_bf16(v0[0], v0[1]); w.y = cvt_pk_bf16(v0[2], v0[3]); w.z = cvt_pk_bf16(v1[0], v1[1]); w.w = cvt_pk_bf16(v1[2], v1[3]);
                    *(u32x4*)(rowp + bj * HALF) = w; } }
    }
};
__device__ __forceinline__ float silu_fast(float x) { return x * __builtin_amdgcn_rcpf(1.f + __builtin_amdgcn_exp2f(-1.4426950408889634f * x)); }
struct EpiSwiGLU {
    static constexpr bool PERM = true, AFTER_DRAIN = false;
    bf16_t* O; int ldc;
    __device__ __forceinline__ void operator()(const f32x4 (&acc)[2][2][4][2], const Unit& u, int wr, int wc, int fr, int fq) const {
        const int row0 = u.pm * BM + wr * 64 + fr, col0 = (u.pn & 3) * HALF + wc * 32 + 8 * fq;
#pragma unroll
        for (int ai = 0; ai < 2; ++ai)
#pragma unroll
            for (int m = 0; m < 4; ++m) { bf16_t* rowp = O + (size_t)(row0 + ai * HALF + m * 16) * ldc + col0;
                const f32x4 a0 = acc[ai][0][m][0], a1 = acc[ai][0][m][1], g0 = acc[ai][1][m][0], g1 = acc[ai][1][m][1];
                u32x4 w; w.x = cvt_pk_bf16(silu_fast(a0[0]) * g0[0], silu_fast(a0[1]) * g0[1]); w.y = cvt_pk_bf16(silu_fast(a0[2]) * g0[2], silu_fast(a0[3]) * g0[3]);
                w.z = cvt_pk_bf16(silu_fast(a1[0]) * g1[0], silu_fast(a1[1]) * g1[1]); w.w = cvt_pk_bf16(silu_fast(a1[2]) * g1[2], silu_fast(a1[3]) * g1[3]);
                *(u32x4*)rowp = w; }
    }
};
struct MoeOrder {
    int nunits, G, v; const PG8_LAS int* tile_e;
    __device__ __forceinline__ bool next(int i, Unit& u) const { const int L = i * G + v; if (L >= nunits) return false; const int t = L >> 2; u.pm = t; u.pn = __builtin_amdgcn_readfirstlane(tile_e[t]) * 4 + (L & 3); return true; }
    __device__ __forceinline__ void a_ready(const Unit&) const {}
    __device__ __forceinline__ void done(const Unit&) const {}
};
}
#include <hip/hip_bf16.h>
#include <cmath>
namespace attn_body {
using bf16=__hip_bfloat16;
using bf16x8=__attribute__((ext_vector_type(8)))short;
using s16x4=__attribute__((ext_vector_type(4)))short;
using f32x16=__attribute__((ext_vector_type(16)))float;
using u32x4=__attribute__((ext_vector_type(4)))unsigned;
constexpr int BATCH=2,NHEAD=16,SEQ=8192,D=64,DM=NHEAD*D;
constexpr int NW=8,QBLK=32,QB=QBLK*NW,KVBLK=64,NQB=SEQ/QB;
constexpr int ATTN_PITCH=DM, ATTN_UNIT_ROWS=QB;
__device__ __forceinline__ int crow(int r,int hi){return (r&3)+8*(r>>2)+4*hi;}
#define SBAR() __builtin_amdgcn_sched_barrier(0)
__device__ __forceinline__ void cmask(f32x16&p0,f32x16&p1,int jb,int qrel,int hi){
  const float NEG=-INFINITY; int kb=64*jb+4*hi;
  #pragma unroll
  for(int r=0;r<16;++r){int kv=kb+(r&3)+8*(r>>2); if(kv>qrel)p0[r]=NEG; if(kv+32>qrel)p1[r]=NEG;}
}

constexpr int NSLOT=3, SLOTB=8192, VSLOTB=16384;
constexpr int LDS_K=0, LDS_V=NSLOT*SLOTB, LDS_WS=LDS_V+NSLOT*VSLOTB, LDS_OST=LDS_WS+NW*64*4, LDS_BYTES=LDS_OST+NW*4096;
constexpr float C2=0.125f*1.4426950408889634f;
__device__ __forceinline__ void glds16(const void*gsrc,unsigned lds_dst){unsigned keep;
  asm volatile("s_mov_b32 %0, m0\n\ts_mov_b32 m0, %2\n\ts_nop 0\n\tglobal_load_lds_dwordx4 %1, off\n\ts_mov_b32 m0, %0":"=&s"(keep):"v"(gsrc),"s"(lds_dst):"memory");}
__device__ __forceinline__ float max3f(float a,float b,float c){float r;asm("v_max3_f32 %0, %1, %2, %3":"=v"(r):"v"(a),"v"(b),"v"(c));return r;}
__device__ __forceinline__ float max2f(float a,float b){float r;asm("v_max_f32_e32 %0, %1, %2":"=v"(r):"v"(a),"v"(b));return r;}
__device__ __forceinline__ float fadd_s(float a,float b){float r;asm("v_add_f32_e32 %0, %1, %2":"=v"(r):"v"(a),"v"(b));return r;}
__device__ __forceinline__ float fsub_s(float a,float b){float r;asm("v_sub_f32_e32 %0, %1, %2":"=v"(r):"v"(a),"v"(b));return r;}
typedef float f32x2_t __attribute__((ext_vector_type(2))); typedef __bf16 bf16x2_t __attribute__((ext_vector_type(2)));
__device__ __forceinline__ unsigned cvtpk_s(float lo,float hi){f32x2_t v={lo,hi};bf16x2_t b=__builtin_convertvector(v,bf16x2_t);return __builtin_bit_cast(unsigned,b);}
#define WAIT_BAR(N) asm volatile("s_waitcnt vmcnt(" #N ") lgkmcnt(0)\n\ts_barrier":::"memory")

__device__ __forceinline__ void qkt(f32x16&p0,f32x16&p1,const char*Kslot,const bf16x8*qr,const f32x16&negm,int r32,int hi){
  const char*kb=Kslot+hi*1024+r32*16;
  #pragma unroll
  for(int d0=0;d0<4;++d0){
    const bf16x8 b0=*reinterpret_cast<const bf16x8*>(kb+d0*2048);
    const bf16x8 b1=*reinterpret_cast<const bf16x8*>(kb+d0*2048+512);
    if(d0==0){p0=__builtin_amdgcn_mfma_f32_32x32x16_bf16(b0,qr[0],negm,0,0,0);p1=__builtin_amdgcn_mfma_f32_32x32x16_bf16(b1,qr[0],negm,0,0,0);}
    else{p0=__builtin_amdgcn_mfma_f32_32x32x16_bf16(b0,qr[d0],p0,0,0,0);p1=__builtin_amdgcn_mfma_f32_32x32x16_bf16(b1,qr[d0],p1,0,0,0);}}
}
typedef __attribute__((address_space(3))) const char* lds_cptr;
typedef short v4i16_t __attribute__((ext_vector_type(4)));
__device__ __forceinline__ void kload8(bf16x8*kf,lds_cptr kp){
  kf[0]=*(const __attribute__((address_space(3))) bf16x8*)(kp);      kf[1]=*(const __attribute__((address_space(3))) bf16x8*)(kp+512);
  kf[2]=*(const __attribute__((address_space(3))) bf16x8*)(kp+2048); kf[3]=*(const __attribute__((address_space(3))) bf16x8*)(kp+2560);
  kf[4]=*(const __attribute__((address_space(3))) bf16x8*)(kp+4096); kf[5]=*(const __attribute__((address_space(3))) bf16x8*)(kp+4608);
  kf[6]=*(const __attribute__((address_space(3))) bf16x8*)(kp+6144); kf[7]=*(const __attribute__((address_space(3))) bf16x8*)(kp+6656);
}
__device__ __forceinline__ void kload2(bf16x8*kf,lds_cptr kp,int j){ kf[2*j]=*(const __attribute__((address_space(3))) bf16x8*)(kp+j*2048); kf[2*j+1]=*(const __attribute__((address_space(3))) bf16x8*)(kp+j*2048+512); }
__device__ __forceinline__ s16x4 vtr(lds_cptr p){ return __builtin_bit_cast(s16x4,__builtin_amdgcn_ds_read_tr16_b64_v4i16((__attribute__((address_space(3))) v4i16_t*)p)); }
__device__ __forceinline__ float rowmax(const f32x16&p0,const f32x16&p1){
  float a=max3f(p0[0],p0[1],p1[0]),b=max3f(p0[2],p0[3],p1[1]);a=max3f(a,p1[2],p1[3]);
  #pragma unroll
  for(int r=4;r<16;r+=4){a=max3f(a,p0[r],p0[r+1]);b=max3f(b,p0[r+2],p0[r+3]);a=max3f(a,p1[r],p1[r+1]);b=max3f(b,p1[r+2],p1[r+3]);}
  const float m=max2f(a,b);
  auto rr=__builtin_amdgcn_permlane32_swap(__float_as_uint(m),__float_as_uint(m),false,false);
  return max2f(__uint_as_float(rr[0]),__uint_as_float(rr[1]));
}
__device__ __forceinline__ void pv(f32x16*o,int vb,bf16x8 pa0,bf16x8 pa1,bf16x8 pa2,bf16x8 pa3){
  #pragma unroll
  for(int d0=0;d0<4;++d0){s16x4 lo[4],hi[4];
    #pragma unroll
    for(int ks=0;ks<4;++ks){
      asm volatile("ds_read_b64_tr_b16 %0,%1 offset:%c2":"=&v"(lo[ks]):"v"(vb),"i"(d0*4096+ks*1024):"memory");
      asm volatile("ds_read_b64_tr_b16 %0,%1 offset:%c2":"=&v"(hi[ks]):"v"(vb),"i"(d0*4096+ks*1024+512):"memory");}
    asm volatile("s_waitcnt lgkmcnt(0)":::"memory");SBAR();
    #define PK(k) (bf16x8){lo[k][0],lo[k][1],lo[k][2],lo[k][3],hi[k][0],hi[k][1],hi[k][2],hi[k][3]}
    o[d0]=__builtin_amdgcn_mfma_f32_32x32x16_bf16(pa0,PK(0),o[d0],0,0,0);
    o[d0]=__builtin_amdgcn_mfma_f32_32x32x16_bf16(pa1,PK(1),o[d0],0,0,0);
    o[d0]=__builtin_amdgcn_mfma_f32_32x32x16_bf16(pa2,PK(2),o[d0],0,0,0);
    o[d0]=__builtin_amdgcn_mfma_f32_32x32x16_bf16(pa3,PK(3),o[d0],0,0,0);
    #undef PK
  }
}

#ifndef ATTN_STORE16
#define ATTN_STORE16(p,v) (*(u32x4*)(p)=(v))
#endif
template<int THRL> __device__ __forceinline__ void attn_unit(int b,int h,int hv,int qb,const bf16*Q,const bf16*__restrict__ K,const bf16*__restrict__ V,bf16*O,char*shm,const int wave_id){
  int tid_=wave_id*64+(int)__builtin_amdgcn_mbcnt_hi(~0u,__builtin_amdgcn_mbcnt_lo(~0u,0u)); asm volatile("":"+v"(tid_)); const int tid=tid_,lane=tid&63,r32=lane&31,hi=lane>>5; const int wid=__builtin_amdgcn_readfirstlane(tid>>6);
  const long rowbase=(long)b*SEQ; const int q0=qb*QB;
  const bf16*Qw=Q+(rowbase+q0+wid*QBLK)*DM+h*D;
  const bf16*Kh=K+rowbase*DM+h*D,*Vh=V+rowbase*DM+hv*128;
  const unsigned lds0=(unsigned)(uintptr_t)shm;
  float*wsf=(float*)(shm+LDS_WS)+wid*64;
  const bf16*ksrc=Kh+(long)lane*DM+wid*8;
  const bf16*vsrc=Vh+(long)(16*(wid&3)+(lane>>2))*DM+(wid>>2)*32+(lane&3)*8;
  const unsigned kdst=lds0+LDS_K+wid*1024, vdst=lds0+LDS_V+wid*1024;
  #define DMA_K(t,slot) glds16(ksrc+(long)(t)*KVBLK*DM,(unsigned)__builtin_amdgcn_readfirstlane(kdst+(slot)))
  #define DMA_V(t,slot) do{ glds16(vsrc+(long)(t)*KVBLK*DM,(unsigned)__builtin_amdgcn_readfirstlane(vdst+2*(slot))); glds16(vsrc+64+(long)(t)*KVBLK*DM,(unsigned)__builtin_amdgcn_readfirstlane(vdst+2*(slot)+8192)); }while(0)
  const int vb0=(int)(lds0+LDS_V)+((lane>>4)&1)*32+(lane&3)*8+(4*hi+((lane&15)>>2))*64;
  const char*Kbase=shm+LDS_K; bf16x8 kf[8];
  const lds_cptr shm3=(lds_cptr)shm; const lds_cptr kp0=shm3+LDS_K+hi*1024+r32*16; const lds_cptr vp0=shm3+LDS_V+((lane>>4)&1)*32+(lane&3)*8+(4*hi+((lane&15)>>2))*64;
  const int NT=(q0+QB)/KVBLK;
  DMA_K(0,0);DMA_V(0,0);DMA_K(1,SLOTB);
  bf16x8 qr[4];
  #pragma unroll
  for(int d0=0;d0<4;++d0)qr[d0]=*reinterpret_cast<const bf16x8*>(&Qw[(long)r32*DM+d0*16+hi*8]);
  float mhat=0.f,l_reg=0.f;f32x16 o[4];o[0]=f32x16{};o[1]=f32x16{};o[2]=f32x16{};o[3]=f32x16{};const f32x16 zz=f32x16{};
  #define CMASK(P0,P1,t) do{int jb_=(t)-(NT-4); if(jb_>=0){ FRESH_HI(hi_,r32_) cmask(P0,P1,jb_,wid*QBLK+r32_,hi_);} }while(0)
  bool resc=false;
  #define START(P0,P1) do{ const float rm=rowmax(P0,P1); resc=false; \
    { const float dl=rm; mhat=fadd_s(mhat,dl); \
      _Pragma("unroll") for(int r=0;r<16;++r){P0[r]=fsub_s(P0[r],dl);P1[r]=fsub_s(P1[r],dl);} \
      } \
    _Pragma("unroll") for(int r=0;r<16;++r)P0[r]=__builtin_amdgcn_exp2f(P0[r]); }while(0)
  #define FRESH_HI(hi_,r32_) int ln__=(int)__builtin_amdgcn_mbcnt_hi(~0u,__builtin_amdgcn_mbcnt_lo(~0u,0u)); asm volatile("":"+v"(ln__)); const int hi_=ln__>>5,r32_=ln__&31; (void)hi_; (void)r32_;
  #define RESC() do{ if(resc){ FRESH_HI(hi_,r32_) asm volatile("s_waitcnt lgkmcnt(0)":::"memory"); \
      _Pragma("unroll") for(int d_=0;d_<4;++d_) _Pragma("unroll") for(int r=0;r<16;++r)o[d_][r]*=wsf[crow(r,hi_)]; } }while(0)
  f32x16 pA0,pA1,pB0,pB1;
  int sl_prev=0,sl_cur=0,sl_next=SLOTB;
  #define ROT() do{sl_prev=sl_cur;sl_cur=sl_next;sl_next=(sl_next==(NSLOT-1)*SLOTB)?0:sl_next+SLOTB;}while(0)
  DMA_K(2,2*SLOTB);
  WAIT_BAR(3);
  qkt(pA0,pA1,Kbase,qr,zz,r32,hi);asm volatile("s_nop 15\n\ts_nop 7":"+v"(pA0),"+v"(pA1));CMASK(pA0,pA1,0);
  START(pA0,pA1);
  _Pragma("unroll") for(int r=0;r<16;++r)pA1[r]=__builtin_amdgcn_exp2f(pA1[r]);
  WAIT_BAR(0);
  DMA_K(3,0);DMA_V(1,SLOTB);
  ROT();
  kload8(kf,kp0+sl_cur);
  WAIT_BAR(3);
  s16x4 vlo[8],vhi[8]; u32x4 pw0,pw1,pw2,pw3;
  #define PKW(P,B) cvtpk_s(P[B],P[B+1])
  #define PAF(k) __builtin_bit_cast(bf16x8,pw##k)
  #define VFR(i) (bf16x8){vlo[i][0],vlo[i][1],vlo[i][2],vlo[i][3],vhi[i][0],vhi[i][1],vhi[i][2],vhi[i][3]}
  #define PIN(x) asm volatile("":"+v"(x))
  #define MX3(a,b,c) __builtin_fmaxf(__builtin_fmaxf((a),(b)),(c))
  #define GAPA(MF,A0,A1,A2,A3,W0,W1,PW) do{ MF; sacc+=A0; sacc+=A1; sacc+=A2; sacc+=A3; PIN(sacc); W0; W1; PIN(PW); SBAR(); }while(0)
  #define EX(v) __builtin_amdgcn_exp2f(v)
  #define GAPB(MF,RL,X,B) do{ MF; RL; X[B]=EX(X[B]); X[B+1]=EX(X[B+1]); PIN(X); SBAR(); }while(0)
  #define VRD(i) do{ vlo[(i)&7]=vtr(vp_+(((i)>>2)*4096+((i)&3)*1024)); vhi[(i)&7]=vtr(vp_+(((i)>>2)*4096+((i)&3)*1024+512)); }while(0)
  #define KRD(G,j) do{ if(G){ kload2(kf,kp0+sl_next,j); SBAR(); } }while(0)
  #define STEP(C0,C1,P0,P1,t,GK,GV,GL) do{ SBAR(); \
    const lds_cptr vp_=vp0+2*sl_prev; \
    VRD(0); SBAR(); float sacc=(P0[0]+P0[1]); \
    GAPA(C0=__builtin_amdgcn_mfma_f32_32x32x16_bf16(kf[0],qr[0],zz,0,0,0), P0[2],P0[3],P0[4],P0[5],     pw0[0]=PKW(P0,0), pw0[1]=PKW(P0,2), pw0); \
    VRD(4); SBAR(); GAPA(C1=__builtin_amdgcn_mfma_f32_32x32x16_bf16(kf[1],qr[0],zz,0,0,0), P0[6],P0[7],P0[8],P0[9],     pw0[2]=PKW(P0,4), pw0[3]=PKW(P0,6), pw0); \
    VRD(1); SBAR(); GAPA(C0=__builtin_amdgcn_mfma_f32_32x32x16_bf16(kf[2],qr[1],C0,0,0,0),   P0[10],P0[11],P0[12],P0[13], pw1[0]=PKW(P0,8), pw1[1]=PKW(P0,10), pw1); \
    VRD(5); SBAR(); GAPA(C1=__builtin_amdgcn_mfma_f32_32x32x16_bf16(kf[3],qr[1],C1,0,0,0),   P0[14],P0[15],P1[0],P1[1],   pw1[2]=PKW(P0,12),pw1[3]=PKW(P0,14), pw1); \
    VRD(2); SBAR(); GAPA(C0=__builtin_amdgcn_mfma_f32_32x32x16_bf16(kf[4],qr[2],C0,0,0,0),   P1[2],P1[3],P1[4],P1[5],     pw2[0]=PKW(P1,0), pw2[1]=PKW(P1,2), pw2); \
    VRD(6); SBAR(); GAPA(C1=__builtin_amdgcn_mfma_f32_32x32x16_bf16(kf[5],qr[2],C1,0,0,0),   P1[6],P1[7],P1[8],P1[9],     pw2[2]=PKW(P1,4), pw2[3]=PKW(P1,6), pw2); \
    VRD(3); SBAR(); GAPA(C0=__builtin_amdgcn_mfma_f32_32x32x16_bf16(kf[6],qr[3],C0,0,0,0),   P1[10],P1[11],P1[12],P1[13], pw3[0]=PKW(P1,8), pw3[1]=PKW(P1,10), pw3); \
    VRD(7); SBAR(); GAPA(C1=__builtin_amdgcn_mfma_f32_32x32x16_bf16(kf[7],qr[3],C1,0,0,0),   P1[14],P1[15],0.f,0.f,       pw3[2]=PKW(P1,12),pw3[3]=PKW(P1,14), pw3); \
    l_reg+=sacc; \
    _Pragma("unroll") for(int r=0;r<16;++r){C0[r]-=mhat;C1[r]-=mhat;} \
    if(GK){DMA_K((t)+3,sl_cur);} if(GV){DMA_V((t)+1,sl_next);} \
    CMASK(C0,C1,t); \
    { float a=MX3(C0[0],C0[1],C1[0]),b=MX3(C0[2],C0[3],C1[1]); a=MX3(a,C1[2],C1[3]); \
      _Pragma("unroll") for(int r=4;r<16;r+=4){a=MX3(a,C0[r],C0[r+1]);b=MX3(b,C0[r+2],C0[r+3]);a=MX3(a,C1[r],C1[r+1]);b=MX3(b,C1[r+2],C1[r+3]);} \
      float rm=__builtin_fmaxf(a,b); { auto rr=__builtin_amdgcn_permlane32_swap(__float_as_uint(rm),__float_as_uint(rm),false,false); rm=__builtin_fmaxf(__uint_as_float(rr[0]),__uint_as_float(rr[1])); } \
      resc=false; \
      if(__builtin_expect(__any(rm>(float)THRL),0)){ const float dl=__builtin_fmaxf(rm,0.f); mhat+=dl; \
        _Pragma("unroll") for(int r=0;r<16;++r){C0[r]-=dl;C1[r]-=dl;} \
        const float f=__builtin_amdgcn_exp2f(-dl); l_reg*=f; { FRESH_HI(hi_,r32_) if(hi_==0)wsf[r32_]=f; } resc=true; } } \
    SBAR(); \
    GAPB(o[0]=__builtin_amdgcn_mfma_f32_32x32x16_bf16(PAF(0),VFR(0),o[0],0,0,0), VRD(8),  C0,0); \
    GAPB(o[1]=__builtin_amdgcn_mfma_f32_32x32x16_bf16(PAF(0),VFR(4),o[1],0,0,0), VRD(12), C0,2); \
    KRD(GL,0); GAPB(o[0]=__builtin_amdgcn_mfma_f32_32x32x16_bf16(PAF(1),VFR(1),o[0],0,0,0), VRD(9),  C0,4); \
    KRD(GL,1); GAPB(o[1]=__builtin_amdgcn_mfma_f32_32x32x16_bf16(PAF(1),VFR(5),o[1],0,0,0), VRD(13), C0,6); \
    KRD(GL,2); GAPB(o[0]=__builtin_amdgcn_mfma_f32_32x32x16_bf16(PAF(2),VFR(2),o[0],0,0,0), VRD(10), C0,8); \
    KRD(GL,3); GAPB(o[1]=__builtin_amdgcn_mfma_f32_32x32x16_bf16(PAF(2),VFR(6),o[1],0,0,0), VRD(14), C0,10); \
    GAPB(o[0]=__builtin_amdgcn_mfma_f32_32x32x16_bf16(PAF(3),VFR(3),o[0],0,0,0), VRD(11), C0,12); \
    GAPB(o[1]=__builtin_amdgcn_mfma_f32_32x32x16_bf16(PAF(3),VFR(7),o[1],0,0,0), VRD(15), C0,14); \
    GAPB(o[2]=__builtin_amdgcn_mfma_f32_32x32x16_bf16(PAF(0),VFR(0),o[2],0,0,0), (void)0, C1,0); \
    GAPB(o[3]=__builtin_amdgcn_mfma_f32_32x32x16_bf16(PAF(0),VFR(4),o[3],0,0,0), (void)0, C1,2); \
    GAPB(o[2]=__builtin_amdgcn_mfma_f32_32x32x16_bf16(PAF(1),VFR(1),o[2],0,0,0), (void)0, C1,4); \
    GAPB(o[3]=__builtin_amdgcn_mfma_f32_32x32x16_bf16(PAF(1),VFR(5),o[3],0,0,0), (void)0, C1,6); \
    GAPB(o[2]=__builtin_amdgcn_mfma_f32_32x32x16_bf16(PAF(2),VFR(2),o[2],0,0,0), (void)0, C1,8); \
    GAPB(o[3]=__builtin_amdgcn_mfma_f32_32x32x16_bf16(PAF(2),VFR(6),o[3],0,0,0), (void)0, C1,10); \
    GAPB(o[2]=__builtin_amdgcn_mfma_f32_32x32x16_bf16(PAF(3),VFR(3),o[2],0,0,0), (void)0, C1,12); \
    GAPB(o[3]=__builtin_amdgcn_mfma_f32_32x32x16_bf16(PAF(3),VFR(7),o[3],0,0,0), (void)0, C1,14); \
    }while(0)
  int t=1;
  #undef CMASK
  #define CMASK(P0,P1,t) do{}while(0)
  for(;t+5<NT;t+=2){
    STEP(pB0,pB1,pA0,pA1,t,true,true,true);     WAIT_BAR(3); RESC(); ROT();
    STEP(pA0,pA1,pB0,pB1,t+1,true,true,true);   WAIT_BAR(3); RESC(); ROT();
  }
  #undef CMASK
  #define CMASK(P0,P1,t) do{int jb_=(t)-(NT-4); if(jb_>=0){ FRESH_HI(hi_,r32_) cmask(P0,P1,jb_,wid*QBLK+r32_,hi_);} }while(0)
  #define ENDW(tt) do{ if((tt)+3<NT){WAIT_BAR(3);} else if((tt)+2<NT){WAIT_BAR(2);} else {WAIT_BAR(0);} }while(0)
  for(;t+1<NT;t+=2){
    STEP(pB0,pB1,pA0,pA1,t,(t+3<NT),(t+1<NT),(t+1<NT));       ENDW(t);   RESC(); ROT();
    STEP(pA0,pA1,pB0,pB1,t+1,(t+4<NT),(t+2<NT),(t+2<NT));     ENDW(t+1); RESC(); ROT();
  }
  STEP(pB0,pB1,pA0,pA1,NT-1,false,false,false); RESC();
  { float sacc=pB0[0]+pB0[1]; _Pragma("unroll") for(int r=2;r<16;++r)sacc+=pB0[r]; _Pragma("unroll") for(int r=0;r<16;++r)sacc+=pB1[r]; l_reg+=sacc;
    pw0=(u32x4){PKW(pB0,0),PKW(pB0,2),PKW(pB0,4),PKW(pB0,6)};pw1=(u32x4){PKW(pB0,8),PKW(pB0,10),PKW(pB0,12),PKW(pB0,14)};pw2=(u32x4){PKW(pB1,0),PKW(pB1,2),PKW(pB1,4),PKW(pB1,6)};pw3=(u32x4){PKW(pB1,8),PKW(pB1,10),PKW(pB1,12),PKW(pB1,14)};
    SBAR(); pv(o,vb0+2*sl_cur,PAF(0),PAF(1),PAF(2),PAF(3)); }
  #undef PKW
  #undef PAF
  #undef VFR
  #undef PIN
  #undef MX3
  #undef GAPA
  #undef GAPB
  #undef EX
  #undef VRD
  #undef KRD
  #undef STEP
  #undef ENDW
  {auto rr=__builtin_amdgcn_permlane32_swap(__float_as_uint(l_reg),__float_as_uint(l_reg),false,false);l_reg=__uint_as_float(rr[0])+__uint_as_float(rr[1]);}
  FRESH_HI(hie,r32e)
  if(hie==0)wsf[32+r32e]=l_reg;asm volatile("s_waitcnt lgkmcnt(0)":::"memory");
  float rli[16];
  #pragma unroll
  for(int r=0;r<16;++r)rli[r]=__builtin_amdgcn_rcpf(wsf[32+crow(r,hie)]);
  bf16*Ow=O+(rowbase+q0+wid*QBLK)*DM+hv*128;
  { bf16*stg=(bf16*)(shm+LDS_OST)+wid*2048;
    #pragma unroll
    for(int hf=0;hf<2;++hf){
      #pragma unroll
      for(int r=0;r<16;++r){const int orow=crow(r,hie);
        #pragma unroll
        for(int d0=0;d0<2;++d0)stg[orow*64+d0*32+r32e]=__float2bfloat16(o[2*hf+d0][r]*rli[r]);}
      asm volatile("s_waitcnt lgkmcnt(0)":::"memory");
      #pragma unroll
      for(int i=0;i<4;++i){const int row=i*8+(ln__>>3),ch=ln__&7; const u32x4 v=*(const u32x4*)(stg+row*64+ch*8); ATTN_STORE16(Ow+(long)row*DM+hf*64+ch*8,v);}
      asm volatile("s_waitcnt lgkmcnt(0)":::"memory"); } }
  asm volatile("s_waitcnt lgkmcnt(0)\n\ts_barrier":::"memory");
  #undef DMA_K
  #undef DMA_V
  #undef CMASK
  #undef START
  #undef RESC
  #undef FRESH_HI
  #undef ROT
}
constexpr int ATTN_LDS_BYTES=LDS_BYTES;
struct AttnTensors { const bf16* Q; const bf16* K; const bf16* V; bf16* O1; bf16* O2; };
struct AttnUnit { int bh; int qb; };
struct StaticOrder {
  int vcu;
  __device__ __forceinline__ explicit StaticOrder(int grid,int block):vcu((block%8)*(grid/8)+block/8){}
  __device__ __forceinline__ bool next(int i,AttnUnit&u)const{ if(i>=4)return false; const int s=vcu&7; u.bh=vcu>>3; u.qb=(i==0)?s:(i==1)?15-s:(i==2)?16+s:31-s; return true; }
  __device__ __forceinline__ void a_ready(const AttnUnit&)const{}
  __device__ __forceinline__ void done(const AttnUnit&)const{}
};
template<class Sched,int THRL=8> __device__ __forceinline__ void attn_phase(char*lds,const AttnTensors&T,const Sched&S,const int wave_id){
  AttnUnit u;
  for(int i=0;S.next(i,u);++i){ S.a_ready(u); const int b=u.bh>>4,hq=u.bh&15; attn_unit<THRL>(b,hq,hq>>1,u.qb,T.Q,T.K,T.V,(hq&1)?T.O2:T.O1,lds,wave_id); S.done(u); }
}
#undef SBAR
#undef WAIT_BAR
}
#define GAS __attribute__((address_space(1)))
#define LAS __attribute__((address_space(3)))
typedef unsigned short bf16;
typedef unsigned v4u __attribute__((ext_vector_type(4)));
typedef float f32x4 __attribute__((ext_vector_type(4)));
typedef short bf16x8 __attribute__((ext_vector_type(8)));
typedef GAS unsigned gu32;
typedef GAS unsigned long long gu64;
#define RLX_AGENT __ATOMIC_RELAXED, __HIP_MEMORY_SCOPE_AGENT
#define LDS_WAIT() asm volatile("s_waitcnt lgkmcnt(0)" ::: "memory")
#define VM_WAIT() asm volatile("s_waitcnt vmcnt(0)" ::: "memory")
__device__ __forceinline__ unsigned long long rt() { return __builtin_amdgcn_s_memrealtime(); }
typedef float f32x2_hw __attribute__((ext_vector_type(2))); typedef __bf16 bf16x2_hw __attribute__((ext_vector_type(2)));
__device__ __forceinline__ unsigned pk2(float lo, float hi) { const f32x2_hw v = {lo, hi}; const bf16x2_hw b = __builtin_convertvector(v, bf16x2_hw); return __builtin_bit_cast(unsigned, b); }
__device__ __forceinline__ unsigned f2bf(float f) { return pk2(f, 0.f) & 0xffffu; }

#define XB_TMO      128
#define XB_XCNT(j)  (256  + 64 * (j))
#define XB_XSUB(j)  (1280 + 64 * (j))
#define XB_XGEN(j)  (2304 + 64 * (j))
#define XB_TOP      3328
#define XB_TOPGEN   3392
#define XCD_BAR_WORDS 3456
#define XB_SPIN_CAP (1u << 18)

__device__ __forceinline__ unsigned xb_ld(unsigned* p)              { return __hip_atomic_load(p, __ATOMIC_RELAXED, __HIP_MEMORY_SCOPE_AGENT); }
__device__ __forceinline__ unsigned xb_add(unsigned* p, unsigned v) { return __hip_atomic_fetch_add(p, v, __ATOMIC_RELAXED, __HIP_MEMORY_SCOPE_AGENT); }
__device__ __forceinline__ unsigned xb_xcc_id() { return (unsigned)__builtin_amdgcn_s_getreg((3 << 11) | 20) & 0xFu; }
#define XB_SPIN(cond, bar) do { unsigned _sp = 0; while (cond) { __builtin_amdgcn_s_sleep(1); \
    if ((++_sp & 255u) == 0u) { if (xb_ld(&(bar)[XB_TMO])) break; if (_sp > XB_SPIN_CAP) { atomicAdd(&(bar)[XB_TMO], 1u); break; } } } } while (0)

struct XcdBarrier {
    unsigned* bar; unsigned x;
    volatile LAS unsigned* st;
};

__device__ __forceinline__ XcdBarrier xcd_barrier_post(unsigned* bar, volatile LAS unsigned* st, const int wave_id) {
    XcdBarrier b; b.bar = bar; b.x = xb_xcc_id(); b.st = st;
    if (wave_id == 0 && __builtin_amdgcn_mbcnt_hi(~0u, __builtin_amdgcn_mbcnt_lo(~0u, 0u)) == 0u) (void)xb_add(&bar[XB_XCNT(b.x)], 1u);
    return b;
}
__device__ __forceinline__ void xcd_barrier_complete(unsigned* bar, unsigned x, unsigned& nloc, unsigned& nx) {
    const unsigned G = gridDim.x * gridDim.y * gridDim.z;
    unsigned sum, cnt, mine, sp = 0u;
    for (;;) {
        sum = 0u; cnt = 0u; mine = 0u;
#pragma unroll
        for (unsigned j = 0; j < 16; ++j) { const unsigned c = xb_ld(&bar[XB_XCNT(j)]); sum += c; cnt += (c > 0u) ? 1u : 0u; mine = (j == x) ? c : mine; }
        if (sum == G) break;
        __builtin_amdgcn_s_sleep(1);
        if ((++sp & 255u) == 0u) { if (xb_ld(&bar[XB_TMO])) break; if (sp > XB_SPIN_CAP) { atomicAdd(&bar[XB_TMO], 1u); break; } }
    }
    nloc = mine > 0u ? mine : 1u; nx = cnt > 0u ? cnt : 1u;
}

__device__ __forceinline__ void xcd_barrier(const XcdBarrier& b, const int wave_id) {
    asm volatile("s_waitcnt vmcnt(0)" ::: "memory");
    __syncthreads();
    if (wave_id == 0 && __builtin_amdgcn_mbcnt_hi(~0u, __builtin_amdgcn_mbcnt_lo(~0u, 0u)) == 0u) {
        unsigned* bar = b.bar;
        __builtin_amdgcn_s_waitcnt(0);
        unsigned nloc = b.st[0], nx = b.st[1];
        if (nloc == 0u) { xcd_barrier_complete(bar, b.x, nloc, nx); b.st[0] = nloc; b.st[1] = nx; }
        const unsigned old = xb_add(&bar[XB_XSUB(b.x)], 1u);
        const unsigned gen = old / nloc;
        if (old + 1u == (gen + 1u) * nloc) {
            __builtin_amdgcn_fence(__ATOMIC_RELEASE, "agent");
            asm volatile("s_waitcnt vmcnt(0)" ::: "memory");
            const unsigned og = xb_add(&bar[XB_TOP], 1u);
            const unsigned tg = og / nx;
            if (og + 1u == (tg + 1u) * nx) xb_add(&bar[XB_TOPGEN], 1u);
            else XB_SPIN(xb_ld(&bar[XB_TOPGEN]) == tg, bar);
            __builtin_amdgcn_fence(__ATOMIC_ACQUIRE, "agent");
            xb_add(&bar[XB_XGEN(b.x)], 1u);
            asm volatile("s_waitcnt vmcnt(0)" ::: "memory");
        } else {
            XB_SPIN(xb_ld(&bar[XB_XGEN(b.x)]) == gen, bar);
            __builtin_amdgcn_fence(__ATOMIC_ACQUIRE, "agent");
            asm volatile("s_waitcnt vmcnt(0)" ::: "memory");
        }
    }
    __syncthreads();
}
constexpr int NWAVES = 8;
constexpr int T = 8192, D = 1024, M = 16384;
constexpr int NINP = 4352;
constexpr int NEXP = 32, NROWS2 = 40960, NTILE2 = NROWS2 / 256;
constexpr float LN_EPS = 1e-5f, RMS_EPS = 1e-6f, ALPHA = 1.6817928305074292f;
constexpr float QSCALE = 0.125f * 1.4426950408889634f;

constexpr size_t al256(size_t x) { return (x + 255) & ~(size_t)255; }
constexpr size_t WS_CTL = 0, CTL_ZERO_BYTES = 1u << 20;
constexpr size_t WS_WIN = WS_CTL + CTL_ZERO_BYTES;
constexpr size_t WS_WAOUT = WS_WIN + (size_t)2 * NINP * D * 2;
constexpr size_t WS_WQKV = WS_WAOUT + (size_t)2 * D * D * 2;
constexpr size_t WS_WQ3 = WS_WQKV + (size_t)3 * D * D * 2;
constexpr size_t WS_WBOUT = WS_WQ3 + (size_t)D * D * 2;
constexpr size_t WS_WR = WS_WBOUT + (size_t)2 * D * D * 2;
constexpr size_t WS_W13 = WS_WR + (size_t)4 * 48 * D * 2;
constexpr size_t WS_W2 = WS_W13 + (size_t)4 * 32 * 1024 * 1024 * 2;
constexpr size_t WS_H = WS_W2 + (size_t)4 * 32 * 1024 * 512 * 2;
constexpr size_t WS_HB = WS_H + (size_t)M * D * 4;
constexpr size_t WS_H1 = WS_HB + (size_t)M * D * 2;
constexpr size_t WS_H1B = WS_H1 + (size_t)M * D * 4;
constexpr size_t WS_PROJ = WS_H1B + (size_t)M * D * 2;
constexpr size_t WS_KB = WS_PROJ + (size_t)M * NINP * 2;
constexpr size_t WS_VB = WS_KB + (size_t)M * D * 2;
constexpr size_t WS_ON = WS_VB + (size_t)M * D * 2;
constexpr size_t WS_MIX = WS_ON + (size_t)M * D * 2;
constexpr size_t WS_EID = WS_MIX + (size_t)M * D * 4;
constexpr size_t WS_GATE = WS_EID + (size_t)2 * M * 4;
constexpr size_t WS_APOS = WS_GATE + (size_t)2 * M * 4;
constexpr size_t WS_XROWS = WS_APOS + (size_t)2 * M * 4;
constexpr size_t WS_HID = WS_XROWS + (size_t)NROWS2 * 1024 * 2;
constexpr size_t WS_YROWS = WS_HID + (size_t)NROWS2 * 512 * 2;
constexpr size_t WS_FAST_END = WS_YROWS + (size_t)NROWS2 * 1024 * 2;
constexpr int CW_BAR = 4096;
constexpr int CW_CNT = 64;
constexpr int LDS_BYTES = 147456, RING_BYTES = 131072, LDSCTL_OFF = RING_BYTES, MISC_OFF = LDSCTL_OFF + 320, TILEE_OFF = MISC_OFF + 128;
constexpr int PREP_SC_OFF = TILEE_OFF + 4 * NTILE2 + 64;
constexpr int STAMP_OFF = PREP_SC_OFF + 8 * 768;
constexpr int SCAN_O_OFF = (STAMP_OFF + 48 * 8 + 15) & ~15;
static_assert(SCAN_O_OFF + 4 * 2048 <= LDS_BYTES, "LDS map");

#define PHASE_IDS int tid_o_ = F.wave * 64 + (int)__builtin_amdgcn_mbcnt_hi(~0u, __builtin_amdgcn_mbcnt_lo(~0u, 0u)); asm volatile("" : "+v"(tid_o_)); const int tid = tid_o_, lane = tid & 63; (void)tid; (void)lane;
struct Frame {
    LAS unsigned char* lds; volatile LAS unsigned* MISC; gu32* ctl;
    int wave, vcu, G;
    unsigned char* ws;
};
struct Args { const float* in[20]; float* out; unsigned char* ws; int ph_lo, ph_hi, bar_region, pad; float lam_init[2]; };

__device__ __forceinline__ float wave_sum(float v) {
#pragma unroll
    for (int o = 1; o < 64; o <<= 1) v += __shfl_xor(v, o);
    return v;
}
__device__ __forceinline__ void p0_transpose_item(const float* W, int ldw, int nvalid, bf16* WT, int ldt, int drow0, int k0, int n0, LAS float* scr, int lane) {
    const int c4 = lane & 7, kr = lane >> 3; const bool ok = (n0 + 4 * c4) < nvalid;
    f32x4 x[8];
#pragma unroll
    for (int i = 0; i < 8; ++i) x[i] = ok ? *(const GAS f32x4*)(W + (size_t)(k0 + kr + 8 * i) * ldw + n0 + 4 * c4) : (f32x4){0.f, 0.f, 0.f, 0.f};
#pragma unroll
    for (int i = 0; i < 8; ++i) *(LAS f32x4*)(scr + (kr + 8 * i) * 36 + ((4 * c4 + 4 * i) & 31)) = x[i];
    LDS_WAIT(); asm volatile("" ::: "memory");
    const int c = lane & 7;
#pragma unroll
    for (int j = 0; j < 4; ++j) { const int n = (lane >> 3) + 8 * j; const LAS float* sp = scr + (8 * c) * 36 + ((n + 4 * c) & 31);
        v4u o; o.x = pk2(sp[0 * 36], sp[1 * 36]); o.y = pk2(sp[2 * 36], sp[3 * 36]); o.z = pk2(sp[4 * 36], sp[5 * 36]); o.w = pk2(sp[6 * 36], sp[7 * 36]);
        *(GAS v4u*)(WT + (size_t)(drow0 + n) * ldt + k0 + 8 * c) = o; }
    LDS_WAIT(); asm volatile("" ::: "memory");
}
__device__ __forceinline__ bool p0_job(int& r, const float* W, int K, int N, int nblk, bf16* WT, int drow_base, bool w13perm, LAS float* scr, int lane) {
    const int items = (K / 64) * nblk;
    if (r >= items) { r -= items; return false; }
    const int kb = r / nblk, nb = r % nblk, n0 = nb * 32;
    int drow0 = drow_base + n0;
    if (w13perm) drow0 = drow_base + ((n0 & 511) >> 7) * 256 + (n0 >> 9) * 128 + (n0 & 127);
    p0_transpose_item(W, N, N, WT, K, drow0, kb * 64, n0, scr, lane);
    return true;
}
__device__ __forceinline__ void p0_prologue(Frame& F, const Args& a) {
    PHASE_IDS
    LAS float* scr = (LAS float*)(F.lds + F.wave * 16384);
    const int gw = F.vcu * NWAVES + F.wave, NGW = F.G * NWAVES;
    bf16* win = (bf16*)(F.ws + WS_WIN); bf16* waout = (bf16*)(F.ws + WS_WAOUT); bf16* wqkv = (bf16*)(F.ws + WS_WQKV); bf16* wq3 = (bf16*)(F.ws + WS_WQ3);
    bf16* wbout = (bf16*)(F.ws + WS_WBOUT); bf16* wr = (bf16*)(F.ws + WS_WR);
    constexpr int I_IN = 16 * 129, I_SQ = 16 * 32, I_KV = 16 * 64;
    constexpr int NSMALL = 2 * I_IN + 2 * I_SQ + I_KV + 2 * I_SQ + 2 * I_SQ;
    for (int it = gw; it < NSMALL; it += NGW) {
        int r = it;
        bool done = false;
        for (int l = 0; l < 2 && !done; ++l) done = p0_job(r, a.in[1] + (size_t)l * D * 4112, D, 4112, 129, win + (size_t)l * NINP * D, 0, false, scr, lane);
        for (int l = 0; l < 2 && !done; ++l) done = p0_job(r, a.in[6] + (size_t)l * D * D, D, D, 32, waout + (size_t)l * D * D, 0, false, scr, lane);
        if (!done) done = p0_job(r, a.in[7], D, 2048, 64, wqkv, 1024, false, scr, lane);
        if (!done) done = p0_job(r, a.in[8], D, D, 32, wqkv, 0, false, scr, lane);
        if (!done) done = p0_job(r, a.in[8] + (size_t)D * D, D, D, 32, wq3, 0, false, scr, lane);
        for (int l = 0; l < 2 && !done; ++l) done = p0_job(r, a.in[11] + (size_t)l * D * D, D, D, 32, wbout + (size_t)l * D * D, 0, false, scr, lane);
    }
    { const int gt = (F.vcu * NWAVES + F.wave) * 64 + lane, NT = F.G * NWAVES * 64;
      for (int i = gt; i < 2 * 224 * (D / 8); i += NT) { const int l = i / (224 * (D / 8)), rr = (i / (D / 8)) % 224, c8 = i % (D / 8); *(GAS v4u*)(win + ((size_t)l * NINP + 4128 + rr) * D + c8 * 8) = (v4u){0u, 0u, 0u, 0u}; }
      for (int i = gt; i < 4 * 48 * D; i += NT) { const int l = i / (48 * D), n = (i / D) % 48, k = i % D;
          const float v = n < 4 ? a.in[16][((size_t)l * D + k) * 4 + n] : (n < 36 ? a.in[17][((size_t)l * D + k) * 32 + (n - 4)] : 0.f); wr[i] = (bf16)f2bf(v); }
      bf16* hb = (bf16*)(F.ws + WS_HB); const float* x = a.in[0];
      for (int i = gt; i < M * D / 8; i += NT) { const f32x4 p = *(const GAS f32x4*)(x + (size_t)i * 8), q = *(const GAS f32x4*)(x + (size_t)i * 8 + 4);
          *(GAS v4u*)(hb + (size_t)i * 8) = (v4u){pk2(p.x, p.y), pk2(p.z, p.w), pk2(q.x, q.y), pk2(q.z, q.w)}; } }
}

__device__ __forceinline__ void p0_moe_weights(Frame& F, const Args& a, int l0, int wg_idx, int nwg) {
    PHASE_IDS
    LAS float* scr = (LAS float*)(F.lds + F.wave * 16384);
    bf16* w13 = (bf16*)(F.ws + WS_W13); bf16* w2 = (bf16*)(F.ws + WS_W2);
    constexpr int I_W13 = 16 * 32, I_W2 = 8 * 32;
    const int gw = wg_idx * NWAVES + F.wave, NGW = nwg * NWAVES;
    for (int it = gw; it < 64 * (I_W13 + I_W2); it += NGW) {
        int r = it;
        if (r < 64 * I_W13) { const int mat = l0 * 32 + r / I_W13; r = r % I_W13; p0_job(r, a.in[18] + (size_t)mat * 1024 * 1024, 1024, 1024, 32, w13 + (size_t)mat * 1024 * 1024, 0, true, scr, lane); }
        else { r -= 64 * I_W13; const int mat = l0 * 32 + r / I_W2; r = r % I_W2; p0_job(r, a.in[19] + (size_t)mat * 512 * 1024, 512, 1024, 32, w2 + (size_t)mat * 1024 * 512, 0, false, scr, lane); }
    }
}

__device__ __forceinline__ void ln_rows8(Frame& F, const int lane, const float* hin, const float* mix, const float* g, const float* b, float* h1, bf16* h1b, int row0) {
    for (int rr = 0; rr < 8; ++rr) {
        const int row = row0 + rr;
        const GAS f32x4* hr = (const GAS f32x4*)(hin + (size_t)row * D) + lane; const GAS f32x4* mr = (const GAS f32x4*)(mix + (size_t)row * D) + lane;
        f32x4 v[4]; float s = 0.f;
#pragma unroll
        for (int j = 0; j < 4; ++j) { v[j] = hr[64 * j] * ALPHA + mr[64 * j]; s += (v[j].x + v[j].y) + (v[j].z + v[j].w); }
        const float mean = wave_sum(s) * (1.f / D); float s2 = 0.f;
#pragma unroll
        for (int j = 0; j < 4; ++j) { v[j] = v[j] - mean; s2 += (v[j].x * v[j].x + v[j].y * v[j].y) + (v[j].z * v[j].z + v[j].w * v[j].w); }
        const float rstd = 1.f / sqrtf(wave_sum(s2) * (1.f / D) + LN_EPS);
        GAS f32x4* o4 = (GAS f32x4*)(h1 + (size_t)row * D) + lane; GAS unsigned long long* o8 = (GAS unsigned long long*)(h1b + (size_t)row * D) + lane;
#pragma unroll
        for (int j = 0; j < 4; ++j) { const f32x4 gv = *((const GAS f32x4*)g + lane + 64 * j), bv = *((const GAS f32x4*)b + lane + 64 * j);
            const f32x4 y = v[j] * rstd * gv + bv; o4[64 * j] = y;
            o8[64 * j] = (unsigned long long)pk2(y.x, y.y) | ((unsigned long long)pk2(y.z, y.w) << 32); }
    }
}
__device__ __forceinline__ void phase_ln1_router(Frame& F, const float* hin, const float* mix, const float* g, const float* b, float* h1, bf16* h1b, const bf16* wr,
                                                 int* eid, float* gate, gu32* counts) {
    PHASE_IDS
    LAS float* lg = (LAS float*)(F.lds);
    LAS int* lcnt = (LAS int*)(F.lds + 16384);
    for (int blk = F.vcu; blk < M / 64; blk += F.G) {
        const int row0 = blk * 64;
        if (tid < 32) lcnt[tid] = 0;
        ln_rows8(F, lane, hin, mix, g, b, h1, h1b, row0 + F.wave * 8);
        VM_WAIT(); __syncthreads();
        if (F.wave < 4) {
            const int fr = lane & 15, fq = lane >> 4;
            const bf16* ap = h1b + (size_t)(row0 + F.wave * 16 + fr) * D + fq * 8;
            f32x4 acc[3]; acc[0] = (f32x4){0.f, 0.f, 0.f, 0.f}; acc[1] = acc[0]; acc[2] = acc[0];
#pragma unroll 4
            for (int ks = 0; ks < 32; ++ks) {
                const bf16x8 av = *(const GAS bf16x8*)(ap + ks * 32);
#pragma unroll
                for (int ct = 0; ct < 3; ++ct) { const bf16x8 bv = *(const GAS bf16x8*)(wr + (size_t)(ct * 16 + fr) * D + ks * 32 + fq * 8);
                    acc[ct] = __builtin_amdgcn_mfma_f32_16x16x32_bf16(av, bv, acc[ct], 0, 0, 0); }
            }
#pragma unroll
            for (int ct = 0; ct < 3; ++ct)
#pragma unroll
                for (int r = 0; r < 4; ++r) lg[(F.wave * 16 + 4 * fq + r) * 52 + ct * 16 + fr] = acc[ct][r];
            LDS_WAIT(); asm volatile("" ::: "memory");
            if (lane < 16) {
                const int rl = F.wave * 16 + lane; const LAS float* L = lg + rl * 52;
                int gi = 0; float gm = L[0];
                for (int q = 1; q < 4; ++q) if (L[q] > gm) { gm = L[q]; gi = q; }
                float gs = 0.f; for (int q = 0; q < 4; ++q) gs += __expf(L[q] - gm);
                const float pg = 1.f / gs; const LAS float* el = L + 4 + gi * 8;
                int i0 = 0; float v0 = el[0];
                for (int i = 1; i < 8; ++i) if (el[i] > v0) { v0 = el[i]; i0 = i; }
                int i1 = 0; float v1 = -INFINITY;
                for (int i = 0; i < 8; ++i) if (i != i0 && el[i] > v1) { v1 = el[i]; i1 = i; }
                const float e1 = __expf(v1 - v0); const int tok = row0 + rl, ea = gi * 8 + i0, eb = gi * 8 + i1;
                eid[2 * tok] = ea; eid[2 * tok + 1] = eb; gate[2 * tok] = pg / (1.f + e1); gate[2 * tok + 1] = pg * e1 / (1.f + e1);
                atomicAdd((int*)&lcnt[ea], 1); atomicAdd((int*)&lcnt[eb], 1);
            }
        }
        LDS_WAIT(); __syncthreads();
        if (tid < 32) { const int c = lcnt[tid]; if (c) __hip_atomic_fetch_add(counts + tid, (unsigned)c, __ATOMIC_RELAXED, __HIP_MEMORY_SCOPE_AGENT); }
        __syncthreads();
    }
}
__device__ __forceinline__ int moe_layout(Frame& F, const gu32* counts, LAS int* ps, LAS int* tile_e) {
    PHASE_IDS
    if (tid == 0) { int acc = 0; for (int e = 0; e < NEXP; ++e) { ps[e] = acc; const int c = (int)__hip_atomic_load(counts + e, __ATOMIC_RELAXED, __HIP_MEMORY_SCOPE_AGENT); const int nt = (c + 255) >> 8;
            for (int t = 0; t < nt; ++t) tile_e[(acc >> 8) + t] = e; acc += nt << 8; } ps[NEXP] = acc; }
    LDS_WAIT(); __syncthreads();
    return __builtin_amdgcn_readfirstlane(ps[NEXP]) >> 8;
}
__device__ __forceinline__ void phase_scatter(Frame& F, const gu32* counts, gu32* cursor, const int* eid, const bf16* h1b, bf16* xrows, int* apos) {
    PHASE_IDS
    LAS int* ps = (LAS int*)(F.lds + 20480); LAS int* tile_e = (LAS int*)(F.lds + TILEE_OFF);
    LAS int* lcnt = (LAS int*)(F.lds + 16384); LAS int* lbase = (LAS int*)(F.lds + 16384 + 256); LAS int* lpos = (LAS int*)(F.lds + 16384 + 512);
    (void)moe_layout(F, counts, ps, tile_e);
    for (int blk = F.vcu; blk < M / 64; blk += F.G) {
        if (tid < 32) lcnt[tid] = 0;
        __syncthreads();
        int e = 0, rk = 0;
        if (tid < 128) { e = eid[blk * 128 + tid]; rk = atomicAdd((int*)&lcnt[e], 1); }
        LDS_WAIT(); __syncthreads();
        if (tid < 32) { const int c = lcnt[tid]; lbase[tid] = c ? (int)__hip_atomic_fetch_add(cursor + tid, (unsigned)c, __ATOMIC_RELAXED, __HIP_MEMORY_SCOPE_AGENT) : 0; }
        LDS_WAIT(); __syncthreads();
        if (tid < 128) { const int pos = ps[e] + lbase[e] + rk; lpos[tid] = pos; apos[blk * 128 + tid] = pos; }
        LDS_WAIT(); __syncthreads();
        for (int a = F.wave; a < 128; a += NWAVES) {
            const int tok = blk * 64 + (a >> 1), pos = lpos[a];
            const GAS v4u* src = (const GAS v4u*)(h1b + (size_t)tok * D) + lane; GAS v4u* dst = (GAS v4u*)(xrows + (size_t)pos * D) + lane;
            const v4u p0 = src[0], p1 = src[64]; dst[0] = p0; dst[64] = p1;
        }
        __syncthreads();
    }
}
__device__ __forceinline__ void phase_combine_ln2(Frame& F, const float* h1, const bf16* yrows, const int* apos, const float* gate, const float* g, const float* b, float* hout, bf16* hb) {
    PHASE_IDS
    const int gw = F.vcu * NWAVES + F.wave, NGW = F.G * NWAVES;
    for (int row = gw; row < M; row += NGW) {
        const int p0 = apos[2 * row], p1 = apos[2 * row + 1]; const float g0 = gate[2 * row], g1 = gate[2 * row + 1];
        const GAS f32x4* hr = (const GAS f32x4*)(h1 + (size_t)row * D) + lane;
        const GAS unsigned long long* y0 = (const GAS unsigned long long*)(yrows + (size_t)p0 * D) + lane; const GAS unsigned long long* y1 = (const GAS unsigned long long*)(yrows + (size_t)p1 * D) + lane;
        f32x4 v[4]; float s = 0.f;
#pragma unroll
        for (int j = 0; j < 4; ++j) { const unsigned long long a = y0[64 * j], c = y1[64 * j];
            f32x4 ya, yc;
            ya.x = __uint_as_float(((unsigned)a) << 16); ya.y = __uint_as_float(((unsigned)a) & 0xffff0000u); ya.z = __uint_as_float(((unsigned)(a >> 32)) << 16); ya.w = __uint_as_float(((unsigned)(a >> 32)) & 0xffff0000u);
            yc.x = __uint_as_float(((unsigned)c) << 16); yc.y = __uint_as_float(((unsigned)c) & 0xffff0000u); yc.z = __uint_as_float(((unsigned)(c >> 32)) << 16); yc.w = __uint_as_float(((unsigned)(c >> 32)) & 0xffff0000u);
            v[j] = hr[64 * j] * ALPHA + ya * g0 + yc * g1; s += (v[j].x + v[j].y) + (v[j].z + v[j].w); }
        const float mean = wave_sum(s) * (1.f / D); float s2 = 0.f;
#pragma unroll
        for (int j = 0; j < 4; ++j) { v[j] = v[j] - mean; s2 += (v[j].x * v[j].x + v[j].y * v[j].y) + (v[j].z * v[j].z + v[j].w * v[j].w); }
        const float rstd = 1.f / sqrtf(wave_sum(s2) * (1.f / D) + LN_EPS);
        GAS f32x4* o4 = (GAS f32x4*)(hout + (size_t)row * D) + lane; GAS unsigned long long* o8 = (GAS unsigned long long*)(hb + (size_t)row * D) + lane;
#pragma unroll
        for (int j = 0; j < 4; ++j) { const f32x4 gv = *((const GAS f32x4*)g + lane + 64 * j), bv = *((const GAS f32x4*)b + lane + 64 * j);
            const f32x4 y = v[j] * rstd * gv + bv; o4[64 * j] = y;
            o8[64 * j] = (unsigned long long)pk2(y.x, y.y) | ((unsigned long long)pk2(y.z, y.w) << 32); }
    }
}

__device__ __forceinline__ void phase_attn_combine(Frame& F, const bf16* O1, const bf16* O2, const float* lam_p, const float* subln, float lam_init, bf16* on) {
    PHASE_IDS
    const float l01 = wave_sum(lam_p[lane] * lam_p[64 + lane]), l23 = wave_sum(lam_p[128 + lane] * lam_p[192 + lane]);
    const float lam = __expf(l01) - __expf(l23) + lam_init;
    float sw[16];
#pragma unroll
    for (int i = 0; i < 16; ++i) sw[i] = subln[(lane & 7) * 16 + i] * (1.f - lam_init);
    const int gw = F.vcu * NWAVES + F.wave, NGW = F.G * NWAVES;
    for (int row = gw; row < M; row += NGW) {
        const GAS v4u* p1 = (const GAS v4u*)(O1 + (size_t)row * D) + 2 * lane; const GAS v4u* p2 = (const GAS v4u*)(O2 + (size_t)row * D) + 2 * lane;
        const v4u a0 = p1[0], a1 = p1[1], b0 = p2[0], b1 = p2[1];
        const unsigned aw[8] = {a0.x, a0.y, a0.z, a0.w, a1.x, a1.y, a1.z, a1.w}, bw[8] = {b0.x, b0.y, b0.z, b0.w, b1.x, b1.y, b1.z, b1.w};
        float o[16]; float ss = 0.f;
#pragma unroll
        for (int i = 0; i < 8; ++i) { o[2 * i] = __uint_as_float(aw[i] << 16) - lam * __uint_as_float(bw[i] << 16); o[2 * i + 1] = __uint_as_float(aw[i] & 0xffff0000u) - lam * __uint_as_float(bw[i] & 0xffff0000u);
            ss += o[2 * i] * o[2 * i] + o[2 * i + 1] * o[2 * i + 1]; }
        ss += __shfl_xor(ss, 1); ss += __shfl_xor(ss, 2); ss += __shfl_xor(ss, 4);
        const float r = 1.f / sqrtf(ss * (1.f / 128.f) + RMS_EPS);
        v4u w0, w1;
        w0.x = pk2(o[0] * r * sw[0], o[1] * r * sw[1]); w0.y = pk2(o[2] * r * sw[2], o[3] * r * sw[3]); w0.z = pk2(o[4] * r * sw[4], o[5] * r * sw[5]); w0.w = pk2(o[6] * r * sw[6], o[7] * r * sw[7]);
        w1.x = pk2(o[8] * r * sw[8], o[9] * r * sw[9]); w1.y = pk2(o[10] * r * sw[10], o[11] * r * sw[11]); w1.z = pk2(o[12] * r * sw[12], o[13] * r * sw[13]); w1.w = pk2(o[14] * r * sw[14], o[15] * r * sw[15]);
        GAS v4u* q = (GAS v4u*)(on + (size_t)row * D) + 2 * lane; q[0] = w0; q[1] = w1;
    }
}

typedef short s16x4v __attribute__((ext_vector_type(4)));
typedef short v4i16_t __attribute__((ext_vector_type(4)));
constexpr size_t WS_WNEG = WS_FAST_END;
constexpr size_t WS_QDEC = WS_WNEG + (size_t)2048 * 64 * 128 * 2;
constexpr size_t WS_KDEC = WS_QDEC + (size_t)2048 * 64 * 128 * 2;
constexpr size_t WS_ATT = WS_KDEC + (size_t)2048 * 64 * 128 * 2;
constexpr size_t WS_U = WS_ATT + (size_t)2048 * 64 * 64 * 2;
constexpr size_t WS_GLAST = WS_U + (size_t)2048 * 64 * 128 * 4;
constexpr size_t WS_OB = WS_GLAST + 8192;
constexpr size_t WS_DN_END = WS_OB + (size_t)M * D * 2;

__device__ __forceinline__ float bf2f(unsigned short v) { return __uint_as_float((unsigned)v << 16); }
__device__ __forceinline__ float silu_f(float x) { return x / (1.f + __expf(-x)); }
__device__ __forceinline__ s16x4v pack4(const f32x4 v) { s16x4v r; const unsigned a = pk2(v[0], v[1]), b = pk2(v[2], v[3]); r[0] = (short)(a & 0xffff); r[1] = (short)(a >> 16); r[2] = (short)(b & 0xffff); r[3] = (short)(b >> 16); return r; }
__device__ __forceinline__ bf16x8 pack8(const f32x4 lo, const f32x4 hi) { const unsigned a = pk2(lo[0], lo[1]), b = pk2(lo[2], lo[3]), c = pk2(hi[0], hi[1]), d = pk2(hi[2], hi[3]); return __builtin_bit_cast(bf16x8, (v4u){a, b, c, d}); }
#define MFMA16(a, b, c) __builtin_amdgcn_mfma_f32_16x16x16bf16_1k((a), (b), (c), 0, 0, 0)
#define MFMA32(a, b, c) __builtin_amdgcn_mfma_f32_16x16x32_bf16((a), (b), (c), 0, 0, 0)

__device__ __forceinline__ void conv8(const bf16* projb, int row, int pos, int col, const float* cw, float (&out)[8]) {
#pragma unroll
    for (int e = 0; e < 8; ++e) out[e] = 0.f;
#pragma unroll
    for (int j = 0; j < 4; ++j) {
        const bool ok = (pos - 3 + j) >= 0;
        v4u x = *(const GAS v4u*)(projb + (size_t)(ok ? row - 3 + j : row) * NINP + col);
        if (!ok) x = (v4u){0u, 0u, 0u, 0u};
        const f32x4 w0 = *(const GAS f32x4*)(cw + j * 3072 + col), w1 = *(const GAS f32x4*)(cw + j * 3072 + col + 4);
        out[0] = fmaf(w0.x, __uint_as_float(x.x << 16), out[0]); out[1] = fmaf(w0.y, __uint_as_float(x.x & 0xffff0000u), out[1]);
        out[2] = fmaf(w0.z, __uint_as_float(x.y << 16), out[2]); out[3] = fmaf(w0.w, __uint_as_float(x.y & 0xffff0000u), out[3]);
        out[4] = fmaf(w1.x, __uint_as_float(x.z << 16), out[4]); out[5] = fmaf(w1.y, __uint_as_float(x.z & 0xffff0000u), out[5]);
        out[6] = fmaf(w1.z, __uint_as_float(x.w << 16), out[6]); out[7] = fmaf(w1.w, __uint_as_float(x.w & 0xffff0000u), out[7]);
    }
#pragma unroll
    for (int e = 0; e < 8; ++e) out[e] = silu_f(out[e]);
}
__device__ __forceinline__ f32x4 conv1x4(const bf16* projb, int rowb, int posb, int col, const float* cw) {
    float x[7];
#pragma unroll
    for (int i = 0; i < 7; ++i) { const bool ok = (posb - 3 + i) >= 0; const float v = bf2f(*(const GAS unsigned short*)(projb + (size_t)(ok ? rowb - 3 + i : rowb) * NINP + col)); x[i] = ok ? v : 0.f; }
    const float w0 = cw[col], w1 = cw[3072 + col], w2 = cw[2 * 3072 + col], w3 = cw[3 * 3072 + col];
    f32x4 o;
#pragma unroll
    for (int r = 0; r < 4; ++r) o[r] = silu_f(fmaf(w3, x[r + 3], fmaf(w2, x[r + 2], fmaf(w1, x[r + 1], w0 * x[r]))));
    return o;
}

__device__ __forceinline__ void phase_dn_prep(Frame& F, const bf16* projb_, const float* convw_, const float* a_log, const float* dt_bias,
                                              bf16* wneg_, bf16* qdec_, bf16* kdec_, bf16* attn_, float* ubuf_, float* glast) {
    const int hh = F.wave;
    { const int unit = F.vcu;
        const float A_h = __expf(a_log[hh]), dtb = dt_bias[hh];
        int lane_ = (int)__builtin_amdgcn_mbcnt_hi(~0u, __builtin_amdgcn_mbcnt_lo(~0u, 0u)); asm volatile("" : "+v"(lane_));
        const int lane = lane_, fr = lane & 15, fq = lane >> 4;
        const float* convw = convw_; asm volatile("" : "+s"(convw));
        const bf16* projb = projb_; asm volatile("" : "+s"(projb));
        bf16* wneg = wneg_; bf16* qdec = qdec_; bf16* kdec = kdec_; bf16* attn = attn_; float* ubuf = ubuf_; asm volatile("" : "+s"(wneg), "+s"(qdec), "+s"(kdec), "+s"(attn), "+s"(ubuf));
        unsigned ldsb = 0; asm volatile("" : "+s"(ldsb));
        LAS float* gcs = (LAS float*)(F.lds + ldsb + PREP_SC_OFF + F.wave * 768); LAS float* bes = gcs + 64; LAS float* rnk = gcs + 128;
        LAS unsigned char* tw = F.lds + ldsb + F.wave * 16384;
        const int b = unit >> 7, n = unit & 127, t0 = n * 64, row0 = b * T + t0, cid = (b * 8 + hh) * 128 + n;
        {
            const int row = row0 + lane;
            const float bl = bf2f(projb[(size_t)row * NINP + 4096 + hh]), al = bf2f(projb[(size_t)row * NINP + 4104 + hh]);
            const float x = al + dtb; const float sp = (x > 20.f) ? x : log1pf(__expf(x));
            float c = -A_h * sp;
#pragma unroll
            for (int o = 1; o < 64; o <<= 1) { const float t = __shfl_up(c, o); if (lane >= o) c += t; }
            gcs[lane] = c; bes[lane] = 1.f / (1.f + __expf(-bl));
        }
        LDS_WAIT(); asm volatile("" ::: "memory");
        const float gl = gcs[63];
        if (lane == 0) glast[cid] = __expf(gl);
#pragma unroll 1
        for (int t = 0; t < 4; ++t) {
            int lb_ = lane; asm volatile("" : "+v"(lb_)); const int fr = lb_ & 15, fq = lb_ >> 4;
            const int tok = 16 * t + fr; float v[4][8]; float ss = 0.f;
#pragma unroll
            for (int ks = 0; ks < 4; ++ks) { conv8(projb, row0 + tok, t0 + tok, 1024 + hh * 128 + 32 * ks + 8 * fq, convw, v[ks]);
#pragma unroll
                for (int e = 0; e < 8; ++e) ss = fmaf(v[ks][e], v[ks][e], ss); }
            ss += __shfl_xor(ss, 16); ss += __shfl_xor(ss, 32);
            const float rn = 1.f / sqrtf(ss + RMS_EPS);
            if (fq == 0) rnk[tok] = rn;
            const float kd = rn * __expf(gl - gcs[tok]);
#pragma unroll
            for (int ks = 0; ks < 4; ++ks) {
                *(LAS v4u*)(tw + tok * 256 + (((4 * ks + fq) ^ fr) << 4)) = (v4u){pk2(v[ks][0] * rn, v[ks][1] * rn), pk2(v[ks][2] * rn, v[ks][3] * rn), pk2(v[ks][4] * rn, v[ks][5] * rn), pk2(v[ks][6] * rn, v[ks][7] * rn)};
                *(GAS v4u*)(kdec + ((size_t)cid * 64 + tok) * 128 + 32 * ks + 8 * fq) = (v4u){pk2(v[ks][0] * kd, v[ks][1] * kd), pk2(v[ks][2] * kd, v[ks][3] * kd), pk2(v[ks][4] * kd, v[ks][5] * kd), pk2(v[ks][6] * kd, v[ks][7] * kd)};
            }
        }
        LDS_WAIT(); asm volatile("" ::: "memory");
#define KFRAG(t_, ks_) (*(const LAS bf16x8*)(tw + (16 * (t_) + fr) * 256 + (((4 * (ks_) + fq) ^ fr) << 4)))
        bf16* attc = attn + (size_t)cid * 64 * 64;
#pragma unroll 1
        for (int ti = 0; ti < 4; ++ti) {
            int lc_ = lane; asm volatile("" : "+v"(lc_)); const int fr = lc_ & 15, fq = lc_ >> 4;
            bf16x8 qf[4];
            { const int tok = 16 * ti + fr; float v[4][8]; float ss = 0.f;
#pragma unroll
              for (int ks = 0; ks < 4; ++ks) { conv8(projb, row0 + tok, t0 + tok, hh * 128 + 32 * ks + 8 * fq, convw, v[ks]);
#pragma unroll
                  for (int e = 0; e < 8; ++e) ss = fmaf(v[ks][e], v[ks][e], ss); }
              ss += __shfl_xor(ss, 16); ss += __shfl_xor(ss, 32);
              const float rn = 1.f / sqrtf(ss + RMS_EPS);
              const float qd = rn * 0.08838834764831845f * __expf(gcs[tok]);
#pragma unroll
              for (int ks = 0; ks < 4; ++ks) {
                  qf[ks] = __builtin_bit_cast(bf16x8, (v4u){pk2(v[ks][0] * rn, v[ks][1] * rn), pk2(v[ks][2] * rn, v[ks][3] * rn), pk2(v[ks][4] * rn, v[ks][5] * rn), pk2(v[ks][6] * rn, v[ks][7] * rn)});
                  *(GAS v4u*)(qdec + ((size_t)cid * 64 + tok) * 128 + 32 * ks + 8 * fq) = (v4u){pk2(v[ks][0] * qd, v[ks][1] * qd), pk2(v[ks][2] * qd, v[ks][3] * qd), pk2(v[ks][4] * qd, v[ks][5] * qd), pk2(v[ks][6] * qd, v[ks][7] * qd)};
              } }
#pragma unroll 1
            for (int tj = 0; tj <= ti; ++tj) {
                f32x4 acc = (f32x4){0.f, 0.f, 0.f, 0.f};
#pragma unroll
                for (int ks = 0; ks < 4; ++ks) acc = MFMA32(qf[ks], KFRAG(tj, ks), acc);
                const int j = 16 * tj + fr; const float gj = gcs[j];
#pragma unroll
                for (int r = 0; r < 4; ++r) { const int i = 16 * ti + 4 * fq + r; const float a = (i >= j) ? acc[r] * 0.08838834764831845f * __expf(gcs[i] - gj) : 0.f;
                    attc[i * 64 + j] = (bf16)f2bf(a); }
            }
            if ((ti & 1) == 0) {
#pragma unroll
                for (int r = 0; r < 4; ++r) attc[(16 * ti + 4 * fq + r) * 64 + 16 * (ti + 1) + fr] = (bf16)0;
            }
        }
        s16x4v nAoff[4][4];
        s16x4v P1n[4], P2[4], P4[4], P8[4];
#pragma unroll
        for (int ti = 0; ti < 4; ++ti)
#pragma unroll
            for (int tj = 0; tj <= ti; ++tj) {
                int le_ = lane; asm volatile("" : "+v"(le_)); const int fr = le_ & 15, fq = le_ >> 4;
                f32x4 acc = (f32x4){0.f, 0.f, 0.f, 0.f};
#pragma unroll
                for (int ks = 0; ks < 4; ++ks) acc = MFMA32(KFRAG(tj, ks), KFRAG(ti, ks), acc);
                const int i = 16 * ti + fr; const float bi = bes[i], gi = gcs[i];
                f32x4 aop;
#pragma unroll
                for (int r = 0; r < 4; ++r) { const int j = 16 * tj + 4 * fq + r; aop[r] = (i > j) ? bi * acc[r] * __expf(gi - gcs[j]) : 0.f; }
                if (tj < ti) { nAoff[ti][tj] = pack4(-aop); }
                else {
                    f32x4 bop;
#pragma unroll
                    for (int r = 0; r < 4; ++r) { const int rw = 16 * ti + 4 * fq + r; bop[r] = (rw > i) ? bes[rw] * acc[r] * __expf(gcs[rw] - gi) : 0.f; }
                    const s16x4v a1 = pack4(aop), b1 = pack4(bop);
                    const f32x4 z = (f32x4){0.f, 0.f, 0.f, 0.f};
                    const s16x4v a2 = pack4(MFMA16(b1, a1, z)), b2 = pack4(MFMA16(a1, b1, z));
                    const s16x4v a4 = pack4(MFMA16(b2, a2, z)), b4 = pack4(MFMA16(a2, b2, z));
                    const s16x4v a8 = pack4(MFMA16(b4, a4, z));
                    P1n[ti] = pack4(-aop); P2[ti] = a2; P4[ti] = a4; P8[ti] = a8;
                }
            }
#undef KFRAG
#define TILE_EL(tok_, ch_) bf2f(*(const LAS unsigned short*)(tw + (tok_) * 256 + (((((ch_) >> 3)) ^ ((tok_) & 15)) << 4) + ((ch_) & 7) * 2))
#define SOLVE_PASS(PASS) do { \
        _Pragma("unroll 1") for (int c8 = 0; c8 < 8; ++c8) { \
            int lo2_ = lane; asm volatile("" : "+v"(lo2_)); const int fr = lo2_ & 15, fq = lo2_ >> 4; \
            const int ch = 16 * c8 + fr; \
            s16x4v Xb[4]; \
            _Pragma("unroll") for (int bi = 0; bi < 4; ++bi) { \
                const int tokb = 16 * bi + 4 * fq; \
                f32x4 Y; \
                _Pragma("unroll") for (int r = 0; r < 4; ++r) { const int tok = tokb + r; float f = bes[tok]; if ((PASS) == 0) f *= __expf(gcs[tok]); Y[r] = TILE_EL(tok, ch) * f; } \
                _Pragma("unroll") for (int bj = 0; bj < 4; ++bj) if (bj < bi) Y = MFMA16(nAoff[bi][bj], Xb[bj], Y); \
                Y = MFMA16(P8[bi], pack4(Y), Y); Y = MFMA16(P4[bi], pack4(Y), Y); Y = MFMA16(P2[bi], pack4(Y), Y); Y = MFMA16(P1n[bi], pack4(Y), Y); \
                Xb[bi] = pack4(Y); \
                if ((PASS) == 1) { *(GAS f32x4*)(ubuf + (size_t)cid * 64 * 128 + (size_t)((c8 * 4 + bi) * 64 + lo2_) * 4) = Y; } \
                else { _Pragma("unroll") for (int r = 0; r < 4; ++r) wneg[((size_t)cid * 64 + tokb + r) * 128 + ch] = (bf16)f2bf(-Y[r]); } \
            } } } while (0)
        SOLVE_PASS(0);
        LDS_WAIT(); asm volatile("" ::: "memory");
        {
            int lo3_ = lane; asm volatile("" : "+v"(lo3_)); const int fr = lo3_ & 15, fq = lo3_ >> 4;
#pragma unroll 1
            for (int t = 0; t < 4; ++t) {
                const int tok = 16 * t + fr;
#pragma unroll
                for (int ks = 0; ks < 4; ++ks) { float v[8]; conv8(projb, row0 + tok, t0 + tok, 2048 + hh * 128 + 32 * ks + 8 * fq, convw, v);
                    *(LAS v4u*)(tw + tok * 256 + (((4 * ks + fq) ^ fr) << 4)) = (v4u){pk2(v[0], v[1]), pk2(v[2], v[3]), pk2(v[4], v[5]), pk2(v[6], v[7])}; }
            }
        }
        LDS_WAIT(); asm volatile("" ::: "memory");
        SOLVE_PASS(1);
#undef SOLVE_PASS
#undef TILE_EL
        LDS_WAIT(); asm volatile("" ::: "memory");
    }
}

constexpr int SC_W = 0, SC_Q = 16384, SC_K = 32768, SC_A = 51200, SC_SET = 60416;
__device__ __forceinline__ bf16x8 lds_a8(const LAS unsigned char* p) {
    const unsigned long long lo = *(const LAS unsigned long long*)p, hi = *(const LAS unsigned long long*)(p + 32);
    return __builtin_bit_cast(bf16x8, (v4u){(unsigned)lo, (unsigned)(lo >> 32), (unsigned)hi, (unsigned)(hi >> 32)});
}
__device__ __forceinline__ bf16x8 lds_tr8(const LAS unsigned char* p, int rowstride16) {
    const s16x4v lo = __builtin_bit_cast(s16x4v, __builtin_amdgcn_ds_read_tr16_b64_v4i16((LAS v4i16_t*)p));
    const s16x4v hi = __builtin_bit_cast(s16x4v, __builtin_amdgcn_ds_read_tr16_b64_v4i16((LAS v4i16_t*)(p + rowstride16)));
    return (bf16x8){lo[0], lo[1], lo[2], lo[3], hi[0], hi[1], hi[2], hi[3]};
}
__device__ __forceinline__ void phase_dn_scan(Frame& F, const bf16* wneg, const bf16* qdec, const bf16* kdec, const bf16* attn, const float* ubuf, const float* glast, bf16* obuf) {
    PHASE_IDS
    const int fr = lane & 15, fq = lane >> 4;
    const int bh = F.vcu >> 1, half = F.vcu & 1, b = bh >> 3, hh = bh & 7, cid0 = bh * 128;
    LAS unsigned char* L = F.lds;
    if (F.wave >= 4) {
        const int lt = (F.wave - 4) * 64 + lane;
        v4u ra[14], rb[14], rc[14];
#define SC_LOAD(R, c) do { const size_t cb = (size_t)(cid0 + (c)) * 64 * 128; \
        _Pragma("unroll") for (int i = 0; i < 4; ++i) { const int p = lt + 256 * i; R[i] = *(const GAS v4u*)(wneg + cb + (size_t)p * 8); R[4 + i] = *(const GAS v4u*)(qdec + cb + (size_t)p * 8); R[8 + i] = *(const GAS v4u*)(kdec + cb + (size_t)p * 8); } \
        _Pragma("unroll") for (int i = 0; i < 2; ++i) { const int p = lt + 256 * i; R[12 + i] = *(const GAS v4u*)(attn + (size_t)(cid0 + (c)) * 64 * 64 + (size_t)p * 8); } } while (0)
#define SC_WRITE(R, set) do { LAS unsigned char* S_ = L + (set) * SC_SET; \
        _Pragma("unroll") for (int i = 0; i < 4; ++i) { const int p = lt + 256 * i, row = p >> 4, c16 = p & 15, sb = c16 >> 2, c = c16 & 3; \
            const int o0 = row * 256 + ((((4 * sb + ((2 * c) & 3)) ^ (row & 15)) << 4) | ((c >> 1) << 3)), o1 = row * 256 + ((((4 * sb + ((2 * c + 1) & 3)) ^ (row & 15)) << 4) | ((c >> 1) << 3)); \
            *(LAS unsigned long long*)(S_ + SC_W + o0) = (unsigned long long)R[i].x | ((unsigned long long)R[i].y << 32); *(LAS unsigned long long*)(S_ + SC_W + o1) = (unsigned long long)R[i].z | ((unsigned long long)R[i].w << 32); \
            *(LAS unsigned long long*)(S_ + SC_Q + o0) = (unsigned long long)R[4 + i].x | ((unsigned long long)R[4 + i].y << 32); *(LAS unsigned long long*)(S_ + SC_Q + o1) = (unsigned long long)R[4 + i].z | ((unsigned long long)R[4 + i].w << 32); \
            *(LAS v4u*)(S_ + SC_K + row * 288 + c16 * 16) = R[8 + i]; } \
        _Pragma("unroll") for (int i = 0; i < 2; ++i) { const int p = lt + 256 * i, row = p >> 3, c16 = p & 7, sb = c16 >> 2, c = c16 & 3; \
            const int o0 = row * 144 + 64 * sb + 16 * ((2 * c) & 3) + 8 * (c >> 1), o1 = row * 144 + 64 * sb + 16 * ((2 * c + 1) & 3) + 8 * (c >> 1); \
            *(LAS unsigned long long*)(S_ + SC_A + o0) = (unsigned long long)R[12 + i].x | ((unsigned long long)R[12 + i].y << 32); *(LAS unsigned long long*)(S_ + SC_A + o1) = (unsigned long long)R[12 + i].z | ((unsigned long long)R[12 + i].w << 32); } } while (0)
#define SC_LSTEP(R, set, n) do { if ((n) + 1 < 128) SC_WRITE(R, set); if ((n) + 4 < 128) SC_LOAD(R, (n) + 4); LDS_WAIT(); __builtin_amdgcn_s_barrier(); } while (0)
        SC_LOAD(ra, 0); SC_LOAD(rb, 1); SC_LOAD(rc, 2);
        SC_WRITE(ra, 0); SC_LOAD(ra, 3);
        LDS_WAIT(); __builtin_amdgcn_s_barrier();
#pragma unroll 1
        for (int n = 0; n < 126; n += 6) {
            SC_LSTEP(rb, 1, n); SC_LSTEP(rc, 0, n + 1); SC_LSTEP(ra, 1, n + 2); SC_LSTEP(rb, 0, n + 3); SC_LSTEP(rc, 1, n + 4); SC_LSTEP(ra, 0, n + 5);
        }
        SC_LSTEP(rb, 1, 126); SC_LSTEP(rc, 0, 127);
#undef SC_LOAD
#undef SC_WRITE
#undef SC_LSTEP
    } else {
        const int c0 = half * 64 + F.wave * 16, dvt = c0 >> 4;
        LAS unsigned char* oslab = F.lds + SCAN_O_OFF + F.wave * 2048;
        f32x4 S[8]; bf16x8 SB[4];
#pragma unroll
        for (int i = 0; i < 8; ++i) S[i] = (f32x4){0.f, 0.f, 0.f, 0.f};
#pragma unroll
        for (int i = 0; i < 4; ++i) SB[i] = (bf16x8){0, 0, 0, 0, 0, 0, 0, 0};
        f32x4 ua[4], ub2[4]; float gla, glb;
#define SC_ULOAD(UN, GL, c) do { const float* ub_ = ubuf + (size_t)(cid0 + (c)) * 64 * 128 + (size_t)(dvt * 4 * 64 + lane) * 4; \
        _Pragma("unroll") for (int mt = 0; mt < 4; ++mt) UN[mt] = *(const GAS f32x4*)(ub_ + mt * 256); GL = glast[cid0 + (c)]; } while (0)
        SC_ULOAD(ua, gla, 0); SC_ULOAD(ub2, glb, 1);
        __builtin_amdgcn_s_barrier();
#define SC_RD(f, base, stride, mt0) do { _Pragma("unroll") for (int m_ = 0; m_ < 2; ++m_) _Pragma("unroll") for (int s_ = 0; s_ < 4; ++s_) f[m_ * 4 + s_] = *(const LAS bf16x8*)(Sx + (base) + (16 * ((mt0) + m_) + fr) * 256 + (((4 * s_ + fq) ^ fr) << 4)); } while (0)
#define SC_MM(acc, f, mt0) do { _Pragma("unroll") for (int m_ = 0; m_ < 2; ++m_) _Pragma("unroll") for (int s_ = 0; s_ < 4; ++s_) acc[(mt0) + m_] = MFMA32(f[m_ * 4 + s_], SB[s_], acc[(mt0) + m_]); } while (0)
#define SC_SB() __builtin_amdgcn_sched_barrier(0)
#define SC_RDK(f, dt0) do { _Pragma("unroll") for (int d_ = 0; d_ < 4; ++d_) _Pragma("unroll") for (int p_ = 0; p_ < 2; ++p_) f[d_ * 2 + p_] = lds_tr8(Sx + SC_K + (32 * p_ + 4 * fq + (fr >> 2)) * 288 + (16 * ((dt0) + d_) + 4 * (fr & 3)) * 2, 16 * 288); } while (0)
#define SC_STEP(UN, GL) do {             const LAS unsigned char* Sx = L + (n & 1) * SC_SET; \
            f32x4 vn[4]; const float glc = GL; \
_Pragma("unroll") \
            for (int mt = 0; mt < 4; ++mt) vn[mt] = UN[mt]; \
            if (n + 2 < 128) SC_ULOAD(UN, GL, n + 2); \
            f32x4 o[4]; \
_Pragma("unroll") \
            for (int mt = 0; mt < 4; ++mt) o[mt] = (f32x4){0.f, 0.f, 0.f, 0.f}; \
            bf16x8 fa[8], fb[8]; \
            SC_RD(fa, SC_W, 256, 0); SC_RD(fb, SC_W, 256, 2); SC_SB(); \
            SC_MM(vn, fa, 0); SC_RD(fa, SC_Q, 256, 0); SC_SB(); \
            SC_MM(vn, fb, 2); SC_RD(fb, SC_Q, 256, 2); SC_SB(); \
            SC_MM(o, fa, 0); \
            fa[0] = *(const LAS bf16x8*)(Sx + SC_A + (0 + fr) * 144 + 16 * fq); fa[1] = *(const LAS bf16x8*)(Sx + SC_A + (16 + fr) * 144 + 16 * fq); \
            fa[2] = *(const LAS bf16x8*)(Sx + SC_A + (32 + fr) * 144 + 16 * fq); fa[3] = *(const LAS bf16x8*)(Sx + SC_A + (32 + fr) * 144 + 64 + 16 * fq); \
            fa[4] = *(const LAS bf16x8*)(Sx + SC_A + (48 + fr) * 144 + 16 * fq); fa[5] = *(const LAS bf16x8*)(Sx + SC_A + (48 + fr) * 144 + 64 + 16 * fq); SC_SB(); \
            SC_MM(o, fb, 2); \
            bf16x8 VB[2]; VB[0] = pack8(vn[0], vn[1]); VB[1] = pack8(vn[2], vn[3]); \
            SC_RDK(fb, 0); SC_SB(); \
            o[0] = MFMA32(fa[0], VB[0], o[0]); o[1] = MFMA32(fa[1], VB[0], o[1]); o[2] = MFMA32(fa[2], VB[0], o[2]); o[2] = MFMA32(fa[3], VB[1], o[2]); o[3] = MFMA32(fa[4], VB[0], o[3]); o[3] = MFMA32(fa[5], VB[1], o[3]); \
            SC_RDK(fa, 4); SC_SB(); \
_Pragma("unroll") \
            for (int dt = 0; dt < 8; ++dt) S[dt] = S[dt] * glc; \
_Pragma("unroll") \
            for (int dt = 0; dt < 4; ++dt) { S[dt] = MFMA32(fb[dt * 2], VB[0], S[dt]); S[dt] = MFMA32(fb[dt * 2 + 1], VB[1], S[dt]); } \
            SC_SB(); \
_Pragma("unroll") \
            for (int dt = 0; dt < 4; ++dt) { S[4 + dt] = MFMA32(fa[dt * 2], VB[0], S[4 + dt]); S[4 + dt] = MFMA32(fa[dt * 2 + 1], VB[1], S[4 + dt]); } \
_Pragma("unroll") \
            for (int mt = 0; mt < 4; ++mt) \
_Pragma("unroll") \
                for (int r = 0; r < 4; ++r) *(LAS unsigned short*)(oslab + (16 * mt + 4 * fq + r) * 32 + fr * 2) = (unsigned short)f2bf(o[mt][r]); \
            LDS_WAIT(); asm volatile("" ::: "memory"); \
            { bf16* ob = obuf + ((size_t)b * T + (size_t)n * 64) * D + hh * 128 + c0; \
_Pragma("unroll") \
              for (int i = 0; i < 2; ++i) { const int p = lane + 64 * i, tok = p >> 1, hf = p & 1; *(GAS v4u*)(ob + (size_t)tok * D + hf * 8) = *(const LAS v4u*)(oslab + p * 16); } } \
_Pragma("unroll") \
            for (int s = 0; s < 4; ++s) SB[s] = pack8(S[2 * s], S[2 * s + 1]); \
            LDS_WAIT(); __builtin_amdgcn_s_barrier(); } while (0)
#pragma unroll 1
        for (int n2 = 0; n2 < 128; n2 += 2) {
#pragma unroll
            for (int par = 0; par < 2; ++par) {
                const int n = n2 + par;
                if (par == 0) { SC_STEP(ua, gla); } else { SC_STEP(ub2, glb); }
            }
        }
#undef SC_STEP
#undef SC_RD
#undef SC_MM
#undef SC_RDK
#undef SC_ULOAD
    }
}
__device__ __forceinline__ void phase_dn_gate(Frame& F, const bf16* obuf, const bf16* projb, const float* norm_w, bf16* on) {
    PHASE_IDS
    float nw[16];
#pragma unroll
    for (int i = 0; i < 16; ++i) nw[i] = norm_w[(lane & 7) * 16 + i];
    const int gw = F.vcu * NWAVES + F.wave, NGW = F.G * NWAVES;
    for (int row = gw; row < M; row += NGW) {
        const GAS v4u* p1 = (const GAS v4u*)(obuf + (size_t)row * D) + 2 * lane; const GAS v4u* p2 = (const GAS v4u*)(projb + (size_t)row * NINP + 3072) + 2 * lane;
        const v4u a0 = p1[0], a1 = p1[1], b0 = p2[0], b1 = p2[1];
        const unsigned aw[8] = {a0.x, a0.y, a0.z, a0.w, a1.x, a1.y, a1.z, a1.w}, bw[8] = {b0.x, b0.y, b0.z, b0.w, b1.x, b1.y, b1.z, b1.w};
        float o[16], z[16]; float ss = 0.f;
#pragma unroll
        for (int i = 0; i < 8; ++i) { o[2 * i] = __uint_as_float(aw[i] << 16); o[2 * i + 1] = __uint_as_float(aw[i] & 0xffff0000u); z[2 * i] = __uint_as_float(bw[i] << 16); z[2 * i + 1] = __uint_as_float(bw[i] & 0xffff0000u);
            ss += o[2 * i] * o[2 * i] + o[2 * i + 1] * o[2 * i + 1]; }
        ss += __shfl_xor(ss, 1); ss += __shfl_xor(ss, 2); ss += __shfl_xor(ss, 4);
        const float r = 1.f / sqrtf(ss * (1.f / 128.f) + RMS_EPS);
        float y[16];
#pragma unroll
        for (int i = 0; i < 16; ++i) y[i] = o[i] * r * nw[i] * silu_f(z[i]);
        v4u w0, w1;
        w0.x = pk2(y[0], y[1]); w0.y = pk2(y[2], y[3]); w0.z = pk2(y[4], y[5]); w0.w = pk2(y[6], y[7]);
        w1.x = pk2(y[8], y[9]); w1.y = pk2(y[10], y[11]); w1.z = pk2(y[12], y[13]); w1.w = pk2(y[14], y[15]);
        GAS v4u* q = (GAS v4u*)(on + (size_t)row * D) + 2 * lane; q[0] = w0; q[1] = w1;
    }
}
#define PH(l, k) (1 + 16 * (l) + (k))
__global__ void __launch_bounds__(NWAVES * 64, 2) mega(Args args) {
    extern __shared__ __attribute__((aligned(16))) unsigned char lds[];
    Frame F;
    F.lds = (LAS unsigned char*)lds; F.MISC = (volatile LAS unsigned*)(F.lds + MISC_OFF);
    F.wave = __builtin_amdgcn_readfirstlane((int)threadIdx.x >> 6);
    F.G = gridDim.x; { const int bx = blockIdx.x; F.vcu = (F.G % 8 == 0) ? (bx % 8) * (F.G / 8) + bx / 8 : bx; }
    F.ws = args.ws; F.ctl = (gu32*)(args.ws + WS_CTL);
    for (int u = threadIdx.x; u < (LDS_BYTES - LDSCTL_OFF) / 4; u += NWAVES * 64) ((LAS unsigned*)(F.lds + LDSCTL_OFF))[u] = 0u;
    __syncthreads();
    const int lo = args.ph_lo, hi = args.ph_hi;
    XcdBarrier bar; bar.bar = (unsigned*)(F.ctl + CW_BAR) + args.bar_region * XCD_BAR_WORDS; bar.x = 0; bar.st = nullptr;
    if (hi - lo > 1) bar = xcd_barrier_post((unsigned*)(F.ctl + CW_BAR) + args.bar_region * XCD_BAR_WORDS, F.MISC + 8, F.wave);
    unsigned char* ws = args.ws;
    bf16* hb = (bf16*)(ws + WS_HB); float* hbuf = (float*)(ws + WS_H); float* h1 = (float*)(ws + WS_H1); bf16* h1b = (bf16*)(ws + WS_H1B);
    bf16* projb = (bf16*)(ws + WS_PROJ); bf16* Kb = (bf16*)(ws + WS_KB); bf16* Qb = Kb - (size_t)M * D; bf16* onb = (bf16*)(ws + WS_ON); float* mix = (float*)(ws + WS_MIX);
    int* eid = (int*)(ws + WS_EID); float* gate = (float*)(ws + WS_GATE); int* apos = (int*)(ws + WS_APOS);
    bf16* xrows = (bf16*)(ws + WS_XROWS); bf16* hid = (bf16*)(ws + WS_HID); bf16* yrows = (bf16*)(ws + WS_YROWS);
    LAS int* tile_e = (LAS int*)(F.lds + TILEE_OFF); LAS int* psl = (LAS int*)(F.lds + 20480);

#ifndef REPSEL
#define REPSEL(p) 0
#endif
#define IN(p) (lo <= (p) && (p) < hi)
#ifdef PROBE_A
#define STAMP() do { if (blockIdx.x == 0 && F.wave == 0 && __builtin_amdgcn_mbcnt_hi(~0u, __builtin_amdgcn_mbcnt_lo(~0u, 0u)) == 0u) { const unsigned n_ = F.MISC[12]; ((volatile LAS unsigned long long*)(F.lds + STAMP_OFF))[n_] = rt(); F.MISC[12] = n_ + 1; } } while (0)
#else
#define STAMP() do { } while (0)
#endif
#define SEAM(p) do { if ((p) + 1 < hi) xcd_barrier(bar, F.wave); STAMP(); } while (0)
#define DO_PHASE(p, cond, ...) do { if ((cond) && IN(p)) { { const int rep_ = 0; (void)rep_; __VA_ARGS__ } SEAM(p); if (REPSEL(p)) { { const int rep_ = REPSEL(p); (void)rep_; __VA_ARGS__ } if ((p) + 1 < hi) xcd_barrier(bar, F.wave); } } } while (0)
    STAMP();
    DO_PHASE(0, true, p0_prologue(F, args););
#define LAYER(l) do { \
    gu32* counts = F.ctl + CW_CNT + 128 * (l); gu32* cursor = counts + 64; \
    DO_PHASE(PH(l, 0), true, \
        if ((l) < 2) { pg8::Gemm g{hb, (const bf16*)(ws + WS_WIN) + (size_t)(l) * NINP * D, M, NINP, D}; pg8::StaticOrder S; S.init(M, NINP, F.G, (int)blockIdx.x); \
            pg8::EpiBf16<0> E{projb, NINP, nullptr, 0, 0, 1.f}; pg8::gemm_phase<pg8::EpiBf16<0>, pg8::StaticOrder, true, true>(F.lds, g, S, E, F.wave); } \
        else { const int NQ = ((l) == 2) ? 3 * D : D; pg8::Gemm g{hb, (const bf16*)(ws + ((l) == 2 ? WS_WQKV : WS_WQ3)), M, NQ, D}; pg8::StaticOrder S; S.init(M, NQ, F.G, (int)blockIdx.x); \
            pg8::EpiBf16<0> E{Qb, D, nullptr, D, (size_t)M * D, QSCALE}; pg8::gemm_phase<pg8::EpiBf16<0>, pg8::StaticOrder, true, true>(F.lds, g, S, E, F.wave); } ); \
    DO_PHASE(PH(l, 1), (l) < 2, \
        phase_dn_prep(F, projb, args.in[2] + (size_t)(l) * 4 * 3072, args.in[3] + (l) * 8, args.in[4] + (l) * 8, (bf16*)(ws + WS_WNEG), (bf16*)(ws + WS_QDEC), (bf16*)(ws + WS_KDEC), (bf16*)(ws + WS_ATT), (float*)(ws + WS_U), (float*)(ws + WS_GLAST)); ); \
    DO_PHASE(PH(l, 2), (l) < 2, \
        if (F.vcu >= 32) { if (rep_ != 1) p0_moe_weights(F, args, 2 * (l), F.vcu - 32, F.G - 32); } \
        else if (rep_ != 2) phase_dn_scan(F, (const bf16*)(ws + WS_WNEG), (const bf16*)(ws + WS_QDEC), (const bf16*)(ws + WS_KDEC), (const bf16*)(ws + WS_ATT), (const float*)(ws + WS_U), (const float*)(ws + WS_GLAST), (bf16*)(ws + WS_OB)); ); \
    DO_PHASE(PH(l, 3), (l) < 2, \
        phase_dn_gate(F, (const bf16*)(ws + WS_OB), projb, args.in[5] + (l) * 128, onb); ); \
    DO_PHASE(PH(l, 1), (l) >= 2, \
        const attn_body::AttnTensors AT{(const attn_body::bf16*)Qb, (const attn_body::bf16*)Kb, (const attn_body::bf16*)(ws + WS_VB), (attn_body::bf16*)projb, (attn_body::bf16*)(projb + (size_t)M * D)}; \
        const attn_body::StaticOrder S((int)F.G, (int)blockIdx.x); \
        attn_body::attn_phase<attn_body::StaticOrder>((char*)lds, AT, S, F.wave); ); \
    DO_PHASE(PH(l, 3), (l) >= 2, \
        phase_attn_combine(F, projb, projb + (size_t)M * D, args.in[9] + ((l) - 2) * 256, args.in[10] + ((l) - 2) * 128, args.lam_init[(l) & 1], onb); ); \
    DO_PHASE(PH(l, 4), true, \
        const bf16* W = ((l) < 2) ? (const bf16*)(ws + WS_WAOUT) + (size_t)(l) * D * D : (const bf16*)(ws + WS_WBOUT) + (size_t)((l) - 2) * D * D; \
        pg8::Gemm g{onb, W, M, D, D}; pg8::StaticOrder S; S.init(M, D, F.G, (int)blockIdx.x); \
        pg8::EpiF32 E{mix, D}; pg8::gemm_phase<pg8::EpiF32, pg8::StaticOrder, true, true>(F.lds, g, S, E, F.wave); ); \
    DO_PHASE(PH(l, 5), true, const float* hin = ((l) == 0) ? args.in[0] : hbuf; \
        phase_ln1_router(F, hin, mix, args.in[12] + (l) * D, args.in[13] + (l) * D, h1, h1b, (const bf16*)(ws + WS_WR) + (size_t)(l) * 48 * D, eid, gate, counts); ); \
    DO_PHASE(PH(l, 6), true, phase_scatter(F, counts, cursor, eid, h1b, xrows, apos); ); \
    DO_PHASE(PH(l, 7), true, const int ntiles = moe_layout(F, counts, psl, tile_e); \
        pg8::Gemm g{xrows, (const bf16*)(ws + WS_W13) + (size_t)(l) * 32 * 1024 * 1024, NROWS2, 1024, 1024}; pg8::MoeOrder S{ntiles * 4, F.G, F.vcu, tile_e}; \
        pg8::EpiSwiGLU E{hid, 512}; pg8::gemm_phase<pg8::EpiSwiGLU, pg8::MoeOrder, true, true>(F.lds, g, S, E, F.wave); ); \
    DO_PHASE(PH(l, 8), true, const int ntiles = moe_layout(F, counts, psl, tile_e); \
        pg8::Gemm g{hid, (const bf16*)(ws + WS_W2) + (size_t)(l) * 32 * 1024 * 512, NROWS2, 1024, 512}; pg8::MoeOrder S{ntiles * 4, F.G, F.vcu, tile_e}; \
        pg8::EpiBf16G E{yrows, 1024, 3}; pg8::gemm_phase<pg8::EpiBf16G, pg8::MoeOrder, true, true>(F.lds, g, S, E, F.wave); ); \
    DO_PHASE(PH(l, 9), true, float* hout = ((l) == 3) ? args.out : hbuf; \
        phase_combine_ln2(F, h1, yrows, apos, gate, args.in[14] + (l) * D, args.in[15] + (l) * D, hout, hb); ); \
    } while (0)
    LAYER(0); LAYER(1); LAYER(2); LAYER(3);
#ifdef PROBE_A
    if (blockIdx.x == 0 && F.wave == 0 && __builtin_amdgcn_mbcnt_hi(~0u, __builtin_amdgcn_mbcnt_lo(~0u, 0u)) == 0u) {
        asm volatile("s_waitcnt vmcnt(0)" ::: "memory");
        volatile LAS unsigned long long* st = (volatile LAS unsigned long long*)(F.lds + STAMP_OFF);
        const float da = (PROBE_A >= 0) ? (float)(st[PROBE_A + 1] - st[PROBE_A]) * 0.01f : 1000.f;
        const float db = (PROBE_B >= 0) ? (float)(st[PROBE_B + 1] - st[PROBE_B]) * 0.01f : 0.f;
        args.out[0] = da; args.out[1] = db;
    }
#endif
#undef LAYER
#undef IN
#undef SEAM
#undef DO_PHASE
#undef STAMP
}

__global__ __launch_bounds__(256) void b2f_k(const unsigned short* __restrict__ src, int lds_, float* __restrict__ dst, int ldd, int cols, float scale) {
    const int row = blockIdx.x; for (int c = threadIdx.x; c < cols; c += 256) dst[(size_t)row * ldd + c] = __uint_as_float((unsigned)src[(size_t)row * lds_ + c] << 16) * scale;
}
__global__ __launch_bounds__(256) void f2b_k(const float* __restrict__ src, int lds_, unsigned short* __restrict__ dst, int ldd, int cols) {
    const int row = blockIdx.x; for (int c = threadIdx.x; c < cols; c += 256) dst[(size_t)row * ldd + c] = (unsigned short)f2bf(src[(size_t)row * lds_ + c]);
}

extern "C" void kernel_launch(void* const* d_in, const int* in_sizes, int n_in, void* d_out, int out_size, void* d_ws, size_t ws_size, hipStream_t stream) {
    static int grid = 0;
    if (grid == 0) {
        int dev = 0, cus = 0;
        if (hipGetDevice(&dev) != hipSuccess || hipDeviceGetAttribute(&cus, hipDeviceAttributeMultiprocessorCount, dev) != hipSuccess) { fprintf(stderr, "kernel_launch: device query failed\n"); grid = -1; return; }
        if (hipFuncSetAttribute((const void*)mega, hipFuncAttributeMaxDynamicSharedMemorySize, LDS_BYTES) != hipSuccess) { fprintf(stderr, "kernel_launch: hipFuncSetAttribute failed\n"); grid = -1; return; }
        int per_cu = 0; (void)hipOccupancyMaxActiveBlocksPerMultiprocessor(&per_cu, (const void*)mega, NWAVES * 64, LDS_BYTES); (void)hipGetLastError();
        if (per_cu < 1) fprintf(stderr, "kernel_launch: occupancy query says %d blocks per CU\n", per_cu);
        grid = cus;
        if (grid != 256) { fprintf(stderr, "kernel_launch: this kernel is built for a 256-CU device (got %d CUs); nothing launched\n", grid); grid = -1; return; }
    }
    if (grid < 0) return;
    unsigned char* ws = (unsigned char*)d_ws;
    if (WS_DN_END > ws_size) { fprintf(stderr, "kernel_launch: workspace too small: need %zu have %zu\n", (size_t)WS_DN_END, ws_size); return; }
    (void)hipMemsetAsync(ws + WS_CTL, 0, CTL_ZERO_BYTES, stream);
    Args a{};
    for (int i = 0; i < 20; ++i) a.in[i] = (const float*)d_in[i];
    a.out = (float*)d_out; a.ws = ws; a.lam_init[0] = (float)(0.8 - 0.6 * exp(-0.3 * 2.0)); a.lam_init[1] = (float)(0.8 - 0.6 * exp(-0.3 * 3.0));
    int nlaunch = 0;
    auto mk = [&](int lo, int hi) { a.ph_lo = lo; a.ph_hi = hi; a.bar_region = nlaunch++; hipLaunchKernelGGL(mega, dim3(grid), dim3(NWAVES * 64), LDS_BYTES, stream, a); };
#ifndef MULTI_LAUNCH
    mk(0, PH(3, 9) + 1);
#else
    mk(0, 1);
    for (int l = 0; l < 4; ++l) mk(PH(l, 0), PH(l, 9) + 1);
#endif
}
```

```cpp
#include <hip/hip_runtime.h>
#include <stdint.h>
#include <stdio.h>
#include <math.h>
#include <cstdint>
namespace pg8 {
#define PG8_LAS __attribute__((address_space(3)))
typedef unsigned short bf16_t;
typedef short bf16x8 __attribute__((ext_vector_type(8)));
typedef float f32x4 __attribute__((ext_vector_type(4)));
typedef unsigned u32x4 __attribute__((ext_vector_type(4)));
constexpr int BM = 256, BK = 64, HALF = 128, HTB = HALF * BK * 2  , STAGE_BYTES = 8 * HTB, NXCD = 8, WGM = 8;

__host__ __device__ __forceinline__ int lds_byte(int r, int c) { const int st = (r >> 4) * 2 + (c >> 5), rr = r & 15, cc = c & 31, ob = rr * 64 + cc * 2; return st * 1024 + (ob ^ (((ob >> 9) & 1) << 5)); }
__host__ __device__ __forceinline__ void stage_rc(int b, int& R, int& C) { const int st = b / 1024, sb = b % 1024, swz = sb ^ (((sb >> 9) & 1) << 5); R = (st >> 1) * 16 + swz / 64; C = (st & 1) * 32 + (swz % 64) / 2; }
__host__ __device__ __forceinline__ int perm32(int rho) { const int n = rho >> 4, i = rho & 15; return 8 * (i >> 2) + 4 * n + (i & 3); }

struct Unit { int pm, pn; };
struct Gemm { const bf16_t* A; const bf16_t* Bt; int M, N, K; };

struct StaticOrder {
    int nM, nN, nwg, G, c;
    __host__ __device__ void init(int M, int N, int G_, int c_) { nM = M / BM; nN = N / BM; nwg = nM * nN; G = G_; c = c_; }
    __host__ __device__ bool next(int i, Unit& u) const {
        const long L = (long)i * G + c; if (L >= nwg) return false;
        int wgid = (int)L; { const int q = nwg / NXCD, r = nwg % NXCD, xcd = wgid % NXCD, off = wgid / NXCD; wgid = (xcd < r ? xcd * (q + 1) : r * (q + 1) + (xcd - r) * q) + off; }
        const int nig = WGM * nN, gid = wgid / nig, fm = gid * WGM, gsz = (nM - fm) < WGM ? (nM - fm) : WGM;
        u.pm = fm + ((wgid % nig) % gsz); u.pn = (wgid % nig) / gsz; return true;
    }
    __device__ __forceinline__ void a_ready(const Unit&) const {}
    __device__ __forceinline__ void done(const Unit&) const {}
};

__device__ __forceinline__ void st16_wt(void* p, u32x4 v) { asm volatile("global_store_dwordx4 %0, %1, off sc1\n\ts_nop 1" :: "v"(p), "v"(v) : "memory"); }
__device__ __forceinline__ unsigned cvt_pk_bf16(float lo, float hi) { unsigned r; asm volatile("v_cvt_pk_bf16_f32 %0, %1, %2" : "=v"(r) : "v"(lo), "v"(hi)); return r; }
typedef float f32x2 __attribute__((ext_vector_type(2)));
__device__ __forceinline__ f32x2 gelu_pk(f32x2 v) {
    const f32x2 av = __builtin_elementwise_abs(v), d = av * 0.2316418882f + 1.0f;
    f32x2 t; t.x = __builtin_amdgcn_rcpf(d.x); t.y = __builtin_amdgcn_rcpf(d.y);
    f32x2 q = t * 0.5307027145f + (-0.7265760135f); q = q * t + 0.7107068705f; q = q * t + (-0.142248368f); q = q * t + 0.127414796f; q = q * t;
    const f32x2 s = (v * v) * (-0.72134752044f);
    f32x2 e; e.x = __builtin_amdgcn_exp2f(s.x); e.y = __builtin_amdgcn_exp2f(s.y);
    const f32x2 m = v * (q * e), r = v - m;
    f32x2 o; o.x = v.x < 0.f ? m.x : r.x; o.y = v.y < 0.f ? m.y : r.y; return o;
}

template <int ACT  > struct EpiBf16 {
    static constexpr bool PERM = true, AFTER_DRAIN = false; static_assert(ACT == 0 || ACT == 1, "EpiBf16: ACT is 0 (none) or 1 (gelu_pk)");
    bf16_t* O; int ldc; const float* bias; int split_cols; size_t split_stride; float scale0;
    __device__ __forceinline__ void operator()(const f32x4 (&acc)[2][2][4][2], const Unit& u, int wr, int wc, int fr, int fq) const {
        const int row0 = u.pm * BM + wr * 64 + fr; int colt = u.pn * BM; bf16_t* base = O;
        float sc = 1.f; if (split_cols) { const int t = colt / split_cols; base += (size_t)t * split_stride; colt -= t * split_cols; if (t == 0) sc = scale0; }
        const int col0 = colt + wc * 32 + 8 * fq, bcol0 = u.pn * BM + wc * 32 + 8 * fq;
        f32x4 bv[2][2];
#pragma unroll
        for (int bj = 0; bj < 2; ++bj)
#pragma unroll
            for (int n = 0; n < 2; ++n) bv[bj][n] = bias ? *(const f32x4*)(bias + bcol0 + bj * HALF + 4 * n) : (f32x4){0.f, 0.f, 0.f, 0.f};
#pragma unroll
        for (int ai = 0; ai < 2; ++ai)
#pragma unroll
            for (int m = 0; m < 4; ++m) { bf16_t* rowp = base + (size_t)(row0 + ai * HALF + m * 16) * ldc + col0;
#pragma unroll
                for (int bj = 0; bj < 2; ++bj) { f32x4 v0 = acc[ai][bj][m][0] + bv[bj][0], v1 = acc[ai][bj][m][1] + bv[bj][1];
                    if (ACT == 1) { f32x2 a = gelu_pk((f32x2){v0[0], v0[1]}), b = gelu_pk((f32x2){v0[2], v0[3]}), c = gelu_pk((f32x2){v1[0], v1[1]}), d = gelu_pk((f32x2){v1[2], v1[3]});
                        v0 = (f32x4){a.x, a.y, b.x, b.y}; v1 = (f32x4){c.x, c.y, d.x, d.y}; }
                    v0 = v0 * sc; v1 = v1 * sc; u32x4 w; w.x = cvt_pk_bf16(v0[0], v0[1]); w.y = cvt_pk_bf16(v0[2], v0[3]); w.z = cvt_pk_bf16(v1[0], v1[1]); w.w = cvt_pk_bf16(v1[2], v1[3]);
                    st16_wt(rowp + bj * HALF, w); } }
    }
};

struct PanelStats {
    unsigned* xbuf;
    unsigned* cnt;
    unsigned* tmo;
    int ntn; float eps;
    unsigned code;
    __device__ __forceinline__ bool run(const f32x4 (&v)[2][2][4][2], const Unit& u, int wr, int wc, int fr, int fq, PG8_LAS unsigned char* lds, int wid, int lane) const {
        typedef float f32x2v __attribute__((ext_vector_type(2)));
        PG8_LAS f32x2v* P = (PG8_LAS f32x2v*)lds;
        PG8_LAS f32x2v* S = (PG8_LAS f32x2v*)(lds + 8192);
        PG8_LAS unsigned* flag = (PG8_LAS unsigned*)(lds + 8192 + 2048);
#pragma unroll
        for (int ai = 0; ai < 2; ++ai)
#pragma unroll
            for (int m = 0; m < 4; ++m) {
                float s = 0.f;
#pragma unroll
                for (int bj = 0; bj < 2; ++bj)
#pragma unroll
                    for (int n = 0; n < 2; ++n) { const f32x4 x = v[ai][bj][m][n]; s += (x[0] + x[1]) + (x[2] + x[3]); }
                s += __shfl_xor(s, 16); s += __shfl_xor(s, 32);
                const float mw = s * (1.0f / 64.0f); float q = 0.f;
#pragma unroll
                for (int bj = 0; bj < 2; ++bj)
#pragma unroll
                    for (int n = 0; n < 2; ++n) { const f32x4 d = v[ai][bj][m][n] - mw; q += (d[0] * d[0] + d[1] * d[1]) + (d[2] * d[2] + d[3] * d[3]); }
                q += __shfl_xor(q, 16); q += __shfl_xor(q, 32);
                if (fq == 0) P[(ai * HALF + wr * 64 + m * 16 + fr) * 4 + wc] = (f32x2v){mw, q};
            }
        asm volatile("s_waitcnt lgkmcnt(0)" ::: "memory"); __builtin_amdgcn_s_barrier(); asm volatile("" ::: "memory");
#if defined(BROKEN_EXCHANGE_NO_WAIT)
#warning BROKEN CONTROL BUILD: the row-statistics exchange does not wait; results are wrong by design
        if (blockIdx.x >= 64) { const long long t0_ = clock64(); while (clock64() - t0_ < 60000) __builtin_amdgcn_s_sleep(8); }
#endif
        const int row = wid * 32 + (lane & 31);
        if (lane < 32) {
            const f32x2v a = P[row * 4 + 0], b = P[row * 4 + 1], c = P[row * 4 + 2], d = P[row * 4 + 3];
            const float mt = (a.x + b.x + c.x + d.x) * 0.25f;
            const float da = a.x - mt, db = b.x - mt, dc = c.x - mt, dd = d.x - mt;
            const float m2 = (a.y + b.y) + (c.y + d.y) + 64.0f * ((da * da + db * db) + (dc * dc + dd * dd));
            unsigned long long* slot = (unsigned long long*)xbuf + ((size_t)(u.pm * BM + row) * 4 + u.pn);
            __hip_atomic_store(slot, ((unsigned long long)__float_as_uint(m2) << 32) | __float_as_uint(mt), __ATOMIC_RELAXED, __HIP_MEMORY_SCOPE_AGENT);
        }
        asm volatile("s_waitcnt vmcnt(0)" ::: "memory");
        if (lane == 0) __hip_atomic_fetch_add(cnt + 64 * u.pm, 1u, __ATOMIC_RELAXED, __HIP_MEMORY_SCOPE_AGENT);
        if (wid == 0) {
            bool dead = false; const unsigned long long t0 = __builtin_amdgcn_s_memrealtime(); const unsigned want = 8u * (unsigned)ntn;
            for (;;) {
#if defined(BROKEN_EXCHANGE_NO_WAIT)
                break;
#endif
                if ((unsigned)__builtin_amdgcn_readfirstlane(__hip_atomic_load(cnt + 64 * u.pm, __ATOMIC_RELAXED, __HIP_MEMORY_SCOPE_AGENT)) >= want) break;
                if (__builtin_amdgcn_s_memrealtime() - t0 > 2000000ull) {
                    if (lane == 0) { unsigned expect = 0u; __hip_atomic_compare_exchange_strong(tmo + 1, &expect, code | (unsigned)(u.pm & 0xff), __ATOMIC_RELAXED, __ATOMIC_RELAXED, __HIP_MEMORY_SCOPE_AGENT);
                                     __hip_atomic_store(tmo, 1u, __ATOMIC_RELAXED, __HIP_MEMORY_SCOPE_AGENT); }
                    dead = true; break; }
                __builtin_amdgcn_s_sleep(2);
            }
            __builtin_amdgcn_fence(__ATOMIC_ACQUIRE, "agent");
            if (lane == 0) flag[0] = dead ? 1u : 0u;
        }
        asm volatile("s_waitcnt vmcnt(0) lgkmcnt(0)" ::: "memory"); __builtin_amdgcn_s_barrier(); asm volatile("" ::: "memory");
        const bool bad = flag[0] != 0u;
        if (lane < 32) {
            const unsigned long long* slot = (const unsigned long long*)xbuf + (size_t)(u.pm * BM + row) * 4; float mt[4], m2[4]; float ms = 0.f;
#pragma unroll
            for (int t = 0; t < 4; ++t) { if (t < ntn) { const unsigned long long w = __hip_atomic_load(slot + t, __ATOMIC_RELAXED, __HIP_MEMORY_SCOPE_AGENT); mt[t] = __uint_as_float((unsigned)w); m2[t] = __uint_as_float((unsigned)(w >> 32)); } else { mt[t] = 0.f; m2[t] = 0.f; } ms += mt[t]; }
            const float mean = ms / (float)ntn; float q = 0.f;
#pragma unroll
            for (int t = 0; t < 4; ++t) if (t < ntn) { const float dm = mt[t] - mean; q += m2[t] + 256.0f * dm * dm; }
            S[row] = (f32x2v){mean, 1.0f / sqrtf(q / (256.0f * (float)ntn) + eps)};
        }
        asm volatile("s_waitcnt lgkmcnt(0)" ::: "memory"); __builtin_amdgcn_s_barrier(); asm volatile("" ::: "memory");
        return bad;
    }
};
struct EpiLnRes {
    static constexpr bool PERM = false, AFTER_DRAIN = true;
    const float* base; float* out; int ldc; const float* bias; PanelStats st; unsigned poison;
    __device__ __forceinline__ void fused(f32x4 (&acc)[2][2][4][2], const Unit& u, int wr, int wc, int fr, int fq, PG8_LAS unsigned char* lds, int wid, int lane) const {
        typedef float f32x2v __attribute__((ext_vector_type(2)));
        const PG8_LAS f32x2v* S = (const PG8_LAS f32x2v*)(lds + 8192);
        const int col0 = u.pn * BM + wc * 32 + 4 * fq;
#pragma unroll
        for (int bj = 0; bj < 2; ++bj)
#pragma unroll
            for (int n = 0; n < 2; ++n) { const f32x4 bv = bias ? *(const f32x4*)(bias + col0 + bj * HALF + n * 16) : (f32x4){0.f, 0.f, 0.f, 0.f};
#pragma unroll
                for (int ai = 0; ai < 2; ++ai)
#pragma unroll
                    for (int m = 0; m < 4; ++m) acc[ai][bj][m][n] += bv; }
        f32x4 pre[4][2][2];
#pragma unroll
        for (int m = 0; m < 4; ++m) { const size_t off = (size_t)(u.pm * BM + wr * 64 + m * 16 + fr) * ldc + col0;
#pragma unroll
            for (int bj = 0; bj < 2; ++bj)
#pragma unroll
                for (int n = 0; n < 2; ++n) pre[m][bj][n] = *(const f32x4*)(base + off + bj * HALF + n * 16); }
        const bool bad = st.run(acc, u, wr, wc, fr, fq, lds, wid, lane) || poison != 0u;
        const float qnan = __builtin_nanf("");
#pragma unroll
        for (int ai = 0; ai < 2; ++ai)
#pragma unroll
            for (int m = 0; m < 4; ++m) { const int r = ai * HALF + wr * 64 + m * 16 + fr; const f32x2v sr = S[r]; const size_t off = (size_t)(u.pm * BM + r) * ldc + col0;
#pragma unroll
                for (int bj = 0; bj < 2; ++bj)
#pragma unroll
                    for (int n = 0; n < 2; ++n) { const f32x4 bs = ai == 0 ? pre[m][bj][n] : *(const f32x4*)(base + off + bj * HALF + n * 16); f32x4 o = bs + (acc[ai][bj][m][n] - sr.x) * sr.y;
                        if (bad) o = (f32x4){qnan, qnan, qnan, qnan}; *(f32x4*)(out + off + bj * HALF + n * 16) = o; }
                if (m & 1) asm volatile("" ::: "memory"); }
    }
};
struct EpiLnResLn {
    static constexpr bool PERM = false, AFTER_DRAIN = true;
    const float* base; float* out; bf16_t* xn; int ldc; const float* bias; PanelStats st1, st2; unsigned poison;
    __device__ __forceinline__ void fused(f32x4 (&acc)[2][2][4][2], const Unit& u, int wr, int wc, int fr, int fq, PG8_LAS unsigned char* lds, int wid, int lane) const {
        typedef float f32x2v __attribute__((ext_vector_type(2))); typedef unsigned u32x2v __attribute__((ext_vector_type(2)));
        const PG8_LAS f32x2v* S = (const PG8_LAS f32x2v*)(lds + 8192);
        const int col0 = u.pn * BM + wc * 32 + 4 * fq;
#pragma unroll
        for (int bj = 0; bj < 2; ++bj)
#pragma unroll
            for (int n = 0; n < 2; ++n) { const f32x4 bv = bias ? *(const f32x4*)(bias + col0 + bj * HALF + n * 16) : (f32x4){0.f, 0.f, 0.f, 0.f};
#pragma unroll
                for (int ai = 0; ai < 2; ++ai)
#pragma unroll
                    for (int m = 0; m < 4; ++m) acc[ai][bj][m][n] += bv; }
        bool bad = st1.run(acc, u, wr, wc, fr, fq, lds, wid, lane) || poison != 0u;
        const float qnan = __builtin_nanf("");
#pragma unroll
        for (int ai = 0; ai < 2; ++ai)
#pragma unroll
            for (int m = 0; m < 4; ++m) { const int r = ai * HALF + wr * 64 + m * 16 + fr; const f32x2v sr = S[r]; const size_t off = (size_t)(u.pm * BM + r) * ldc + col0;
#pragma unroll
                for (int bj = 0; bj < 2; ++bj)
#pragma unroll
                    for (int n = 0; n < 2; ++n) { const f32x4 bs = *(const f32x4*)(base + off + bj * HALF + n * 16); acc[ai][bj][m][n] = bs + (acc[ai][bj][m][n] - sr.x) * sr.y; }
                asm volatile("" : "+v"(acc[ai][0][m][0]), "+v"(acc[ai][0][m][1]), "+v"(acc[ai][1][m][0]), "+v"(acc[ai][1][m][1]));
                if (m & 1) asm volatile("" ::: "memory"); }
        const bool bad1 = bad;
        bad = st2.run(acc, u, wr, wc, fr, fq, lds, wid, lane) || bad;
#pragma unroll
        for (int ai = 0; ai < 2; ++ai)
#pragma unroll
            for (int m = 0; m < 4; ++m) { const int r = ai * HALF + wr * 64 + m * 16 + fr; const f32x2v sr = S[r]; const size_t off = (size_t)(u.pm * BM + r) * ldc + col0;
#pragma unroll
                for (int bj = 0; bj < 2; ++bj)
#pragma unroll
                    for (int n = 0; n < 2; ++n) { const f32x4 x1 = acc[ai][bj][m][n]; *(f32x4*)(out + off + bj * HALF + n * 16) = bad1 ? (f32x4){qnan, qnan, qnan, qnan} : x1;
                        const f32x4 o = (x1 - sr.x) * sr.y; u32x2v w; w.x = cvt_pk_bf16(o[0], o[1]); w.y = cvt_pk_bf16(o[2], o[3]);
                        if (bad) { w.x = 0x7fc07fc0u; w.y = 0x7fc07fc0u; } *(u32x2v*)(xn + off + bj * HALF + n * 16) = w; }
                asm volatile("" ::: "memory"); }
    }
};

template <class Epi, class Sched, bool ALIGN_EPI = false, bool SP2 = false>
__device__ __forceinline__ void gemm_phase(PG8_LAS unsigned char* lds, const Gemm g, const Sched& S, const Epi& E, const int wave_id) {
    int tid_ = wave_id * 64 + (int)__builtin_amdgcn_mbcnt_hi(~0u, __builtin_amdgcn_mbcnt_lo(~0u, 0u)); asm volatile("" : "+v"(tid_));
    const int tid = tid_, wid = __builtin_amdgcn_readfirstlane(tid >> 6), lane = tid & 63, wr = wid >> 2, wc = wid & 3, fr = lane & 15, fq = lane >> 4;
    const int K = g.K, nt = K / BK;
    unsigned voffA[2], voffB[2];
#pragma unroll
    for (int i = 0; i < 2; ++i) { int R, C; stage_rc(tid * 16 + i * 8192, R, C); const int Rb = Epi::PERM ? ((R & ~31) + perm32(R & 31)) : R;
        voffA[i] = (unsigned)(R * K + C) * 2u; voffB[i] = (unsigned)(Rb * K + C) * 2u; }
    const size_t kstep = (size_t)(BK * 2);
    const size_t hstep = (size_t)HALF * K * 2;
    const size_t tstep = 2 * hstep;
    const unsigned ldsw = (unsigned)wid * 1024u;
    const int aoff = lds_byte(wr * 64 + fr, fq * 8), boff = lds_byte(wc * 32 + fr, fq * 8);
#define PG8_SA(b, h) (((b) * 2 + (h)) * HTB)
#define PG8_SB(b, h) ((4 + (b) * 2 + (h)) * HTB)
#define PG8_STAGE(bufoff, gbase, voff) do { _Pragma("unroll") for (int _i = 0; _i < 2; ++_i) \
        __builtin_amdgcn_global_load_lds((const unsigned*)((const char*)(gbase) + (voff)[_i]), (PG8_LAS unsigned*)(lds + (bufoff) + ldsw + _i * 8192), 16, 0, 0); } while (0)
#define PG8_LDA(dst, b, h) do { _Pragma("unroll") for (int m = 0; m < 4; ++m) _Pragma("unroll") for (int k = 0; k < 2; ++k) dst[m][k] = *(const PG8_LAS bf16x8*)(lds + PG8_SA(b, h) + aoff + m * 2048 + k * 1024); } while (0)
#define PG8_LDB(dst, b, h) do { _Pragma("unroll") for (int n = 0; n < 2; ++n) _Pragma("unroll") for (int k = 0; k < 2; ++k) dst[n][k] = *(const PG8_LAS bf16x8*)(lds + PG8_SB(b, h) + boff + n * 2048 + k * 1024); } while (0)
#define PG8_MMA(ai, bj, At, Bt) do { __builtin_amdgcn_s_setprio(1); _Pragma("unroll") for (int m = 0; m < 4; ++m) _Pragma("unroll") for (int n = 0; n < 2; ++n) _Pragma("unroll") for (int k = 0; k < 2; ++k) \
        acc[ai][bj][m][n] = __builtin_amdgcn_mfma_f32_16x16x32_bf16(Bt[n][k], At[m][k], acc[ai][bj][m][n], 0, 0, 0); __builtin_amdgcn_s_setprio(0); } while (0)
#define PG8_WAIT_V(n) asm volatile("s_waitcnt vmcnt(" #n ")" ::: "memory")
#define PG8_WAIT_L(n) asm volatile("s_waitcnt lgkmcnt(" #n ")" ::: "memory")
#define PG8_BAR __builtin_amdgcn_s_barrier()
#define PG8_SCHED __builtin_amdgcn_sched_barrier(0)
    Unit cur, nxt; int ui = 0;
    if (!S.next(0, cur)) return;
    f32x4 acc[2][2][4][2];
#pragma unroll
    for (int a = 0; a < 2; ++a)
#pragma unroll
        for (int b = 0; b < 2; ++b)
#pragma unroll
            for (int m = 0; m < 4; ++m)
#pragma unroll
                for (int n = 0; n < 2; ++n) acc[a][b][m][n] = (f32x4){0.f, 0.f, 0.f, 0.f};
    bf16x8 At[4][2], B0[2][2], B1[2][2];
    const char* cA = (const char*)g.A + (size_t)cur.pm * tstep; const char* cB = (const char*)g.Bt + (size_t)cur.pn * tstep;
    S.a_ready(cur);
    if constexpr (SP2) {
        PG8_STAGE(PG8_SB(0, 0), cB, voffB); PG8_STAGE(PG8_SB(0, 1), cB + hstep, voffB); PG8_STAGE(PG8_SA(0, 0), cA, voffA); PG8_STAGE(PG8_SA(0, 1), cA + hstep, voffA);
        if (wr == 1) PG8_BAR;
        PG8_WAIT_V(2); PG8_BAR;
        PG8_STAGE(PG8_SB(1, 0), cB + kstep, voffB); PG8_STAGE(PG8_SA(1, 0), cA + kstep, voffA); PG8_STAGE(PG8_SB(1, 1), cB + hstep + kstep, voffB);
        PG8_WAIT_V(6); PG8_BAR;
    } else {
        PG8_STAGE(PG8_SB(0, 0), cB, voffB); PG8_STAGE(PG8_SA(0, 0), cA, voffA); PG8_STAGE(PG8_SB(0, 1), cB + hstep, voffB); PG8_STAGE(PG8_SA(0, 1), cA + hstep, voffA);
        if (wr == 1) PG8_BAR;
        PG8_WAIT_V(4); PG8_BAR;
        PG8_STAGE(PG8_SB(1, 0), cB + kstep, voffB); PG8_STAGE(PG8_SA(1, 0), cA + kstep, voffA); PG8_STAGE(PG8_SB(1, 1), cB + hstep + kstep, voffB);
        PG8_WAIT_V(6); PG8_BAR;
    }
    for (;;) {
        const bool has_next = S.next(ui + 1, nxt);
        const char* nA = has_next ? (const char*)g.A + (size_t)nxt.pm * tstep : cA; const char* nB = has_next ? (const char*)g.Bt + (size_t)nxt.pn * tstep : cB;
        for (int t = 0; t < nt; t += 2) {
            const bool last = (t == nt - 2);
            const char* a1 = cA + (size_t)(t + 1) * kstep;
            const char* a2 = last ? nA : cA + (size_t)(t + 2) * kstep; const char* b2 = last ? nB : cB + (size_t)(t + 2) * kstep;
            const char* a3 = a2 + kstep; const char* b3 = b2 + kstep;
            if (last && has_next) S.a_ready(nxt);
            if constexpr (SP2) {
            PG8_LDB(B0, 0, 0); PG8_LDB(B1, 0, 1); PG8_SCHED; PG8_LDA(At, 0, 0); PG8_STAGE(PG8_SA(1, 1), a1 + hstep, voffA);
            PG8_WAIT_V(8); PG8_WAIT_L(0); PG8_BAR; PG8_MMA(0, 0, At, B0); PG8_MMA(0, 1, At, B1); PG8_BAR; PG8_SCHED;
            PG8_LDA(At, 0, 1); PG8_STAGE(PG8_SB(0, 0), b2, voffB); PG8_STAGE(PG8_SB(0, 1), b2 + hstep, voffB); PG8_STAGE(PG8_SA(0, 0), a2, voffA);
            PG8_WAIT_V(8); PG8_WAIT_L(0); PG8_BAR; PG8_MMA(1, 0, At, B0); PG8_MMA(1, 1, At, B1); PG8_BAR; PG8_SCHED;
            PG8_LDB(B0, 1, 0); PG8_LDB(B1, 1, 1); PG8_SCHED; PG8_LDA(At, 1, 0); PG8_STAGE(PG8_SA(0, 1), a2 + hstep, voffA);
            PG8_WAIT_V(8); PG8_WAIT_L(0); PG8_BAR; PG8_MMA(0, 0, At, B0); PG8_MMA(0, 1, At, B1); PG8_BAR; PG8_SCHED;
            PG8_LDA(At, 1, 1); PG8_STAGE(PG8_SB(1, 0), b3, voffB); PG8_STAGE(PG8_SB(1, 1), b3 + hstep, voffB); PG8_STAGE(PG8_SA(1, 0), a3, voffA);
            PG8_WAIT_V(8); PG8_WAIT_L(0); PG8_BAR; PG8_MMA(1, 0, At, B0); PG8_MMA(1, 1, At, B1); PG8_BAR; PG8_SCHED;
            } else {
            PG8_LDB(B0, 0, 0); PG8_SCHED; PG8_LDA(At, 0, 0); PG8_STAGE(PG8_SA(1, 1), a1 + hstep, voffA);
            PG8_WAIT_L(8); PG8_BAR; PG8_WAIT_L(0); PG8_MMA(0, 0, At, B0); PG8_BAR; PG8_SCHED;
            PG8_LDB(B1, 0, 1); PG8_STAGE(PG8_SB(0, 0), b2, voffB);
            PG8_BAR; PG8_WAIT_L(0); PG8_MMA(0, 1, At, B1); PG8_BAR;
            PG8_LDA(At, 0, 1); PG8_STAGE(PG8_SA(0, 0), a2, voffA);
            PG8_BAR; PG8_WAIT_L(0); PG8_MMA(1, 0, At, B0); PG8_BAR; PG8_SCHED;
            PG8_STAGE(PG8_SB(0, 1), b2 + hstep, voffB);
            PG8_WAIT_V(6); PG8_BAR; PG8_MMA(1, 1, At, B1); PG8_BAR;
            PG8_LDB(B0, 1, 0); PG8_SCHED; PG8_LDA(At, 1, 0); PG8_STAGE(PG8_SA(0, 1), a2 + hstep, voffA);
            PG8_WAIT_L(8); PG8_BAR; PG8_WAIT_L(0); PG8_MMA(0, 0, At, B0); PG8_BAR; PG8_SCHED;
            PG8_LDB(B1, 1, 1); PG8_STAGE(PG8_SB(1, 0), b3, voffB);
            PG8_BAR; PG8_WAIT_L(0); PG8_MMA(0, 1, At, B1); PG8_BAR;
            PG8_LDA(At, 1, 1); PG8_STAGE(PG8_SA(1, 0), a3, voffA);
            PG8_BAR; PG8_WAIT_L(0); PG8_MMA(1, 0, At, B0); PG8_BAR; PG8_SCHED;
            PG8_STAGE(PG8_SB(1, 1), b3 + hstep, voffB);
            PG8_WAIT_V(6); PG8_BAR; PG8_MMA(1, 1, At, B1); PG8_BAR;
            }
        }
        if constexpr (ALIGN_EPI) { if (wr == 0) PG8_BAR; }
        if constexpr (!Epi::AFTER_DRAIN) { E(acc, cur, wr, wc, fr, fq); S.done(cur); }
        if (!has_next) break;
#pragma unroll
        for (int a = 0; a < 2; ++a)
#pragma unroll
            for (int b = 0; b < 2; ++b)
#pragma unroll
                for (int m = 0; m < 4; ++m)
#pragma unroll
                    for (int n = 0; n < 2; ++n) acc[a][b][m][n] = (f32x4){0.f, 0.f, 0.f, 0.f};
        cur = nxt; cA = nA; cB = nB; ++ui;
        if constexpr (ALIGN_EPI) { if (wr == 1) PG8_BAR; }
    }
    PG8_WAIT_V(0);
    if constexpr (!ALIGN_EPI) { if (wr == 0) PG8_BAR; }
    PG8_BAR;
    if constexpr (Epi::AFTER_DRAIN) { E.fused(acc, cur, wr, wc, fr, fq, lds, wid, lane); S.done(cur); }
#undef PG8_SA
#undef PG8_SB
#undef PG8_STAGE
#undef PG8_LDA
#undef PG8_LDB
#undef PG8_MMA
#undef PG8_WAIT_V
#undef PG8_WAIT_L
#undef PG8_BAR
#undef PG8_SCHED
}
}
namespace pg8 {
struct EpiF32 {
    static constexpr bool PERM = false, AFTER_DRAIN = false;
    float* C; int ldc;
    __device__ __forceinline__ void operator()(const f32x4 (&acc)[2][2][4][2], const Unit& u, int wr, int wc, int fr, int fq) const {
        const int row0 = u.pm * BM + wr * 64 + fr, col0 = u.pn * BM + wc * 32 + 4 * fq;
#pragma unroll
        for (int ai = 0; ai < 2; ++ai)
#pragma unroll
            for (int m = 0; m < 4; ++m) { float* rowp = C + (size_t)(row0 + ai * HALF + m * 16) * ldc + col0;
#pragma unroll
                for (int bj = 0; bj < 2; ++bj)
#pragma unroll
                    for (int n = 0; n < 2; ++n) *(f32x4*)(rowp + bj * HALF + n * 16) = acc[ai][bj][m][n]; }
    }
};
struct EpiBf16G {
    static constexpr bool PERM = true, AFTER_DRAIN = false;
    bf16_t* O; int ldc; int pnmask;
    __device__ __forceinline__ void operator()(const f32x4 (&acc)[2][2][4][2], const Unit& u, int wr, int wc, int fr, int fq) const {
        const int row0 = u.pm * BM + wr * 64 + fr, col0 = (u.pn & pnmask) * BM + wc * 32 + 8 * fq;
#pragma unroll
        for (int ai = 0; ai < 2; ++ai)
#pragma unroll
            for (int m = 0; m < 4; ++m) { bf16_t* rowp = O + (size_t)(row0 + ai * HALF + m * 16) * ldc + col0;
#pragma unroll
                for (int bj = 0; bj < 2; ++bj) { const f32x4 v0 = acc[ai][bj][m][0], v1 = acc[ai][bj][m][1];
                    u32x4 w; w.x = cvt_pk_bf16(v0[0], v0[1]); w.y = cvt_pk_bf16(v0[2], v0[3]); w.z = cvt_pk_bf16(v1[0], v1[1]); w.w = cvt_pk_bf16(v1[2], v1[3]);
                    st16_wt(rowp + bj * HALF, w); } }
    }
};
__device__ __forceinline__ float silu_fast(float x) { return x * __builtin_amdgcn_rcpf(1.f + __builtin_amdgcn_exp2f(-1.4426950408889634f * x)); }
struct EpiSwiGLU {
    static constexpr bool PERM = true, AFTER_DRAIN = false;
    bf16_t* O; int ldc;
    __device__ __forceinline__ void operator()(const f32x4 (&acc)[2][2][4][2], const Unit& u, int wr, int wc, int fr, int fq) const {
        const int row0 = u.pm * BM + wr * 64 + fr, col0 = (u.pn & 3) * HALF + wc * 32 + 8 * fq;
#pragma unroll
        for (int ai = 0; ai < 2; ++ai)
#pragma unroll
            for (int m = 0; m < 4; ++m) { bf16_t* rowp = O + (size_t)(row0 + ai * HALF + m * 16) * ldc + col0;
                const f32x4 a0 = acc[ai][0][m][0], a1 = acc[ai][0][m][1], g0 = acc[ai][1][m][0], g1 = acc[ai][1][m][1];
                u32x4 w; w.x = cvt_pk_bf16(silu_fast(a0[0]) * g0[0], silu_fast(a0[1]) * g0[1]); w.y = cvt_pk_bf16(silu_fast(a0[2]) * g0[2], silu_fast(a0[3]) * g0[3]);
                w.z = cvt_pk_bf16(silu_fast(a1[0]) * g1[0], silu_fast(a1[1]) * g1[1]); w.w = cvt_pk_bf16(silu_fast(a1[2]) * g1[2], silu_fast(a1[3]) * g1[3]);
                st16_wt(rowp, w); }
    }
};
struct MoeOrder {
    int nunits, G, v; const PG8_LAS int* tile_e;
    __device__ __forceinline__ bool next(int i, Unit& u) const { const int L = i * G + v; if (L >= nunits) return false; const int t = L >> 2; u.pm = t; u.pn = __builtin_amdgcn_readfirstlane(tile_e[t]) * 4 + (L & 3); return true; }
    __device__ __forceinline__ void a_ready(const Unit&) const {}
    __device__ __forceinline__ void done(const Unit&) const {}
};
}
#include <hip/hip_bf16.h>
#include <cmath>
namespace attn_body {
using bf16=__hip_bfloat16;
using bf16x8=__attribute__((ext_vector_type(8)))short;
using s16x4=__attribute__((ext_vector_type(4)))short;
using f32x16=__attribute__((ext_vector_type(16)))float;
using u32x4=__attribute__((ext_vector_type(4)))unsigned;
constexpr int BATCH=2,NHEAD=16,SEQ=8192,D=64,DM=NHEAD*D;
constexpr int NW=8,QBLK=32,QB=QBLK*NW,KVBLK=64,NQB=SEQ/QB;
constexpr int ATTN_PITCH=DM, ATTN_UNIT_ROWS=QB;
__device__ __forceinline__ int crow(int r,int hi){return (r&3)+8*(r>>2)+4*hi;}
#define SBAR() __builtin_amdgcn_sched_barrier(0)
__device__ __forceinline__ void cmask(f32x16&p0,f32x16&p1,int jb,int qrel,int hi){
  const float NEG=-INFINITY; int kb=64*jb+4*hi;
  #pragma unroll
  for(int r=0;r<16;++r){int kv=kb+(r&3)+8*(r>>2); if(kv>qrel)p0[r]=NEG; if(kv+32>qrel)p1[r]=NEG;}
}

constexpr int NSLOT=3, SLOTB=8192, VSLOTB=16384;
constexpr int LDS_K=0, LDS_V=NSLOT*SLOTB, LDS_WS=LDS_V+NSLOT*VSLOTB, LDS_OST=LDS_WS+NW*64*4, LDS_BYTES=LDS_OST+NW*4096;
constexpr float C2=0.125f*1.4426950408889634f;
__device__ __forceinline__ void glds16(const void*gsrc,unsigned lds_dst){unsigned keep;
  asm volatile("s_mov_b32 %0, m0\n\ts_mov_b32 m0, %2\n\ts_nop 0\n\tglobal_load_lds_dwordx4 %1, off\n\ts_mov_b32 m0, %0":"=&s"(keep):"v"(gsrc),"s"(lds_dst):"memory");}
__device__ __forceinline__ float max3f(float a,float b,float c){float r;asm("v_max3_f32 %0, %1, %2, %3":"=v"(r):"v"(a),"v"(b),"v"(c));return r;}
__device__ __forceinline__ float max2f(float a,float b){float r;asm("v_max_f32_e32 %0, %1, %2":"=v"(r):"v"(a),"v"(b));return r;}
__device__ __forceinline__ float fadd_s(float a,float b){float r;asm("v_add_f32_e32 %0, %1, %2":"=v"(r):"v"(a),"v"(b));return r;}
__device__ __forceinline__ float fsub_s(float a,float b){float r;asm("v_sub_f32_e32 %0, %1, %2":"=v"(r):"v"(a),"v"(b));return r;}
typedef float f32x2_t __attribute__((ext_vector_type(2))); typedef __bf16 bf16x2_t __attribute__((ext_vector_type(2)));
__device__ __forceinline__ unsigned cvtpk_s(float lo,float hi){f32x2_t v={lo,hi};bf16x2_t b=__builtin_convertvector(v,bf16x2_t);return __builtin_bit_cast(unsigned,b);}
#define WAIT_BAR(N) asm volatile("s_waitcnt vmcnt(" #N ") lgkmcnt(0)\n\ts_barrier":::"memory")

__device__ __forceinline__ void qkt(f32x16&p0,f32x16&p1,const char*Kslot,const bf16x8*qr,const f32x16&negm,int r32,int hi){
  const char*kb=Kslot+hi*1024+r32*16;
  #pragma unroll
  for(int d0=0;d0<4;++d0){
    const bf16x8 b0=*reinterpret_cast<const bf16x8*>(kb+d0*2048);
    const bf16x8 b1=*reinterpret_cast<const bf16x8*>(kb+d0*2048+512);
    if(d0==0){p0=__builtin_amdgcn_mfma_f32_32x32x16_bf16(b0,qr[0],negm,0,0,0);p1=__builtin_amdgcn_mfma_f32_32x32x16_bf16(b1,qr[0],negm,0,0,0);}
    else{p0=__builtin_amdgcn_mfma_f32_32x32x16_bf16(b0,qr[d0],p0,0,0,0);p1=__builtin_amdgcn_mfma_f32_32x32x16_bf16(b1,qr[d0],p1,0,0,0);}}
}
typedef __attribute__((address_space(3))) const char* lds_cptr;
typedef short v4i16_t __attribute__((ext_vector_type(4)));
__device__ __forceinline__ void kload8(bf16x8*kf,lds_cptr kp){
  kf[0]=*(const __attribute__((address_space(3))) bf16x8*)(kp);      kf[1]=*(const __attribute__((address_space(3))) bf16x8*)(kp+512);
  kf[2]=*(const __attribute__((address_space(3))) bf16x8*)(kp+2048); kf[3]=*(const __attribute__((address_space(3))) bf16x8*)(kp+2560);
  kf[4]=*(const __attribute__((address_space(3))) bf16x8*)(kp+4096); kf[5]=*(const __attribute__((address_space(3))) bf16x8*)(kp+4608);
  kf[6]=*(const __attribute__((address_space(3))) bf16x8*)(kp+6144); kf[7]=*(const __attribute__((address_space(3))) bf16x8*)(kp+6656);
}
__device__ __forceinline__ void kload2(bf16x8*kf,lds_cptr kp,int j){ kf[2*j]=*(const __attribute__((address_space(3))) bf16x8*)(kp+j*2048); kf[2*j+1]=*(const __attribute__((address_space(3))) bf16x8*)(kp+j*2048+512); }
__device__ __forceinline__ s16x4 vtr(lds_cptr p){ return __builtin_bit_cast(s16x4,__builtin_amdgcn_ds_read_tr16_b64_v4i16((__attribute__((address_space(3))) v4i16_t*)p)); }
__device__ __forceinline__ float rowmax(const f32x16&p0,const f32x16&p1){
  float a=max3f(p0[0],p0[1],p1[0]),b=max3f(p0[2],p0[3],p1[1]);a=max3f(a,p1[2],p1[3]);
  #pragma unroll
  for(int r=4;r<16;r+=4){a=max3f(a,p0[r],p0[r+1]);b=max3f(b,p0[r+2],p0[r+3]);a=max3f(a,p1[r],p1[r+1]);b=max3f(b,p1[r+2],p1[r+3]);}
  const float m=max2f(a,b);
  auto rr=__builtin_amdgcn_permlane32_swap(__float_as_uint(m),__float_as_uint(m),false,false);
  return max2f(__uint_as_float(rr[0]),__uint_as_float(rr[1]));
}
__device__ __forceinline__ void pv(f32x16*o,int vb,bf16x8 pa0,bf16x8 pa1,bf16x8 pa2,bf16x8 pa3){
  #pragma unroll
  for(int d0=0;d0<4;++d0){s16x4 lo[4],hi[4];
    #pragma unroll
    for(int ks=0;ks<4;++ks){
      asm volatile("ds_read_b64_tr_b16 %0,%1 offset:%c2":"=&v"(lo[ks]):"v"(vb),"i"(d0*4096+ks*1024):"memory");
      asm volatile("ds_read_b64_tr_b16 %0,%1 offset:%c2":"=&v"(hi[ks]):"v"(vb),"i"(d0*4096+ks*1024+512):"memory");}
    asm volatile("s_waitcnt lgkmcnt(0)":::"memory");SBAR();
    #define PK(k) (bf16x8){lo[k][0],lo[k][1],lo[k][2],lo[k][3],hi[k][0],hi[k][1],hi[k][2],hi[k][3]}
    o[d0]=__builtin_amdgcn_mfma_f32_32x32x16_bf16(pa0,PK(0),o[d0],0,0,0);
    o[d0]=__builtin_amdgcn_mfma_f32_32x32x16_bf16(pa1,PK(1),o[d0],0,0,0);
    o[d0]=__builtin_amdgcn_mfma_f32_32x32x16_bf16(pa2,PK(2),o[d0],0,0,0);
    o[d0]=__builtin_amdgcn_mfma_f32_32x32x16_bf16(pa3,PK(3),o[d0],0,0,0);
    #undef PK
  }
}

#ifndef ATTN_STORE16
#define ATTN_STORE16(p,v) (*(u32x4*)(p)=(v))
#endif
template<int THRL> __device__ __forceinline__ void attn_unit(int b,int h,int hv,int qb,const bf16*Q,const bf16*__restrict__ K,const bf16*__restrict__ V,bf16*O,char*shm,const int wave_id){
  int tid_=wave_id*64+(int)__builtin_amdgcn_mbcnt_hi(~0u,__builtin_amdgcn_mbcnt_lo(~0u,0u)); asm volatile("":"+v"(tid_)); const int tid=tid_,lane=tid&63,r32=lane&31,hi=lane>>5; const int wid=__builtin_amdgcn_readfirstlane(tid>>6);
  const long rowbase=(long)b*SEQ; const int q0=qb*QB;
  const bf16*Qw=Q+(rowbase+q0+wid*QBLK)*DM+h*D;
  const bf16*Kh=K+rowbase*DM+h*D,*Vh=V+rowbase*DM+hv*128;
  const unsigned lds0=(unsigned)(uintptr_t)shm;
  float*wsf=(float*)(shm+LDS_WS)+wid*64;
  const bf16*ksrc=Kh+(long)lane*DM+wid*8;
  const bf16*vsrc=Vh+(long)(16*(wid&3)+(lane>>2))*DM+(wid>>2)*32+(lane&3)*8;
  const unsigned kdst=lds0+LDS_K+wid*1024, vdst=lds0+LDS_V+wid*1024;
  #define DMA_K(t,slot) glds16(ksrc+(long)(t)*KVBLK*DM,(unsigned)__builtin_amdgcn_readfirstlane(kdst+(slot)))
  #define DMA_V(t,slot) do{ glds16(vsrc+(long)(t)*KVBLK*DM,(unsigned)__builtin_amdgcn_readfirstlane(vdst+2*(slot))); glds16(vsrc+64+(long)(t)*KVBLK*DM,(unsigned)__builtin_amdgcn_readfirstlane(vdst+2*(slot)+8192)); }while(0)
  const int vb0=(int)(lds0+LDS_V)+((lane>>4)&1)*32+(lane&3)*8+(4*hi+((lane&15)>>2))*64;
  const char*Kbase=shm+LDS_K; bf16x8 kf[8];
  const lds_cptr shm3=(lds_cptr)shm; const lds_cptr kp0=shm3+LDS_K+hi*1024+r32*16; const lds_cptr vp0=shm3+LDS_V+((lane>>4)&1)*32+(lane&3)*8+(4*hi+((lane&15)>>2))*64;
  const int NT=(q0+QB)/KVBLK;
  DMA_K(0,0);DMA_V(0,0);DMA_K(1,SLOTB);
  bf16x8 qr[4];
  #pragma unroll
  for(int d0=0;d0<4;++d0)qr[d0]=*reinterpret_cast<const bf16x8*>(&Qw[(long)r32*DM+d0*16+hi*8]);
  float mhat=0.f,l_reg=0.f;f32x16 o[4];o[0]=f32x16{};o[1]=f32x16{};o[2]=f32x16{};o[3]=f32x16{};const f32x16 zz=f32x16{};
  #define CMASK(P0,P1,t) do{int jb_=(t)-(NT-4); if(jb_>=0){ FRESH_HI(hi_,r32_) cmask(P0,P1,jb_,wid*QBLK+r32_,hi_);} }while(0)
  bool resc=false;
  #define START(P0,P1) do{ const float rm=rowmax(P0,P1); resc=false; \
    { const float dl=rm; mhat=fadd_s(mhat,dl); \
      _Pragma("unroll") for(int r=0;r<16;++r){P0[r]=fsub_s(P0[r],dl);P1[r]=fsub_s(P1[r],dl);} \
      } \
    _Pragma("unroll") for(int r=0;r<16;++r)P0[r]=__builtin_amdgcn_exp2f(P0[r]); }while(0)
  #define FRESH_HI(hi_,r32_) int ln__=(int)__builtin_amdgcn_mbcnt_hi(~0u,__builtin_amdgcn_mbcnt_lo(~0u,0u)); asm volatile("":"+v"(ln__)); const int hi_=ln__>>5,r32_=ln__&31; (void)hi_; (void)r32_;
  #define RESC() do{ if(resc){ FRESH_HI(hi_,r32_) asm volatile("s_waitcnt lgkmcnt(0)":::"memory"); \
      _Pragma("unroll") for(int d_=0;d_<4;++d_) _Pragma("unroll") for(int r=0;r<16;++r)o[d_][r]*=wsf[crow(r,hi_)]; } }while(0)
  f32x16 pA0,pA1,pB0,pB1;
  int sl_prev=0,sl_cur=0,sl_next=SLOTB;
  #define ROT() do{sl_prev=sl_cur;sl_cur=sl_next;sl_next=(sl_next==(NSLOT-1)*SLOTB)?0:sl_next+SLOTB;}while(0)
  DMA_K(2,2*SLOTB);
  WAIT_BAR(3);
  qkt(pA0,pA1,Kbase,qr,zz,r32,hi);asm volatile("s_nop 15\n\ts_nop 7":"+v"(pA0),"+v"(pA1));CMASK(pA0,pA1,0);
  START(pA0,pA1);
  _Pragma("unroll") for(int r=0;r<16;++r)pA1[r]=__builtin_amdgcn_exp2f(pA1[r]);
  WAIT_BAR(0);
  DMA_K(3,0);DMA_V(1,SLOTB);
  ROT();
  kload8(kf,kp0+sl_cur);
  WAIT_BAR(3);
  s16x4 vlo[8],vhi[8]; u32x4 pw0,pw1,pw2,pw3;
  #define PKW(P,B) cvtpk_s(P[B],P[B+1])
  #define PAF(k) __builtin_bit_cast(bf16x8,pw##k)
  #define VFR(i) (bf16x8){vlo[i][0],vlo[i][1],vlo[i][2],vlo[i][3],vhi[i][0],vhi[i][1],vhi[i][2],vhi[i][3]}
  #define PIN(x) asm volatile("":"+v"(x))
  #define MX3(a,b,c) __builtin_fmaxf(__builtin_fmaxf((a),(b)),(c))
  #define GAPA(MF,A0,A1,A2,A3,W0,W1,PW) do{ MF; sacc+=A0; sacc+=A1; sacc+=A2; sacc+=A3; PIN(sacc); W0; W1; PIN(PW); SBAR(); }while(0)
  #define EX(v) __builtin_amdgcn_exp2f(v)
  #define GAPB(MF,RL,X,B) do{ MF; RL; X[B]=EX(X[B]); X[B+1]=EX(X[B+1]); PIN(X); SBAR(); }while(0)
  #define VRD(i) do{ vlo[(i)&7]=vtr(vp_+(((i)>>2)*4096+((i)&3)*1024)); vhi[(i)&7]=vtr(vp_+(((i)>>2)*4096+((i)&3)*1024+512)); }while(0)
  #define KRD(G,j) do{ if(G){ kload2(kf,kp0+sl_next,j); SBAR(); } }while(0)
  #define STEP(C0,C1,P0,P1,t,GK,GV,GL) do{ SBAR(); \
    const lds_cptr vp_=vp0+2*sl_prev; \
    VRD(0); SBAR(); float sacc=(P0[0]+P0[1]); \
    GAPA(C0=__builtin_amdgcn_mfma_f32_32x32x16_bf16(kf[0],qr[0],zz,0,0,0), P0[2],P0[3],P0[4],P0[5],     pw0[0]=PKW(P0,0), pw0[1]=PKW(P0,2), pw0); \
    VRD(4); SBAR(); GAPA(C1=__builtin_amdgcn_mfma_f32_32x32x16_bf16(kf[1],qr[0],zz,0,0,0), P0[6],P0[7],P0[8],P0[9],     pw0[2]=PKW(P0,4), pw0[3]=PKW(P0,6), pw0); \
    VRD(1); SBAR(); GAPA(C0=__builtin_amdgcn_mfma_f32_32x32x16_bf16(kf[2],qr[1],C0,0,0,0),   P0[10],P0[11],P0[12],P0[13], pw1[0]=PKW(P0,8), pw1[1]=PKW(P0,10), pw1); \
    VRD(5); SBAR(); GAPA(C1=__builtin_amdgcn_mfma_f32_32x32x16_bf16(kf[3],qr[1],C1,0,0,0),   P0[14],P0[15],P1[0],P1[1],   pw1[2]=PKW(P0,12),pw1[3]=PKW(P0,14), pw1); \
    VRD(2); SBAR(); GAPA(C0=__builtin_amdgcn_mfma_f32_32x32x16_bf16(kf[4],qr[2],C0,0,0,0),   P1[2],P1[3],P1[4],P1[5],     pw2[0]=PKW(P1,0), pw2[1]=PKW(P1,2), pw2); \
    VRD(6); SBAR(); GAPA(C1=__builtin_amdgcn_mfma_f32_32x32x16_bf16(kf[5],qr[2],C1,0,0,0),   P1[6],P1[7],P1[8],P1[9],     pw2[2]=PKW(P1,4), pw2[3]=PKW(P1,6), pw2); \
    VRD(3); SBAR(); GAPA(C0=__builtin_amdgcn_mfma_f32_32x32x16_bf16(kf[6],qr[3],C0,0,0,0),   P1[10],P1[11],P1[12],P1[13], pw3[0]=PKW(P1,8), pw3[1]=PKW(P1,10), pw3); \
    VRD(7); SBAR(); GAPA(C1=__builtin_amdgcn_mfma_f32_32x32x16_bf16(kf[7],qr[3],C1,0,0,0),   P1[14],P1[15],0.f,0.f,       pw3[2]=PKW(P1,12),pw3[3]=PKW(P1,14), pw3); \
    l_reg+=sacc; \
    _Pragma("unroll") for(int r=0;r<16;++r){C0[r]-=mhat;C1[r]-=mhat;} \
    if(GK){DMA_K((t)+3,sl_cur);} if(GV){DMA_V((t)+1,sl_next);} \
    CMASK(C0,C1,t); \
    { float a=MX3(C0[0],C0[1],C1[0]),b=MX3(C0[2],C0[3],C1[1]); a=MX3(a,C1[2],C1[3]); \
      _Pragma("unroll") for(int r=4;r<16;r+=4){a=MX3(a,C0[r],C0[r+1]);b=MX3(b,C0[r+2],C0[r+3]);a=MX3(a,C1[r],C1[r+1]);b=MX3(b,C1[r+2],C1[r+3]);} \
      float rm=__builtin_fmaxf(a,b); { auto rr=__builtin_amdgcn_permlane32_swap(__float_as_uint(rm),__float_as_uint(rm),false,false); rm=__builtin_fmaxf(__uint_as_float(rr[0]),__uint_as_float(rr[1])); } \
      resc=false; \
      if(__builtin_expect(__any(rm>(float)THRL),0)){ const float dl=__builtin_fmaxf(rm,0.f); mhat+=dl; \
        _Pragma("unroll") for(int r=0;r<16;++r){C0[r]-=dl;C1[r]-=dl;} \
        const float f=__builtin_amdgcn_exp2f(-dl); l_reg*=f; { FRESH_HI(hi_,r32_) if(hi_==0)wsf[r32_]=f; } resc=true; } } \
    SBAR(); \
    GAPB(o[0]=__builtin_amdgcn_mfma_f32_32x32x16_bf16(PAF(0),VFR(0),o[0],0,0,0), VRD(8),  C0,0); \
    GAPB(o[1]=__builtin_amdgcn_mfma_f32_32x32x16_bf16(PAF(0),VFR(4),o[1],0,0,0), VRD(12), C0,2); \
    KRD(GL,0); GAPB(o[0]=__builtin_amdgcn_mfma_f32_32x32x16_bf16(PAF(1),VFR(1),o[0],0,0,0), VRD(9),  C0,4); \
    KRD(GL,1); GAPB(o[1]=__builtin_amdgcn_mfma_f32_32x32x16_bf16(PAF(1),VFR(5),o[1],0,0,0), VRD(13), C0,6); \
    KRD(GL,2); GAPB(o[0]=__builtin_amdgcn_mfma_f32_32x32x16_bf16(PAF(2),VFR(2),o[0],0,0,0), VRD(10), C0,8); \
    KRD(GL,3); GAPB(o[1]=__builtin_amdgcn_mfma_f32_32x32x16_bf16(PAF(2),VFR(6),o[1],0,0,0), VRD(14), C0,10); \
    GAPB(o[0]=__builtin_amdgcn_mfma_f32_32x32x16_bf16(PAF(3),VFR(3),o[0],0,0,0), VRD(11), C0,12); \
    GAPB(o[1]=__builtin_amdgcn_mfma_f32_32x32x16_bf16(PAF(3),VFR(7),o[1],0,0,0), VRD(15), C0,14); \
    GAPB(o[2]=__builtin_amdgcn_mfma_f32_32x32x16_bf16(PAF(0),VFR(0),o[2],0,0,0), (void)0, C1,0); \
    GAPB(o[3]=__builtin_amdgcn_mfma_f32_32x32x16_bf16(PAF(0),VFR(4),o[3],0,0,0), (void)0, C1,2); \
    GAPB(o[2]=__builtin_amdgcn_mfma_f32_32x32x16_bf16(PAF(1),VFR(1),o[2],0,0,0), (void)0, C1,4); \
    GAPB(o[3]=__builtin_amdgcn_mfma_f32_32x32x16_bf16(PAF(1),VFR(5),o[3],0,0,0), (void)0, C1,6); \
    GAPB(o[2]=__builtin_amdgcn_mfma_f32_32x32x16_bf16(PAF(2),VFR(2),o[2],0,0,0), (void)0, C1,8); \
    GAPB(o[3]=__builtin_amdgcn_mfma_f32_32x32x16_bf16(PAF(2),VFR(6),o[3],0,0,0), (void)0, C1,10); \
    GAPB(o[2]=__builtin_amdgcn_mfma_f32_32x32x16_bf16(PAF(3),VFR(3),o[2],0,0,0), (void)0, C1,12); \
    GAPB(o[3]=__builtin_amdgcn_mfma_f32_32x32x16_bf16(PAF(3),VFR(7),o[3],0,0,0), (void)0, C1,14); \
    }while(0)
  int t=1;
  #undef CMASK
  #define CMASK(P0,P1,t) do{}while(0)
  for(;t+5<NT;t+=2){
    STEP(pB0,pB1,pA0,pA1,t,true,true,true);     WAIT_BAR(3); RESC(); ROT();
    STEP(pA0,pA1,pB0,pB1,t+1,true,true,true);   WAIT_BAR(3); RESC(); ROT();
  }
  #undef CMASK
  #define CMASK(P0,P1,t) do{int jb_=(t)-(NT-4); if(jb_>=0){ FRESH_HI(hi_,r32_) cmask(P0,P1,jb_,wid*QBLK+r32_,hi_);} }while(0)
  #define ENDW(tt) do{ if((tt)+3<NT){WAIT_BAR(3);} else if((tt)+2<NT){WAIT_BAR(2);} else {WAIT_BAR(0);} }while(0)
  for(;t+1<NT;t+=2){
    STEP(pB0,pB1,pA0,pA1,t,(t+3<NT),(t+1<NT),(t+1<NT));       ENDW(t);   RESC(); ROT();
    STEP(pA0,pA1,pB0,pB1,t+1,(t+4<NT),(t+2<NT),(t+2<NT));     ENDW(t+1); RESC(); ROT();
  }
  STEP(pB0,pB1,pA0,pA1,NT-1,false,false,false); RESC();
  { float sacc=pB0[0]+pB0[1]; _Pragma("unroll") for(int r=2;r<16;++r)sacc+=pB0[r]; _Pragma("unroll") for(int r=0;r<16;++r)sacc+=pB1[r]; l_reg+=sacc;
    pw0=(u32x4){PKW(pB0,0),PKW(pB0,2),PKW(pB0,4),PKW(pB0,6)};pw1=(u32x4){PKW(pB0,8),PKW(pB0,10),PKW(pB0,12),PKW(pB0,14)};pw2=(u32x4){PKW(pB1,0),PKW(pB1,2),PKW(pB1,4),PKW(pB1,6)};pw3=(u32x4){PKW(pB1,8),PKW(pB1,10),PKW(pB1,12),PKW(pB1,14)};
    SBAR(); pv(o,vb0+2*sl_cur,PAF(0),PAF(1),PAF(2),PAF(3)); }
  #undef PKW
  #undef PAF
  #undef VFR
  #undef PIN
  #undef MX3
  #undef GAPA
  #undef GAPB
  #undef EX
  #undef VRD
  #undef KRD
  #undef STEP
  #undef ENDW
  {auto rr=__builtin_amdgcn_permlane32_swap(__float_as_uint(l_reg),__float_as_uint(l_reg),false,false);l_reg=__uint_as_float(rr[0])+__uint_as_float(rr[1]);}
  FRESH_HI(hie,r32e)
  if(hie==0)wsf[32+r32e]=l_reg;asm volatile("s_waitcnt lgkmcnt(0)":::"memory");
  float rli[16];
  #pragma unroll
  for(int r=0;r<16;++r)rli[r]=__builtin_amdgcn_rcpf(wsf[32+crow(r,hie)]);
  bf16*Ow=O+(rowbase+q0+wid*QBLK)*DM+hv*128;
  { bf16*stg=(bf16*)(shm+LDS_OST)+wid*2048;
    #pragma unroll
    for(int hf=0;hf<2;++hf){
      #pragma unroll
      for(int r=0;r<16;++r){const int orow=crow(r,hie);
        #pragma unroll
        for(int d0=0;d0<2;++d0)stg[orow*64+d0*32+r32e]=__float2bfloat16(o[2*hf+d0][r]*rli[r]);}
      asm volatile("s_waitcnt lgkmcnt(0)":::"memory");
      #pragma unroll
      for(int i=0;i<4;++i){const int row=i*8+(ln__>>3),ch=ln__&7; const u32x4 v=*(const u32x4*)(stg+row*64+ch*8); ATTN_STORE16(Ow+(long)row*DM+hf*64+ch*8,v);}
      asm volatile("s_waitcnt lgkmcnt(0)":::"memory"); } }
  asm volatile("s_waitcnt lgkmcnt(0)\n\ts_barrier":::"memory");
  #undef DMA_K
  #undef DMA_V
  #undef CMASK
  #undef START
  #undef RESC
  #undef FRESH_HI
  #undef ROT
}
constexpr int ATTN_LDS_BYTES=LDS_BYTES;
struct AttnTensors { const bf16* Q; const bf16* K; const bf16* V; bf16* O1; bf16* O2; };
struct AttnUnit { int bh; int qb; };
struct StaticOrder {
  int vcu;
  __device__ __forceinline__ explicit StaticOrder(int grid,int block):vcu((block%8)*(grid/8)+block/8){}
  __device__ __forceinline__ bool next(int i,AttnUnit&u)const{ if(i>=4)return false; const int s=vcu&7; u.bh=vcu>>3; u.qb=(i==0)?s:(i==1)?15-s:(i==2)?16+s:31-s; return true; }
  __device__ __forceinline__ void a_ready(const AttnUnit&)const{}
  __device__ __forceinline__ void done(const AttnUnit&)const{}
};
template<class Sched,int THRL=8> __device__ __forceinline__ void attn_phase(char*lds,const AttnTensors&T,const Sched&S,const int wave_id){
  AttnUnit u;
  for(int i=0;S.next(i,u);++i){ S.a_ready(u); const int b=u.bh>>4,hq=u.bh&15; attn_unit<THRL>(b,hq,hq>>1,u.qb,T.Q,T.K,T.V,(hq&1)?T.O2:T.O1,lds,wave_id); S.done(u); }
}
#undef SBAR
#undef WAIT_BAR
}
#define GAS __attribute__((address_space(1)))
#define LAS __attribute__((address_space(3)))
typedef unsigned short bf16;
typedef unsigned v4u __attribute__((ext_vector_type(4)));
typedef float f32x4 __attribute__((ext_vector_type(4)));
typedef short bf16x8 __attribute__((ext_vector_type(8)));
typedef GAS unsigned gu32;
typedef GAS unsigned long long gu64;
#define RLX_AGENT __ATOMIC_RELAXED, __HIP_MEMORY_SCOPE_AGENT
#define LDS_WAIT() asm volatile("s_waitcnt lgkmcnt(0)" ::: "memory")
#define VM_WAIT() asm volatile("s_waitcnt vmcnt(0)" ::: "memory")
__device__ __forceinline__ unsigned long long rt() { return __builtin_amdgcn_s_memrealtime(); }
typedef float f32x2_hw __attribute__((ext_vector_type(2))); typedef __bf16 bf16x2_hw __attribute__((ext_vector_type(2)));
__device__ __forceinline__ unsigned pk2(float lo, float hi) { const f32x2_hw v = {lo, hi}; const bf16x2_hw b = __builtin_convertvector(v, bf16x2_hw); return __builtin_bit_cast(unsigned, b); }
__device__ __forceinline__ unsigned f2bf(float f) { return pk2(f, 0.f) & 0xffffu; }
__device__ __forceinline__ void st16g(void* p, v4u v) { asm volatile("global_store_dwordx4 %0, %1, off sc1\n\ts_nop 1" :: "v"(p), "v"(v) : "memory"); }
__device__ __forceinline__ void st8g(void* p, unsigned long long v) { asm volatile("global_store_dwordx2 %0, %1, off sc1\n\ts_nop 1" :: "v"(p), "v"(v) : "memory"); }

#define XB_TMO      128
#define XB_XCNT(j)  (256  + 64 * (j))
#define XB_XSUB(j)  (1280 + 64 * (j))
#define XB_XGEN(j)  (2304 + 64 * (j))
#define XB_TOP      3328
#define XB_TOPGEN   3392
#define XCD_BAR_WORDS 3456
#define XB_SPIN_CAP (1u << 18)

__device__ __forceinline__ unsigned xb_ld(unsigned* p)              { return __hip_atomic_load(p, __ATOMIC_RELAXED, __HIP_MEMORY_SCOPE_AGENT); }
__device__ __forceinline__ unsigned xb_add(unsigned* p, unsigned v) { return __hip_atomic_fetch_add(p, v, __ATOMIC_RELAXED, __HIP_MEMORY_SCOPE_AGENT); }
__device__ __forceinline__ unsigned xb_xcc_id() { return (unsigned)__builtin_amdgcn_s_getreg((3 << 11) | 20) & 0xFu; }
#define XB_SPIN(cond, bar) do { unsigned _sp = 0; while (cond) { __builtin_amdgcn_s_sleep(1); \
    if ((++_sp & 255u) == 0u) { if (xb_ld(&(bar)[XB_TMO])) break; if (_sp > XB_SPIN_CAP) { atomicAdd(&(bar)[XB_TMO], 1u); break; } } } } while (0)

struct XcdBarrier {
    unsigned* bar; unsigned x;
    volatile LAS unsigned* st;
};

__device__ __forceinline__ XcdBarrier xcd_barrier_post(unsigned* bar, volatile LAS unsigned* st, const int wave_id) {
    XcdBarrier b; b.bar = bar; b.x = xb_xcc_id(); b.st = st;
    if (wave_id == 0 && __builtin_amdgcn_mbcnt_hi(~0u, __builtin_amdgcn_mbcnt_lo(~0u, 0u)) == 0u) (void)xb_add(&bar[XB_XCNT(b.x)], 1u);
    return b;
}
__device__ __forceinline__ void xcd_barrier_complete(unsigned* bar, unsigned x, unsigned& nloc, unsigned& nx) {
    const unsigned G = gridDim.x * gridDim.y * gridDim.z;
    unsigned sum, cnt, mine, sp = 0u;
    for (;;) {
        sum = 0u; cnt = 0u; mine = 0u;
#pragma unroll
        for (unsigned j = 0; j < 16; ++j) { const unsigned c = xb_ld(&bar[XB_XCNT(j)]); sum += c; cnt += (c > 0u) ? 1u : 0u; mine = (j == x) ? c : mine; }
        if (sum == G) break;
        __builtin_amdgcn_s_sleep(1);
        if ((++sp & 255u) == 0u) { if (xb_ld(&bar[XB_TMO])) break; if (sp > XB_SPIN_CAP) { atomicAdd(&bar[XB_TMO], 1u); break; } }
    }
    nloc = mine > 0u ? mine : 1u; nx = cnt > 0u ? cnt : 1u;
}

__device__ __forceinline__ void xcd_barrier(const XcdBarrier& b, const int wave_id) {
    asm volatile("s_waitcnt vmcnt(0)" ::: "memory");
    __syncthreads();
    if (wave_id == 0 && __builtin_amdgcn_mbcnt_hi(~0u, __builtin_amdgcn_mbcnt_lo(~0u, 0u)) == 0u) {
        unsigned* bar = b.bar;
        __builtin_amdgcn_s_waitcnt(0);
        unsigned nloc = b.st[0], nx = b.st[1];
        if (nloc == 0u) { xcd_barrier_complete(bar, b.x, nloc, nx); b.st[0] = nloc; b.st[1] = nx; }
        const unsigned old = xb_add(&bar[XB_XSUB(b.x)], 1u);
        const unsigned gen = old / nloc;
        if (old + 1u == (gen + 1u) * nloc) {
            __builtin_amdgcn_fence(__ATOMIC_RELEASE, "agent");
            asm volatile("s_waitcnt vmcnt(0)" ::: "memory");
            const unsigned og = xb_add(&bar[XB_TOP], 1u);
            const unsigned tg = og / nx;
            if (og + 1u == (tg + 1u) * nx) xb_add(&bar[XB_TOPGEN], 1u);
            else XB_SPIN(xb_ld(&bar[XB_TOPGEN]) == tg, bar);
            __builtin_amdgcn_fence(__ATOMIC_ACQUIRE, "agent");
            xb_add(&bar[XB_XGEN(b.x)], 1u);
            asm volatile("s_waitcnt vmcnt(0)" ::: "memory");
        } else {
            XB_SPIN(xb_ld(&bar[XB_XGEN(b.x)]) == gen, bar);
            __builtin_amdgcn_fence(__ATOMIC_ACQUIRE, "agent");
            asm volatile("s_waitcnt vmcnt(0)" ::: "memory");
        }
    }
    __syncthreads();
}
constexpr int NWAVES = 8;
constexpr int T = 8192, D = 1024, M = 16384;
constexpr int NINP = 4096;
constexpr int NEXP = 32, NROWS2 = 40960, NTILE2 = NROWS2 / 256;
constexpr float LN_EPS = 1e-5f, RMS_EPS = 1e-6f, ALPHA = 1.6817928305074292f;
constexpr float QSCALE = 0.125f * 1.4426950408889634f;

constexpr size_t al256(size_t x) { return (x + 255) & ~(size_t)255; }
constexpr size_t WS_CTL = 0, CTL_ZERO_BYTES = 1u << 20;
constexpr size_t WS_WIN = WS_CTL + CTL_ZERO_BYTES;
constexpr size_t WS_WAOUT = WS_WIN + (size_t)2 * NINP * D * 2;
constexpr size_t WS_WQKV = WS_WAOUT + (size_t)2 * D * D * 2;
constexpr size_t WS_WQ3 = WS_WQKV + (size_t)3 * D * D * 2;
constexpr size_t WS_WBOUT = WS_WQ3 + (size_t)D * D * 2;
constexpr size_t WS_WR = WS_WBOUT + (size_t)2 * D * D * 2;
constexpr size_t WS_WG = WS_WR + (size_t)4 * 48 * D * 2;
constexpr size_t WS_W13 = WS_WG + (size_t)2 * 16 * D * 2;
constexpr size_t WS_W2 = WS_W13 + (size_t)4 * 32 * 1024 * 1024 * 2;
constexpr size_t WS_H = WS_W2 + (size_t)4 * 32 * 1024 * 512 * 2;
constexpr size_t WS_HB = WS_H + (size_t)M * D * 4;
constexpr size_t WS_H1 = WS_HB + (size_t)M * D * 2;
constexpr size_t WS_H1B = WS_H1 + (size_t)M * D * 4;
constexpr size_t WS_PROJ = WS_H1B + (size_t)M * D * 2;
constexpr size_t WS_KB = WS_PROJ + (size_t)M * NINP * 2;
constexpr size_t WS_VB = WS_KB + (size_t)M * D * 2;
constexpr size_t WS_ON = WS_VB + (size_t)M * D * 2;
constexpr size_t WS_MIX = WS_ON + (size_t)M * D * 2;
constexpr size_t WS_EID = WS_MIX + (size_t)M * D * 4;
constexpr size_t WS_GATE = WS_EID + (size_t)2 * M * 4;
constexpr size_t WS_APOS = WS_GATE + (size_t)2 * M * 4;
constexpr size_t WS_XROWS = WS_APOS + (size_t)2 * M * 4;
constexpr size_t WS_HID = WS_XROWS + (size_t)NROWS2 * 1024 * 2;
constexpr size_t WS_YROWS = WS_HID + (size_t)NROWS2 * 512 * 2;
constexpr size_t WS_FAST_END = WS_YROWS + (size_t)NROWS2 * 1024 * 2;
constexpr int CW_BAR = 4096;
constexpr int CW_CNT = 16384, CSTR = 64;
constexpr int LDS_BYTES = 147456, RING_BYTES = 131072, LDSCTL_OFF = RING_BYTES, MISC_OFF = LDSCTL_OFF + 320, TILEE_OFF = MISC_OFF + 128;
constexpr int PREP_SC_OFF = TILEE_OFF + 4 * NTILE2 + 64;
constexpr int STAMP_OFF = PREP_SC_OFF + 8 * 768;
constexpr int SCAN_O_OFF = (STAMP_OFF + 48 * 8 + 15) & ~15;
static_assert(SCAN_O_OFF + 4 * 2048 <= LDS_BYTES, "LDS map");

#define PHASE_IDS int tid_o_ = F.wave * 64 + (int)__builtin_amdgcn_mbcnt_hi(~0u, __builtin_amdgcn_mbcnt_lo(~0u, 0u)); asm volatile("" : "+v"(tid_o_)); const int tid = tid_o_, lane = tid & 63; (void)tid; (void)lane;
struct Frame {
    LAS unsigned char* lds; volatile LAS unsigned* MISC; gu32* ctl;
    int wave, vcu, G;
    unsigned char* ws;
};
struct Args { const float* in[20]; float* out; unsigned char* ws; int ph_lo, ph_hi, bar_region, pad; float lam_init[2]; };

__device__ __forceinline__ float wave_sum(float v) {
#pragma unroll
    for (int o = 1; o < 64; o <<= 1) v += __shfl_xor(v, o);
    return v;
}
__device__ __forceinline__ void p0_item_load(f32x4 (&x)[8], const float* W, int ldw, int nvalid, int k0, int n0, int lane) {
    const int c4 = lane & 7, kr = lane >> 3; const bool ok = (n0 + 4 * c4) < nvalid;
#pragma unroll
    for (int i = 0; i < 8; ++i) x[i] = ok ? *(const GAS f32x4*)(W + (size_t)(k0 + kr + 8 * i) * ldw + n0 + 4 * c4) : (f32x4){0.f, 0.f, 0.f, 0.f};
}
__device__ __forceinline__ void p0_item_store(const f32x4 (&x)[8], bf16* WT, int ldt, int drow0, int k0, LAS float* scr, int lane) {
    const int c4 = lane & 7, kr = lane >> 3;
#pragma unroll
    for (int i = 0; i < 8; ++i) *(LAS f32x4*)(scr + (kr + 8 * i) * 36 + ((4 * c4 + 4 * i) & 31)) = x[i];
    LDS_WAIT(); asm volatile("" ::: "memory");
    const int c = lane & 7;
#pragma unroll
    for (int j = 0; j < 4; ++j) { const int n = (lane >> 3) + 8 * j; const LAS float* sp = scr + (8 * c) * 36 + ((n + 4 * c) & 31);
        v4u o; o.x = pk2(sp[0 * 36], sp[1 * 36]); o.y = pk2(sp[2 * 36], sp[3 * 36]); o.z = pk2(sp[4 * 36], sp[5 * 36]); o.w = pk2(sp[6 * 36], sp[7 * 36]);
        *(GAS v4u*)(WT + (size_t)(drow0 + n) * ldt + k0 + 8 * c) = o; }
    LDS_WAIT(); asm volatile("" ::: "memory");
}
__device__ __forceinline__ void p0_transpose_item(const float* W, int ldw, int nvalid, bf16* WT, int ldt, int drow0, int k0, int n0, LAS float* scr, int lane) {
    f32x4 x[8]; p0_item_load(x, W, ldw, nvalid, k0, n0, lane); p0_item_store(x, WT, ldt, drow0, k0, scr, lane);
}
__device__ __forceinline__ bool p0_job(int& r, const float* W, int K, int N, int ldw, int nblk, bf16* WT, int drow_base, bool w13perm, LAS float* scr, int lane) {
    const int items = (K / 64) * nblk;
    if (r >= items) { r -= items; return false; }
    const int kb = r / nblk, nb = r % nblk, n0 = nb * 32;
    int drow0 = drow_base + n0;
    if (w13perm) drow0 = drow_base + ((n0 & 511) >> 7) * 256 + (n0 >> 9) * 128 + (n0 & 127);
    p0_transpose_item(W, ldw, N, WT, K, drow0, kb * 64, n0, scr, lane);
    return true;
}
__device__ __forceinline__ void p0_prologue(Frame& F, const Args& a) {
    PHASE_IDS
    LAS float* scr = (LAS float*)(F.lds + F.wave * 16384);
    const int gw = F.vcu * NWAVES + F.wave, NGW = F.G * NWAVES;
    bf16* win = (bf16*)(F.ws + WS_WIN); bf16* waout = (bf16*)(F.ws + WS_WAOUT); bf16* wqkv = (bf16*)(F.ws + WS_WQKV); bf16* wq3 = (bf16*)(F.ws + WS_WQ3);
    bf16* wbout = (bf16*)(F.ws + WS_WBOUT); bf16* wr = (bf16*)(F.ws + WS_WR);
    constexpr int I_IN = 16 * 128, I_SQ = 16 * 32, I_KV = 16 * 64;
    constexpr int NSMALL = 2 * I_IN + 2 * I_SQ + I_KV + 2 * I_SQ + 2 * I_SQ;
    for (int it = gw; it < NSMALL; it += NGW) {
        int r = it;
        bool done = false;
        for (int l = 0; l < 2 && !done; ++l) done = p0_job(r, a.in[1] + (size_t)l * D * 4112, D, 4096, 4112, 128, win + (size_t)l * NINP * D, 0, false, scr, lane);
        for (int l = 0; l < 2 && !done; ++l) done = p0_job(r, a.in[6] + (size_t)l * D * D, D, D, D, 32, waout + (size_t)l * D * D, 0, false, scr, lane);
        if (!done) done = p0_job(r, a.in[7], D, 2048, 2048, 64, wqkv, 1024, false, scr, lane);
        if (!done) done = p0_job(r, a.in[8], D, D, D, 32, wqkv, 0, false, scr, lane);
        if (!done) done = p0_job(r, a.in[8] + (size_t)D * D, D, D, D, 32, wq3, 0, false, scr, lane);
        for (int l = 0; l < 2 && !done; ++l) done = p0_job(r, a.in[11] + (size_t)l * D * D, D, D, D, 32, wbout + (size_t)l * D * D, 0, false, scr, lane);
    }
    { const int gt = (F.vcu * NWAVES + F.wave) * 64 + lane, NT = F.G * NWAVES * 64;
      { bf16* wgt = (bf16*)(F.ws + WS_WG); for (int i = gt; i < 2 * 16 * D; i += NT) { const int l = i / (16 * D), n = (i / D) % 16, k = i % D; wgt[i] = (bf16)f2bf(a.in[1][((size_t)l * D + k) * 4112 + 4096 + n]); } }
      for (int i = gt; i < 4 * 48 * D; i += NT) { const int l = i / (48 * D), n = (i / D) % 48, k = i % D;
          const float v = n < 4 ? a.in[16][((size_t)l * D + k) * 4 + n] : (n < 36 ? a.in[17][((size_t)l * D + k) * 32 + (n - 4)] : 0.f); wr[i] = (bf16)f2bf(v); }
      bf16* hb = (bf16*)(F.ws + WS_HB); const float* x = a.in[0];
      for (int i = gt; i < M * D / 8; i += NT) { const f32x4 p = *(const GAS f32x4*)(x + (size_t)i * 8), q = *(const GAS f32x4*)(x + (size_t)i * 8 + 4);
          *(GAS v4u*)(hb + (size_t)i * 8) = (v4u){pk2(p.x, p.y), pk2(p.z, p.w), pk2(q.x, q.y), pk2(q.z, q.w)}; } }
}

struct MoeItem { const float* W; bf16* WT; int K, drow0, k0, n0; };
__device__ __forceinline__ MoeItem moe_item(const Args& a, unsigned char* ws, int l0, int r) {
    constexpr int I_W13 = 16 * 32, I_W2 = 8 * 32; MoeItem m;
    if (r < 64 * I_W13) { const int mat = l0 * 32 + r / I_W13; r = r % I_W13; const int kb = r / 32, n0 = (r % 32) * 32;
        m.W = a.in[18] + (size_t)mat * 1024 * 1024; m.WT = (bf16*)(ws + WS_W13) + (size_t)mat * 1024 * 1024; m.K = 1024; m.k0 = kb * 64; m.n0 = n0; m.drow0 = ((n0 & 511) >> 7) * 256 + (n0 >> 9) * 128 + (n0 & 127); }
    else { r -= 64 * I_W13; const int mat = l0 * 32 + r / I_W2; r = r % I_W2; const int kb = r / 32, n0 = (r % 32) * 32;
        m.W = a.in[19] + (size_t)mat * 512 * 1024; m.WT = (bf16*)(ws + WS_W2) + (size_t)mat * 1024 * 512; m.K = 512; m.k0 = kb * 64; m.n0 = n0; m.drow0 = n0; }
    return m;
}
__device__ __forceinline__ void p0_moe_weights(Frame& F, const Args& a, int l0, int wg_idx, int nwg) {
    PHASE_IDS
    LAS float* scr = (LAS float*)(F.lds + F.wave * 16384);
    constexpr int NIT = 64 * (16 * 32 + 8 * 32);
    const int gw = wg_idx * NWAVES + F.wave, NGW = nwg * NWAVES;
    f32x4 xa[8], xb[8];
    int it = gw;
    if (it >= NIT) return;
    MoeItem ma = moe_item(a, F.ws, l0, it), mb = ma;
    p0_item_load(xa, ma.W, 1024, 1024, ma.k0, ma.n0, lane);
    for (;;) {
        const bool hb_ = (it + NGW) < NIT;
        if (hb_) { mb = moe_item(a, F.ws, l0, it + NGW); p0_item_load(xb, mb.W, 1024, 1024, mb.k0, mb.n0, lane); }
        p0_item_store(xa, ma.WT, ma.K, ma.drow0, ma.k0, scr, lane);
        if (!hb_) break;
        it += NGW;
        const bool ha_ = (it + NGW) < NIT;
        if (ha_) { ma = moe_item(a, F.ws, l0, it + NGW); p0_item_load(xa, ma.W, 1024, 1024, ma.k0, ma.n0, lane); }
        p0_item_store(xb, mb.WT, mb.K, mb.drow0, mb.k0, scr, lane);
        if (!ha_) break;
        it += NGW;
    }
}

__device__ __forceinline__ f32x4 bf4_to_f32(unsigned long long a) { f32x4 y; y.x = __uint_as_float(((unsigned)a) << 16); y.y = __uint_as_float(((unsigned)a) & 0xffff0000u); y.z = __uint_as_float(((unsigned)(a >> 32)) << 16); y.w = __uint_as_float(((unsigned)(a >> 32)) & 0xffff0000u); return y; }
__device__ __forceinline__ void ln_rows8(Frame& F, const int lane, const float* hin_f32, const bf16* hin_b, const bf16* mixb, const float* g, const float* b, bf16* h1b, int row0) {
#pragma unroll 4
    for (int rr = 0; rr < 8; ++rr) {
        const int row = row0 + rr;
        const GAS unsigned long long* mr = (const GAS unsigned long long*)(mixb + (size_t)row * D) + lane;
        f32x4 v[4]; float s = 0.f;
        if (hin_f32) { const GAS f32x4* hr = (const GAS f32x4*)(hin_f32 + (size_t)row * D) + lane;
#pragma unroll
            for (int j = 0; j < 4; ++j) v[j] = hr[64 * j] * ALPHA + bf4_to_f32(mr[64 * j]); }
        else { const GAS unsigned long long* hr = (const GAS unsigned long long*)(hin_b + (size_t)row * D) + lane;
#pragma unroll
            for (int j = 0; j < 4; ++j) v[j] = bf4_to_f32(hr[64 * j]) * ALPHA + bf4_to_f32(mr[64 * j]); }
#pragma unroll
        for (int j = 0; j < 4; ++j) s += (v[j].x + v[j].y) + (v[j].z + v[j].w);
        const float mean = wave_sum(s) * (1.f / D); float s2 = 0.f;
#pragma unroll
        for (int j = 0; j < 4; ++j) { v[j] = v[j] - mean; s2 += (v[j].x * v[j].x + v[j].y * v[j].y) + (v[j].z * v[j].z + v[j].w * v[j].w); }
        const float rstd = 1.f / sqrtf(wave_sum(s2) * (1.f / D) + LN_EPS);
        GAS unsigned long long* o8 = (GAS unsigned long long*)(h1b + (size_t)row * D) + lane;
#pragma unroll
        for (int j = 0; j < 4; ++j) { const f32x4 gv = *((const GAS f32x4*)g + lane + 64 * j), bv = *((const GAS f32x4*)b + lane + 64 * j);
            const f32x4 y = v[j] * rstd * gv + bv;
            o8[64 * j] = (unsigned long long)pk2(y.x, y.y) | ((unsigned long long)pk2(y.z, y.w) << 32); }
    }
}
__device__ __forceinline__ void phase_ln1_router(Frame& F, const float* hin_f32, const bf16* hin_b, const bf16* mixb, const float* g, const float* b, bf16* h1b, const bf16* wr,
                                                 int* eid, float* gate, gu32* counts) {
    PHASE_IDS
    LAS float* lg = (LAS float*)(F.lds);
    LAS int* lcnt = (LAS int*)(F.lds + 16384);
    for (int blk = F.vcu; blk < M / 64; blk += F.G) {
        const int row0 = blk * 64;
        if (tid < 32) lcnt[tid] = 0;
        ln_rows8(F, lane, hin_f32, hin_b, mixb, g, b, h1b, row0 + F.wave * 8);
        VM_WAIT(); __syncthreads();
        if (F.wave < 4) {
            const int fr = lane & 15, fq = lane >> 4;
            const bf16* ap = h1b + (size_t)(row0 + F.wave * 16 + fr) * D + fq * 8;
            f32x4 acc[3]; acc[0] = (f32x4){0.f, 0.f, 0.f, 0.f}; acc[1] = acc[0]; acc[2] = acc[0];
#pragma unroll 8
            for (int ks = 0; ks < 32; ++ks) {
                const bf16x8 av = *(const GAS bf16x8*)(ap + ks * 32);
#pragma unroll
                for (int ct = 0; ct < 3; ++ct) { const bf16x8 bv = *(const GAS bf16x8*)(wr + (size_t)(ct * 16 + fr) * D + ks * 32 + fq * 8);
                    acc[ct] = __builtin_amdgcn_mfma_f32_16x16x32_bf16(av, bv, acc[ct], 0, 0, 0); }
            }
#pragma unroll
            for (int ct = 0; ct < 3; ++ct)
#pragma unroll
                for (int r = 0; r < 4; ++r) lg[(F.wave * 16 + 4 * fq + r) * 52 + ct * 16 + fr] = acc[ct][r];
            LDS_WAIT(); asm volatile("" ::: "memory");
            if (lane < 16) {
                const int rl = F.wave * 16 + lane; const LAS float* L = lg + rl * 52;
                int gi = 0; float gm = L[0];
                for (int q = 1; q < 4; ++q) if (L[q] > gm) { gm = L[q]; gi = q; }
                float gs = 0.f; for (int q = 0; q < 4; ++q) gs += __expf(L[q] - gm);
                const float pg = 1.f / gs; const LAS float* el = L + 4 + gi * 8;
                int i0 = 0; float v0 = el[0];
                for (int i = 1; i < 8; ++i) if (el[i] > v0) { v0 = el[i]; i0 = i; }
                int i1 = 0; float v1 = -INFINITY;
                for (int i = 0; i < 8; ++i) if (i != i0 && el[i] > v1) { v1 = el[i]; i1 = i; }
                const float e1 = __expf(v1 - v0); const int tok = row0 + rl, ea = gi * 8 + i0, eb = gi * 8 + i1;
                eid[2 * tok] = ea; eid[2 * tok + 1] = eb; gate[2 * tok] = pg / (1.f + e1); gate[2 * tok + 1] = pg * e1 / (1.f + e1);
                atomicAdd((int*)&lcnt[ea], 1); atomicAdd((int*)&lcnt[eb], 1);
            }
        }
        LDS_WAIT(); __syncthreads();
        if (tid < 32) { const int c = lcnt[tid]; if (c) __hip_atomic_fetch_add(counts + tid * CSTR, (unsigned)c, __ATOMIC_RELAXED, __HIP_MEMORY_SCOPE_AGENT); }
        __syncthreads();
    }
}
__device__ __forceinline__ int moe_layout(Frame& F, const gu32* counts, LAS int* ps, LAS int* tile_e) {
    PHASE_IDS
    if (tid < NEXP) ps[40 + tid] = (int)__hip_atomic_load(counts + tid * CSTR, __ATOMIC_RELAXED, __HIP_MEMORY_SCOPE_AGENT);
    LDS_WAIT(); __syncthreads();
    if (tid == 0) { int acc = 0; for (int e = 0; e < NEXP; ++e) { ps[e] = acc; const int c = ps[40 + e]; const int nt = (c + 255) >> 8;
            for (int t = 0; t < nt; ++t) tile_e[(acc >> 8) + t] = e; acc += nt << 8; } ps[NEXP] = acc; }
    LDS_WAIT(); __syncthreads();
    return __builtin_amdgcn_readfirstlane(ps[NEXP]) >> 8;
}
__device__ __forceinline__ void phase_scatter(Frame& F, const gu32* counts, gu32* cursor, const int* eid, const bf16* h1b, bf16* xrows, int* apos) {
    PHASE_IDS
    LAS int* ps = (LAS int*)(F.lds + 20480); LAS int* tile_e = (LAS int*)(F.lds + TILEE_OFF);
    LAS int* lcnt = (LAS int*)(F.lds + 16384); LAS int* lbase = (LAS int*)(F.lds + 16384 + 256); LAS int* lpos = (LAS int*)(F.lds + 16384 + 512);
    (void)moe_layout(F, counts, ps, tile_e);
    for (int blk = F.vcu; blk < M / 64; blk += F.G) {
        if (tid < 32) lcnt[tid] = 0;
        __syncthreads();
        int e = 0, rk = 0;
        if (tid < 128) { e = eid[blk * 128 + tid]; rk = atomicAdd((int*)&lcnt[e], 1); }
        LDS_WAIT(); __syncthreads();
        if (tid < 32) { const int c = lcnt[tid]; lbase[tid] = c ? (int)__hip_atomic_fetch_add(cursor + tid * CSTR, (unsigned)c, __ATOMIC_RELAXED, __HIP_MEMORY_SCOPE_AGENT) : 0; }
        LDS_WAIT(); __syncthreads();
        if (tid < 128) { const int pos = ps[e] + lbase[e] + rk; lpos[tid] = pos; apos[blk * 128 + tid] = pos; }
        LDS_WAIT(); __syncthreads();
#pragma unroll 8
        for (int a = F.wave; a < 128; a += NWAVES) {
            const int tok = blk * 64 + (a >> 1), pos = lpos[a];
            const GAS v4u* src = (const GAS v4u*)(h1b + (size_t)tok * D) + lane; GAS v4u* dst = (GAS v4u*)(xrows + (size_t)pos * D) + lane;
            const v4u p0 = src[0], p1 = src[64]; dst[0] = p0; dst[64] = p1;
        }
        __syncthreads();
    }
}
__device__ __forceinline__ void phase_combine_ln2(Frame& F, const bf16* h1b, const bf16* yrows, const int* apos, const float* gate, const float* g, const float* b, float* out_f32, bf16* hb) {
    PHASE_IDS
    const int gw = F.vcu * NWAVES + F.wave, NGW = F.G * NWAVES;
#pragma unroll 4
    for (int row = gw; row < M; row += NGW) {
        const int p0 = apos[2 * row], p1 = apos[2 * row + 1]; const float g0 = gate[2 * row], g1 = gate[2 * row + 1];
        const GAS unsigned long long* hr = (const GAS unsigned long long*)(h1b + (size_t)row * D) + lane;
        const GAS unsigned long long* y0 = (const GAS unsigned long long*)(yrows + (size_t)p0 * D) + lane; const GAS unsigned long long* y1 = (const GAS unsigned long long*)(yrows + (size_t)p1 * D) + lane;
        f32x4 v[4]; float s = 0.f;
#pragma unroll
        for (int j = 0; j < 4; ++j) { v[j] = bf4_to_f32(hr[64 * j]) * ALPHA + bf4_to_f32(y0[64 * j]) * g0 + bf4_to_f32(y1[64 * j]) * g1; s += (v[j].x + v[j].y) + (v[j].z + v[j].w); }
        const float mean = wave_sum(s) * (1.f / D); float s2 = 0.f;
#pragma unroll
        for (int j = 0; j < 4; ++j) { v[j] = v[j] - mean; s2 += (v[j].x * v[j].x + v[j].y * v[j].y) + (v[j].z * v[j].z + v[j].w * v[j].w); }
        const float rstd = 1.f / sqrtf(wave_sum(s2) * (1.f / D) + LN_EPS);
#pragma unroll
        for (int j = 0; j < 4; ++j) { const f32x4 gv = *((const GAS f32x4*)g + lane + 64 * j), bv = *((const GAS f32x4*)b + lane + 64 * j);
            const f32x4 y = v[j] * rstd * gv + bv;
            if (out_f32) *((GAS f32x4*)(out_f32 + (size_t)row * D) + lane + 64 * j) = y;
            else *((GAS unsigned long long*)(hb + (size_t)row * D) + lane + 64 * j) = (unsigned long long)pk2(y.x, y.y) | ((unsigned long long)pk2(y.z, y.w) << 32); }
    }
}
__device__ __forceinline__ void phase_attn_combine(Frame& F, const bf16* O1, const bf16* O2, const float* lam_p, const float* subln, float lam_init, bf16* on) {
    PHASE_IDS
    const float l01 = wave_sum(lam_p[lane] * lam_p[64 + lane]), l23 = wave_sum(lam_p[128 + lane] * lam_p[192 + lane]);
    const float lam = __expf(l01) - __expf(l23) + lam_init;
    float sw[16];
#pragma unroll
    for (int i = 0; i < 16; ++i) sw[i] = subln[(lane & 7) * 16 + i] * (1.f - lam_init);
    const int gw = F.vcu * NWAVES + F.wave, NGW = F.G * NWAVES;
    for (int row = gw; row < M; row += NGW) {
        const GAS v4u* p1 = (const GAS v4u*)(O1 + (size_t)row * D) + 2 * lane; const GAS v4u* p2 = (const GAS v4u*)(O2 + (size_t)row * D) + 2 * lane;
        const v4u a0 = p1[0], a1 = p1[1], b0 = p2[0], b1 = p2[1];
        const unsigned aw[8] = {a0.x, a0.y, a0.z, a0.w, a1.x, a1.y, a1.z, a1.w}, bw[8] = {b0.x, b0.y, b0.z, b0.w, b1.x, b1.y, b1.z, b1.w};
        float o[16]; float ss = 0.f;
#pragma unroll
        for (int i = 0; i < 8; ++i) { o[2 * i] = __uint_as_float(aw[i] << 16) - lam * __uint_as_float(bw[i] << 16); o[2 * i + 1] = __uint_as_float(aw[i] & 0xffff0000u) - lam * __uint_as_float(bw[i] & 0xffff0000u);
            ss += o[2 * i] * o[2 * i] + o[2 * i + 1] * o[2 * i + 1]; }
        ss += __shfl_xor(ss, 1); ss += __shfl_xor(ss, 2); ss += __shfl_xor(ss, 4);
        const float r = 1.f / sqrtf(ss * (1.f / 128.f) + RMS_EPS);
        v4u w0, w1;
        w0.x = pk2(o[0] * r * sw[0], o[1] * r * sw[1]); w0.y = pk2(o[2] * r * sw[2], o[3] * r * sw[3]); w0.z = pk2(o[4] * r * sw[4], o[5] * r * sw[5]); w0.w = pk2(o[6] * r * sw[6], o[7] * r * sw[7]);
        w1.x = pk2(o[8] * r * sw[8], o[9] * r * sw[9]); w1.y = pk2(o[10] * r * sw[10], o[11] * r * sw[11]); w1.z = pk2(o[12] * r * sw[12], o[13] * r * sw[13]); w1.w = pk2(o[14] * r * sw[14], o[15] * r * sw[15]);
        GAS v4u* q = (GAS v4u*)(on + (size_t)row * D) + 2 * lane; q[0] = w0; q[1] = w1;
    }
}

typedef short s16x4v __attribute__((ext_vector_type(4)));
typedef short v4i16_t __attribute__((ext_vector_type(4)));
constexpr size_t WS_WNEG = WS_FAST_END;
constexpr size_t WS_QDEC = WS_WNEG + (size_t)2048 * 64 * 128 * 2;
constexpr size_t WS_KDEC = WS_QDEC + (size_t)2048 * 64 * 128 * 2;
constexpr size_t WS_ATT = WS_KDEC + (size_t)2048 * 64 * 128 * 2;
constexpr size_t WS_U = WS_ATT + (size_t)2048 * 64 * 64 * 2;
constexpr size_t WS_GLAST = WS_U + (size_t)2048 * 64 * 128 * 4;
constexpr size_t WS_VBUF = WS_GLAST + 8192;
constexpr size_t WS_SBUF = WS_VBUF + (size_t)2048 * 8 * 2 * 64 * 8 * 2;
constexpr size_t WS_DN_END = WS_SBUF + (size_t)2048 * 8 * 4 * 64 * 8 * 2;

__device__ __forceinline__ float bf2f(unsigned short v) { return __uint_as_float((unsigned)v << 16); }
__device__ __forceinline__ float silu_f(float x) { return x * __builtin_amdgcn_rcpf(1.f + __builtin_amdgcn_exp2f(-1.4426950408889634f * x)); }
__device__ __forceinline__ s16x4v pack4(const f32x4 v) { s16x4v r; const unsigned a = pk2(v[0], v[1]), b = pk2(v[2], v[3]); r[0] = (short)(a & 0xffff); r[1] = (short)(a >> 16); r[2] = (short)(b & 0xffff); r[3] = (short)(b >> 16); return r; }
__device__ __forceinline__ bf16x8 pack8(const f32x4 lo, const f32x4 hi) { const unsigned a = pk2(lo[0], lo[1]), b = pk2(lo[2], lo[3]), c = pk2(hi[0], hi[1]), d = pk2(hi[2], hi[3]); return __builtin_bit_cast(bf16x8, (v4u){a, b, c, d}); }
#define MFMA16(a, b, c) __builtin_amdgcn_mfma_f32_16x16x16bf16_1k((a), (b), (c), 0, 0, 0)
#define MFMA32(a, b, c) __builtin_amdgcn_mfma_f32_16x16x32_bf16((a), (b), (c), 0, 0, 0)

__device__ __forceinline__ void conv8(const bf16* projb, int row, int pos, int col, const float* cw, float (&out)[8]) {
#pragma unroll
    for (int e = 0; e < 8; ++e) out[e] = 0.f;
#pragma unroll
    for (int j = 0; j < 4; ++j) {
        const bool ok = (pos - 3 + j) >= 0;
        v4u x = *(const GAS v4u*)(projb + (size_t)(ok ? row - 3 + j : row) * NINP + col);
        if (!ok) x = (v4u){0u, 0u, 0u, 0u};
        const f32x4 w0 = *(const GAS f32x4*)(cw + j * 3072 + col), w1 = *(const GAS f32x4*)(cw + j * 3072 + col + 4);
        out[0] = fmaf(w0.x, __uint_as_float(x.x << 16), out[0]); out[1] = fmaf(w0.y, __uint_as_float(x.x & 0xffff0000u), out[1]);
        out[2] = fmaf(w0.z, __uint_as_float(x.y << 16), out[2]); out[3] = fmaf(w0.w, __uint_as_float(x.y & 0xffff0000u), out[3]);
        out[4] = fmaf(w1.x, __uint_as_float(x.z << 16), out[4]); out[5] = fmaf(w1.y, __uint_as_float(x.z & 0xffff0000u), out[5]);
        out[6] = fmaf(w1.z, __uint_as_float(x.w << 16), out[6]); out[7] = fmaf(w1.w, __uint_as_float(x.w & 0xffff0000u), out[7]);
    }
#pragma unroll
    for (int e = 0; e < 8; ++e) out[e] = silu_f(out[e]);
}
__device__ __forceinline__ f32x4 conv1x4(const bf16* projb, int rowb, int posb, int col, const float* cw) {
    float x[7];
#pragma unroll
    for (int i = 0; i < 7; ++i) { const bool ok = (posb - 3 + i) >= 0; const float v = bf2f(*(const GAS unsigned short*)(projb + (size_t)(ok ? rowb - 3 + i : rowb) * NINP + col)); x[i] = ok ? v : 0.f; }
    const float w0 = cw[col], w1 = cw[3072 + col], w2 = cw[2 * 3072 + col], w3 = cw[3 * 3072 + col];
    f32x4 o;
#pragma unroll
    for (int r = 0; r < 4; ++r) o[r] = silu_f(fmaf(w3, x[r + 3], fmaf(w2, x[r + 2], fmaf(w1, x[r + 1], w0 * x[r]))));
    return o;
}

__device__ __forceinline__ void phase_dn_prep(Frame& F, const bf16* hb, const bf16* wg, const bf16* projb_, const float* convw_, const float* a_log, const float* dt_bias,
                                              bf16* wneg_, bf16* qdec_, bf16* kdec_, bf16* attn_, float* ubuf_, float* glast) {
    const int hh = F.wave;
    { const int unit = F.vcu;
        const float A_h = __expf(a_log[hh]), dtb = dt_bias[hh];
        int lane_ = (int)__builtin_amdgcn_mbcnt_hi(~0u, __builtin_amdgcn_mbcnt_lo(~0u, 0u)); asm volatile("" : "+v"(lane_));
        const int lane = lane_, fr = lane & 15, fq = lane >> 4;
        const float* convw = convw_; asm volatile("" : "+s"(convw));
        const bf16* projb = projb_; asm volatile("" : "+s"(projb));
        bf16* wneg = wneg_; bf16* qdec = qdec_; bf16* kdec = kdec_; bf16* attn = attn_; float* ubuf = ubuf_; asm volatile("" : "+s"(wneg), "+s"(qdec), "+s"(kdec), "+s"(attn), "+s"(ubuf));
        unsigned ldsb = 0; asm volatile("" : "+s"(ldsb));
        LAS float* gcs = (LAS float*)(F.lds + ldsb + PREP_SC_OFF + F.wave * 768); LAS float* bes = gcs + 64; LAS float* rnk = gcs + 128;
        LAS unsigned char* tw = F.lds + ldsb + F.wave * 16384;
        const int b = unit >> 7, n = unit & 127, t0 = n * 64, row0 = b * T + t0, cid = (b * 8 + hh) * 128 + n;
        {
            LAS float* glp = (LAS float*)(F.lds + ldsb);
            const int rt = hh & 3, kh = hh >> 2;
            const bf16* ap = hb + (size_t)(row0 + 16 * rt + fr) * D + kh * 512 + fq * 8; const bf16* bp = wg + (size_t)fr * D + kh * 512 + fq * 8;
            f32x4 acc = (f32x4){0.f, 0.f, 0.f, 0.f};
#pragma unroll 4
            for (int ks = 0; ks < 16; ++ks) acc = MFMA32(*(const GAS bf16x8*)(ap + ks * 32), *(const GAS bf16x8*)(bp + ks * 32), acc);
#pragma unroll
            for (int r = 0; r < 4; ++r) glp[(kh * 64 + 16 * rt + 4 * fq + r) * 17 + fr] = acc[r];
            LDS_WAIT(); __syncthreads();
            const float bl = glp[lane * 17 + hh] + glp[(64 + lane) * 17 + hh], al = glp[lane * 17 + 8 + hh] + glp[(64 + lane) * 17 + 8 + hh];
            LDS_WAIT(); __syncthreads();
            const float x = al + dtb; const float sp = (x > 20.f) ? x : log1pf(__expf(x));
            float c = -A_h * sp;
#pragma unroll
            for (int o = 1; o < 64; o <<= 1) { const float t = __shfl_up(c, o); if (lane >= o) c += t; }
            gcs[lane] = c; bes[lane] = 1.f / (1.f + __expf(-bl));
        }
        LDS_WAIT(); asm volatile("" ::: "memory");
        const float gl = gcs[63];
        if (lane == 0) glast[cid] = __expf(gl);
#pragma unroll 1
        for (int t = 0; t < 4; ++t) {
            int lb_ = lane; asm volatile("" : "+v"(lb_)); const int fr = lb_ & 15, fq = lb_ >> 4;
            const int tok = 16 * t + fr; float v[4][8]; float ss = 0.f;
#pragma unroll
            for (int ks = 0; ks < 4; ++ks) { conv8(projb, row0 + tok, t0 + tok, 1024 + hh * 128 + 32 * ks + 8 * fq, convw, v[ks]);
#pragma unroll
                for (int e = 0; e < 8; ++e) ss = fmaf(v[ks][e], v[ks][e], ss); }
            ss += __shfl_xor(ss, 16); ss += __shfl_xor(ss, 32);
            const float rn = 1.f / sqrtf(ss + RMS_EPS);
            if (fq == 0) rnk[tok] = rn;
            const float kd = rn * __expf(gl - gcs[tok]);
#pragma unroll
            for (int ks = 0; ks < 4; ++ks) {
                *(LAS v4u*)(tw + tok * 256 + (((4 * ks + fq) ^ fr) << 4)) = (v4u){pk2(v[ks][0] * rn, v[ks][1] * rn), pk2(v[ks][2] * rn, v[ks][3] * rn), pk2(v[ks][4] * rn, v[ks][5] * rn), pk2(v[ks][6] * rn, v[ks][7] * rn)};
                *(GAS v4u*)(kdec + ((size_t)cid * 64 + tok) * 128 + 32 * ks + 8 * fq) = (v4u){pk2(v[ks][0] * kd, v[ks][1] * kd), pk2(v[ks][2] * kd, v[ks][3] * kd), pk2(v[ks][4] * kd, v[ks][5] * kd), pk2(v[ks][6] * kd, v[ks][7] * kd)};
            }
        }
        LDS_WAIT(); asm volatile("" ::: "memory");
#define KFRAG(t_, ks_) (*(const LAS bf16x8*)(tw + (16 * (t_) + fr) * 256 + (((4 * (ks_) + fq) ^ fr) << 4)))
        bf16* attc = attn + (size_t)cid * 64 * 64;
#pragma unroll 1
        for (int ti = 0; ti < 4; ++ti) {
            int lc_ = lane; asm volatile("" : "+v"(lc_)); const int fr = lc_ & 15, fq = lc_ >> 4;
            bf16x8 qf[4];
            { const int tok = 16 * ti + fr; float v[4][8]; float ss = 0.f;
#pragma unroll
              for (int ks = 0; ks < 4; ++ks) { conv8(projb, row0 + tok, t0 + tok, hh * 128 + 32 * ks + 8 * fq, convw, v[ks]);
#pragma unroll
                  for (int e = 0; e < 8; ++e) ss = fmaf(v[ks][e], v[ks][e], ss); }
              ss += __shfl_xor(ss, 16); ss += __shfl_xor(ss, 32);
              const float rn = 1.f / sqrtf(ss + RMS_EPS);
              const float qd = rn * 0.08838834764831845f * __expf(gcs[tok]);
#pragma unroll
              for (int ks = 0; ks < 4; ++ks) {
                  qf[ks] = __builtin_bit_cast(bf16x8, (v4u){pk2(v[ks][0] * rn, v[ks][1] * rn), pk2(v[ks][2] * rn, v[ks][3] * rn), pk2(v[ks][4] * rn, v[ks][5] * rn), pk2(v[ks][6] * rn, v[ks][7] * rn)});
                  { bf16* qrow = qdec + ((size_t)cid * 64 + tok) * 128 + 32 * ks;
                    *(GAS unsigned long long*)(qrow + 8 * ((2 * fq) & 3) + 4 * (fq >> 1)) = (unsigned long long)pk2(v[ks][0] * qd, v[ks][1] * qd) | ((unsigned long long)pk2(v[ks][2] * qd, v[ks][3] * qd) << 32);
                    *(GAS unsigned long long*)(qrow + 8 * ((2 * fq + 1) & 3) + 4 * (fq >> 1)) = (unsigned long long)pk2(v[ks][4] * qd, v[ks][5] * qd) | ((unsigned long long)pk2(v[ks][6] * qd, v[ks][7] * qd) << 32); }
              } }
#pragma unroll 1
            for (int tj = 0; tj <= ti; ++tj) {
                f32x4 acc = (f32x4){0.f, 0.f, 0.f, 0.f};
#pragma unroll
                for (int ks = 0; ks < 4; ++ks) acc = MFMA32(KFRAG(tj, ks), qf[ks], acc);
                const int i = 16 * ti + fr; const float gi = gcs[i]; const f32x4 gj = *(const LAS f32x4*)(gcs + 16 * tj + 4 * fq);
                float a[4];
#pragma unroll
                for (int r = 0; r < 4; ++r) { const int j = 16 * tj + 4 * fq + r; a[r] = (i >= j) ? acc[r] * 0.08838834764831845f * __expf(gi - gj[r]) : 0.f; }
                *(GAS unsigned long long*)(attc + i * 64 + 32 * (tj >> 1) + 8 * fq + 4 * (tj & 1)) = (unsigned long long)pk2(a[0], a[1]) | ((unsigned long long)pk2(a[2], a[3]) << 32);
            }
            if ((ti & 1) == 0)
                *(GAS unsigned long long*)(attc + (16 * ti + fr) * 64 + 32 * ((ti + 1) >> 1) + 8 * fq + 4 * ((ti + 1) & 1)) = 0ull;
        }
        s16x4v nAoff[4][4];
        s16x4v P1n[4], P2[4], P4[4], P8[4];
#pragma unroll
        for (int ti = 0; ti < 4; ++ti)
#pragma unroll
            for (int tj = 0; tj <= ti; ++tj) {
                int le_ = lane; asm volatile("" : "+v"(le_)); const int fr = le_ & 15, fq = le_ >> 4;
                f32x4 acc = (f32x4){0.f, 0.f, 0.f, 0.f};
#pragma unroll
                for (int ks = 0; ks < 4; ++ks) acc = MFMA32(KFRAG(tj, ks), KFRAG(ti, ks), acc);
                const int i = 16 * ti + fr; const float bi = bes[i], gi = gcs[i];
                f32x4 aop;
#pragma unroll
                for (int r = 0; r < 4; ++r) { const int j = 16 * tj + 4 * fq + r; aop[r] = (i > j) ? bi * acc[r] * __expf(gi - gcs[j]) : 0.f; }
                if (tj < ti) { nAoff[ti][tj] = pack4(-aop); }
                else {
                    f32x4 bop;
#pragma unroll
                    for (int r = 0; r < 4; ++r) { const int rw = 16 * ti + 4 * fq + r; bop[r] = (rw > i) ? bes[rw] * acc[r] * __expf(gcs[rw] - gi) : 0.f; }
                    const s16x4v a1 = pack4(aop), b1 = pack4(bop);
                    const f32x4 z = (f32x4){0.f, 0.f, 0.f, 0.f};
                    const s16x4v a2 = pack4(MFMA16(b1, a1, z)), b2 = pack4(MFMA16(a1, b1, z));
                    const s16x4v a4 = pack4(MFMA16(b2, a2, z)), b4 = pack4(MFMA16(a2, b2, z));
                    const s16x4v a8 = pack4(MFMA16(b4, a4, z));
                    P1n[ti] = pack4(-aop); P2[ti] = a2; P4[ti] = a4; P8[ti] = a8;
                }
            }
#undef KFRAG
#define TILE_EL(tok_, ch_) bf2f(*(const LAS unsigned short*)(tw + (tok_) * 256 + (((((ch_) >> 3)) ^ ((tok_) & 15)) << 4) + ((ch_) & 7) * 2))
#define TILE_ST(tok_, ch_, val_) (*(LAS unsigned short*)(tw + (tok_) * 256 + (((((ch_) >> 3)) ^ ((tok_) & 15)) << 4) + ((ch_) & 7) * 2) = (unsigned short)f2bf(val_))
#define SOLVE_PASS(PASS) do { \
        _Pragma("unroll 1") for (int c8 = 0; c8 < 8; ++c8) { \
            int lo2_ = lane; asm volatile("" : "+v"(lo2_)); const int fr = lo2_ & 15, fq = lo2_ >> 4; \
            const int ch = 16 * c8 + fr; \
            s16x4v Xb[4]; \
            _Pragma("unroll") for (int bi = 0; bi < 4; ++bi) { \
                const int tokb = 16 * bi + 4 * fq; \
                f32x4 Y; \
                _Pragma("unroll") for (int r = 0; r < 4; ++r) { const int tok = tokb + r; float f = bes[tok]; if ((PASS) == 0) f *= __expf(gcs[tok]); Y[r] = TILE_EL(tok, ch) * f; } \
                _Pragma("unroll") for (int bj = 0; bj < 4; ++bj) if (bj < bi) Y = MFMA16(nAoff[bi][bj], Xb[bj], Y); \
                Y = MFMA16(P8[bi], pack4(Y), Y); Y = MFMA16(P4[bi], pack4(Y), Y); Y = MFMA16(P2[bi], pack4(Y), Y); Y = MFMA16(P1n[bi], pack4(Y), Y); \
                Xb[bi] = pack4(Y); \
                if ((PASS) == 1) { *(GAS f32x4*)(ubuf + (size_t)cid * 64 * 128 + (size_t)((c8 * 4 + bi) * 64 + lo2_) * 4) = Y; } \
                else { _Pragma("unroll") for (int r = 0; r < 4; ++r) TILE_ST(tokb + r, ch, -Y[r]); } \
            } } } while (0)
        SOLVE_PASS(0);
        LDS_WAIT(); asm volatile("" ::: "memory");
        {
            int lo4_ = lane; asm volatile("" : "+v"(lo4_));
#pragma unroll
            for (int i = 0; i < 16; ++i) { const int p = lo4_ + 64 * i, tok = p >> 4, c16 = p & 15; *(GAS v4u*)(wneg + ((size_t)cid * 64 + tok) * 128 + c16 * 8) = *(const LAS v4u*)(tw + tok * 256 + ((c16 ^ (tok & 15)) << 4)); }
        }
        LDS_WAIT(); asm volatile("" ::: "memory");
        {
            int lo3_ = lane; asm volatile("" : "+v"(lo3_)); const int fr = lo3_ & 15, fq = lo3_ >> 4;
#pragma unroll 1
            for (int t = 0; t < 4; ++t) {
                const int tok = 16 * t + fr;
#pragma unroll
                for (int ks = 0; ks < 4; ++ks) { float v[8]; conv8(projb, row0 + tok, t0 + tok, 2048 + hh * 128 + 32 * ks + 8 * fq, convw, v);
                    *(LAS v4u*)(tw + tok * 256 + (((4 * ks + fq) ^ fr) << 4)) = (v4u){pk2(v[0], v[1]), pk2(v[2], v[3]), pk2(v[4], v[5]), pk2(v[6], v[7])}; }
            }
        }
        LDS_WAIT(); asm volatile("" ::: "memory");
        SOLVE_PASS(1);
#undef SOLVE_PASS
#undef TILE_EL
#undef TILE_ST
        LDS_WAIT(); asm volatile("" ::: "memory");
    }
}

constexpr int SC_W = 0, SC_K = 16384, SC_U = 34816, SC_G = 51200, SC_SET = 51456;
__device__ __forceinline__ bf16x8 lds_tr8(const LAS unsigned char* p, int rowstride16) {
    const s16x4v lo = __builtin_bit_cast(s16x4v, __builtin_amdgcn_ds_read_tr16_b64_v4i16((LAS v4i16_t*)p));
    const s16x4v hi = __builtin_bit_cast(s16x4v, __builtin_amdgcn_ds_read_tr16_b64_v4i16((LAS v4i16_t*)(p + rowstride16)));
    return (bf16x8){lo[0], lo[1], lo[2], lo[3], hi[0], hi[1], hi[2], hi[3]};
}
__device__ __forceinline__ void phase_dn_scan(Frame& F, const bf16* wneg, const bf16* kdec, const float* ubuf, const float* glast, bf16* sbuf, bf16* vbuf, const int dbg = 0) {
    PHASE_IDS
    const int fr = lane & 15, fq = lane >> 4;
    const int bh = F.vcu >> 2, quarter = F.vcu & 3, cid0 = bh * 128;
    LAS unsigned char* L = F.lds;
    if (F.wave >= 4) {
        const int lt = (F.wave - 4) * 64 + lane;
        v4u r0[10], r1[10], r2[10], r3[10]; float g0 = 0.f, g1 = 0.f, g2 = 0.f, g3 = 0.f;
#define SC_LOAD(R, G, c) do { const size_t cb = (size_t)(cid0 + (c)) * 64 * 128; \
        _Pragma("unroll") for (int i = 0; i < 4; ++i) { const int p = lt + 256 * i; R[i] = *(const GAS v4u*)(wneg + cb + (size_t)p * 8); R[4 + i] = *(const GAS v4u*)(kdec + cb + (size_t)p * 8); \
            if (i < 2) R[8 + i] = *(const GAS v4u*)(ubuf + cb + (size_t)quarter * 2048 + (size_t)p * 4); } G = glast[cid0 + (c)]; } while (0)
#define SC_WRITE(R, G, set) do { LAS unsigned char* S_ = L + (set) * SC_SET; \
        _Pragma("unroll") for (int i = 0; i < 4; ++i) { const int p = lt + 256 * i, row = p >> 4, c16 = p & 15, sb = c16 >> 2, c = c16 & 3; \
            const int o0 = row * 256 + ((((4 * sb + ((2 * c) & 3)) ^ (row & 15)) << 4) | ((c >> 1) << 3)), o1 = row * 256 + ((((4 * sb + ((2 * c + 1) & 3)) ^ (row & 15)) << 4) | ((c >> 1) << 3)); \
            *(LAS unsigned long long*)(S_ + SC_W + o0) = (unsigned long long)R[i].x | ((unsigned long long)R[i].y << 32); *(LAS unsigned long long*)(S_ + SC_W + o1) = (unsigned long long)R[i].z | ((unsigned long long)R[i].w << 32); \
            *(LAS v4u*)(S_ + SC_K + row * 288 + c16 * 16) = R[4 + i]; if (i < 2) *(LAS v4u*)(S_ + SC_U + p * 16) = R[8 + i]; } if (lt == 0) *(LAS float*)(S_ + SC_G) = G; } while (0)
#define SC_LSTEP(R, G, set, n) do { if (!(dbg & 2)) { if ((n) + 1 < 128) SC_WRITE(R, G, set); if ((n) + 5 < 128) SC_LOAD(R, G, (n) + 5); } LDS_WAIT(); __builtin_amdgcn_s_barrier(); } while (0)
        SC_LOAD(r0, g0, 0); SC_LOAD(r1, g1, 1); SC_LOAD(r2, g2, 2); SC_LOAD(r3, g3, 3);
        SC_WRITE(r0, g0, 0); SC_LOAD(r0, g0, 4);
        LDS_WAIT(); __builtin_amdgcn_s_barrier();
#pragma unroll 1
        for (int n = 0; n < 128; n += 4) {
            SC_LSTEP(r1, g1, 1, n); SC_LSTEP(r2, g2, 0, n + 1); SC_LSTEP(r3, g3, 1, n + 2); SC_LSTEP(r0, g0, 0, n + 3);
        }
#undef SC_LOAD
#undef SC_WRITE
#undef SC_LSTEP
    } else if (F.wave >= 2) {
        for (int n = 0; n < 129; ++n) { LDS_WAIT(); __builtin_amdgcn_s_barrier(); }
    } else {
        const int c0 = quarter * 32 + F.wave * 16, dvt = c0 >> 4;
        f32x4 S[8]; bf16x8 SB[4];
#pragma unroll
        for (int i = 0; i < 8; ++i) S[i] = (f32x4){0.f, 0.f, 0.f, 0.f};
#pragma unroll
        for (int i = 0; i < 4; ++i) SB[i] = (bf16x8){0, 0, 0, 0, 0, 0, 0, 0};
        __builtin_amdgcn_s_barrier();
#define SC_SB() __builtin_amdgcn_sched_barrier(0)
#define SC_STEP() do { if (dbg & 4) { LDS_WAIT(); __builtin_amdgcn_s_barrier(); break; } const LAS unsigned char* Sx = L + (n & 1) * SC_SET; \
            f32x4 vn[4]; const float glc = *(const LAS float*)(Sx + SC_G); \
            _Pragma("unroll") for (int mt = 0; mt < 4; ++mt) vn[mt] = *(const LAS f32x4*)(Sx + SC_U + ((F.wave * 4 + mt) * 64 + lane) * 16); \
            bf16x8 fa[8], fb[8]; \
            _Pragma("unroll") for (int m_ = 0; m_ < 2; ++m_) _Pragma("unroll") for (int s_ = 0; s_ < 4; ++s_) { fa[m_ * 4 + s_] = *(const LAS bf16x8*)(Sx + SC_W + (16 * m_ + fr) * 256 + (((4 * s_ + fq) ^ fr) << 4)); fb[m_ * 4 + s_] = *(const LAS bf16x8*)(Sx + SC_W + (16 * (2 + m_) + fr) * 256 + (((4 * s_ + fq) ^ fr) << 4)); } \
            if (!(dbg & 1)) { GAS v4u* sp_ = (GAS v4u*)(sbuf + ((size_t)(cid0 + n) * 8 + dvt) * 4 * 64 * 8) + lane; _Pragma("unroll") for (int s_ = 0; s_ < 4; ++s_) sp_[s_ * 64] = __builtin_bit_cast(v4u, SB[s_]); } else { asm volatile("" :: "v"(SB[0]), "v"(SB[1]), "v"(SB[2]), "v"(SB[3])); } \
            SC_SB(); \
            _Pragma("unroll") for (int m_ = 0; m_ < 2; ++m_) _Pragma("unroll") for (int s_ = 0; s_ < 4; ++s_) vn[m_] = MFMA32(fa[m_ * 4 + s_], SB[s_], vn[m_]); \
            _Pragma("unroll") for (int d_ = 0; d_ < 4; ++d_) _Pragma("unroll") for (int p_ = 0; p_ < 2; ++p_) fa[d_ * 2 + p_] = lds_tr8(Sx + SC_K + (32 * p_ + 4 * fq + (fr >> 2)) * 288 + (16 * d_ + 4 * (fr & 3)) * 2, 16 * 288); \
            SC_SB(); \
            _Pragma("unroll") for (int m_ = 0; m_ < 2; ++m_) _Pragma("unroll") for (int s_ = 0; s_ < 4; ++s_) vn[2 + m_] = MFMA32(fb[m_ * 4 + s_], SB[s_], vn[2 + m_]); \
            _Pragma("unroll") for (int d_ = 0; d_ < 4; ++d_) _Pragma("unroll") for (int p_ = 0; p_ < 2; ++p_) fb[d_ * 2 + p_] = lds_tr8(Sx + SC_K + (32 * p_ + 4 * fq + (fr >> 2)) * 288 + (16 * (4 + d_) + 4 * (fr & 3)) * 2, 16 * 288); \
            SC_SB(); \
            bf16x8 VB[2]; VB[0] = pack8(vn[0], vn[1]); VB[1] = pack8(vn[2], vn[3]); \
            if (!(dbg & 1)) { GAS v4u* vp_ = (GAS v4u*)(vbuf + ((size_t)(cid0 + n) * 8 + dvt) * 2 * 64 * 8) + lane; vp_[0] = __builtin_bit_cast(v4u, VB[0]); vp_[64] = __builtin_bit_cast(v4u, VB[1]); } else { asm volatile("" :: "v"(VB[0]), "v"(VB[1])); } \
            _Pragma("unroll") for (int dt = 0; dt < 8; ++dt) S[dt] = S[dt] * glc; \
            _Pragma("unroll") for (int dt = 0; dt < 4; ++dt) { S[dt] = MFMA32(fa[dt * 2], VB[0], S[dt]); S[dt] = MFMA32(fa[dt * 2 + 1], VB[1], S[dt]); } \
            _Pragma("unroll") for (int dt = 0; dt < 4; ++dt) { S[4 + dt] = MFMA32(fb[dt * 2], VB[0], S[4 + dt]); S[4 + dt] = MFMA32(fb[dt * 2 + 1], VB[1], S[4 + dt]); } \
            _Pragma("unroll") for (int s_ = 0; s_ < 4; ++s_) SB[s_] = pack8(S[2 * s_], S[2 * s_ + 1]); \
            LDS_WAIT(); __builtin_amdgcn_s_barrier(); } while (0)
#pragma unroll 1
        for (int n2 = 0; n2 < 128; n2 += 2) {
#pragma unroll
            for (int par = 0; par < 2; ++par) {
                const int n = n2 + par;
                SC_STEP();
            }
        }
#undef SC_STEP
#undef SC_SB
    }
}
__device__ __forceinline__ void phase_dn_out(Frame& F, const bf16* qdec, const bf16* attn, const bf16* sbuf, const bf16* vbuf, const bf16* projb, const float* norm_w, bf16* on) {
    PHASE_IDS
    const int fr = lane & 15, fq = lane >> 4;
    LAS unsigned char* tw = F.lds + F.wave * 16384;
    LAS float* rinv = (LAS float*)(F.lds + PREP_SC_OFF + F.wave * 768);
    for (int cid = F.vcu * NWAVES + F.wave; cid < 2048; cid += F.G * NWAVES) {
        const int bh = cid >> 7, n = cid & 127, b = bh >> 3, hh = bh & 7; const size_t row0 = (size_t)b * T + (size_t)n * 64;
        bf16x8 qf[4][4], af[6];
        { const bf16* qb_ = qdec + (size_t)cid * 64 * 128 + fr * 128 + fq * 8;
#pragma unroll
          for (int mt = 0; mt < 4; ++mt)
#pragma unroll
              for (int s_ = 0; s_ < 4; ++s_) qf[mt][s_] = *(const GAS bf16x8*)(qb_ + mt * 16 * 128 + s_ * 32);
          const bf16* ab_ = attn + (size_t)cid * 64 * 64 + fr * 64 + fq * 8;
          af[0] = *(const GAS bf16x8*)(ab_); af[1] = *(const GAS bf16x8*)(ab_ + 16 * 64); af[2] = *(const GAS bf16x8*)(ab_ + 32 * 64); af[3] = *(const GAS bf16x8*)(ab_ + 32 * 64 + 32);
          af[4] = *(const GAS bf16x8*)(ab_ + 48 * 64); af[5] = *(const GAS bf16x8*)(ab_ + 48 * 64 + 32); }
        f32x4 ss[4];
#pragma unroll
        for (int mt = 0; mt < 4; ++mt) ss[mt] = (f32x4){0.f, 0.f, 0.f, 0.f};
#pragma unroll 2
        for (int dvt = 0; dvt < 8; ++dvt) {
            const GAS v4u* sp_ = (const GAS v4u*)(sbuf + ((size_t)cid * 8 + dvt) * 4 * 64 * 8) + lane; const GAS v4u* vp_ = (const GAS v4u*)(vbuf + ((size_t)cid * 8 + dvt) * 2 * 64 * 8) + lane;
            bf16x8 SBf[4], VBf[2];
#pragma unroll
            for (int s_ = 0; s_ < 4; ++s_) SBf[s_] = __builtin_bit_cast(bf16x8, sp_[s_ * 64]);
            VBf[0] = __builtin_bit_cast(bf16x8, vp_[0]); VBf[1] = __builtin_bit_cast(bf16x8, vp_[64]);
            f32x4 o[4];
#pragma unroll
            for (int mt = 0; mt < 4; ++mt) { o[mt] = (f32x4){0.f, 0.f, 0.f, 0.f};
#pragma unroll
                for (int s_ = 0; s_ < 4; ++s_) o[mt] = MFMA32(qf[mt][s_], SBf[s_], o[mt]); }
            o[0] = MFMA32(af[0], VBf[0], o[0]); o[1] = MFMA32(af[1], VBf[0], o[1]); o[2] = MFMA32(af[2], VBf[0], o[2]); o[2] = MFMA32(af[3], VBf[1], o[2]); o[3] = MFMA32(af[4], VBf[0], o[3]); o[3] = MFMA32(af[5], VBf[1], o[3]);
#pragma unroll
            for (int mt = 0; mt < 4; ++mt) { ss[mt] = ss[mt] + o[mt] * o[mt];
                const unsigned lo = pk2(o[mt][0], o[mt][1]), hi2 = pk2(o[mt][2], o[mt][3]);
                LAS unsigned short* tp = (LAS unsigned short*)(tw + (16 * mt + 4 * fq) * 256 + (16 * dvt + fr) * 2);
                tp[0] = (unsigned short)(lo & 0xffff); tp[128] = (unsigned short)(lo >> 16); tp[256] = (unsigned short)(hi2 & 0xffff); tp[384] = (unsigned short)(hi2 >> 16); }
        }
#pragma unroll
        for (int mt = 0; mt < 4; ++mt)
#pragma unroll
            for (int r = 0; r < 4; ++r) { float v = ss[mt][r]; v += __shfl_xor(v, 1); v += __shfl_xor(v, 2); v += __shfl_xor(v, 4); v += __shfl_xor(v, 8);
                if (fr == 0) rinv[16 * mt + 4 * fq + r] = 1.f / sqrtf(v * (1.f / 128.f) + RMS_EPS); }
        LDS_WAIT(); asm volatile("" ::: "memory");
        { const int c16 = lane & 15; f32x4 nw0 = *(const GAS f32x4*)(norm_w + c16 * 8), nw1 = *(const GAS f32x4*)(norm_w + c16 * 8 + 4);
#pragma unroll 4
          for (int i = 0; i < 16; ++i) { const int tok = (lane >> 4) + 4 * i; const float ri = rinv[tok];
              const v4u ov = *(const LAS v4u*)(tw + tok * 256 + c16 * 16); const v4u zv = *(const GAS v4u*)(projb + (row0 + tok) * NINP + 3072 + hh * 128 + c16 * 8);
              const unsigned ow[4] = {ov.x, ov.y, ov.z, ov.w}, zw[4] = {zv.x, zv.y, zv.z, zv.w}; const float nwv[8] = {nw0.x, nw0.y, nw0.z, nw0.w, nw1.x, nw1.y, nw1.z, nw1.w};
              unsigned res[4];
#pragma unroll
              for (int e = 0; e < 4; ++e) { const float o0 = __uint_as_float(ow[e] << 16), o1 = __uint_as_float(ow[e] & 0xffff0000u), z0 = __uint_as_float(zw[e] << 16), z1 = __uint_as_float(zw[e] & 0xffff0000u);
                  res[e] = pk2(o0 * ri * nwv[2 * e] * silu_f(z0), o1 * ri * nwv[2 * e + 1] * silu_f(z1)); }
              *(GAS v4u*)(on + (row0 + tok) * D + hh * 128 + c16 * 8) = (v4u){res[0], res[1], res[2], res[3]}; } }
        LDS_WAIT(); asm volatile("" ::: "memory");
    }
}
#define PH(l, k) (1 + 16 * (l) + (k))
__global__ void __launch_bounds__(NWAVES * 64, 2) mega(Args args) {
    extern __shared__ __attribute__((aligned(16))) unsigned char lds[];
    Frame F;
    F.lds = (LAS unsigned char*)lds; F.MISC = (volatile LAS unsigned*)(F.lds + MISC_OFF);
    F.wave = __builtin_amdgcn_readfirstlane((int)threadIdx.x >> 6);
    F.G = gridDim.x; { const int bx = blockIdx.x; F.vcu = (F.G % 8 == 0) ? (bx % 8) * (F.G / 8) + bx / 8 : bx; }
    F.ws = args.ws; F.ctl = (gu32*)(args.ws + WS_CTL);
    for (int u = threadIdx.x; u < (LDS_BYTES - LDSCTL_OFF) / 4; u += NWAVES * 64) ((LAS unsigned*)(F.lds + LDSCTL_OFF))[u] = 0u;
    __syncthreads();
    const int lo = args.ph_lo, hi = args.ph_hi;
    XcdBarrier bar; bar.bar = (unsigned*)(F.ctl + CW_BAR) + args.bar_region * XCD_BAR_WORDS; bar.x = 0; bar.st = nullptr;
    if (hi - lo > 1) bar = xcd_barrier_post((unsigned*)(F.ctl + CW_BAR) + args.bar_region * XCD_BAR_WORDS, F.MISC + 8, F.wave);
    unsigned char* ws = args.ws;
    bf16* hb = (bf16*)(ws + WS_HB); bf16* h1b = (bf16*)(ws + WS_H1B);
    bf16* projb = (bf16*)(ws + WS_PROJ); bf16* Kb = (bf16*)(ws + WS_KB); bf16* Qb = Kb - (size_t)M * D; bf16* onb = (bf16*)(ws + WS_ON); bf16* mixb = (bf16*)(ws + WS_MIX);
    int* eid = (int*)(ws + WS_EID); float* gate = (float*)(ws + WS_GATE); int* apos = (int*)(ws + WS_APOS);
    bf16* xrows = (bf16*)(ws + WS_XROWS); bf16* hid = (bf16*)(ws + WS_HID); bf16* yrows = (bf16*)(ws + WS_YROWS);
    LAS int* tile_e = (LAS int*)(F.lds + TILEE_OFF); LAS int* psl = (LAS int*)(F.lds + 20480);

#ifndef REPSEL
#define REPSEL(p) 0
#endif
#define IN(p) (lo <= (p) && (p) < hi)
#ifdef PROBE_A
#define STAMP() do { if (blockIdx.x == 0 && F.wave == 0 && __builtin_amdgcn_mbcnt_hi(~0u, __builtin_amdgcn_mbcnt_lo(~0u, 0u)) == 0u) { const unsigned n_ = F.MISC[12]; ((volatile LAS unsigned long long*)(F.lds + STAMP_OFF))[n_] = rt(); F.MISC[12] = n_ + 1; } } while (0)
#else
#define STAMP() do { } while (0)
#endif
#define SEAM(p) do { if ((p) + 1 < hi) xcd_barrier(bar, F.wave); STAMP(); } while (0)
#define DO_PHASE(p, cond, ...) do { if ((cond) && IN(p)) { { const int rep_ = 0; (void)rep_; __VA_ARGS__ } SEAM(p); if (REPSEL(p)) { { const int rep_ = REPSEL(p); (void)rep_; __VA_ARGS__ } if ((p) + 1 < hi) xcd_barrier(bar, F.wave); } } } while (0)
    STAMP();
    DO_PHASE(0, true, p0_prologue(F, args););
#define LAYER(l) do { \
    gu32* counts = F.ctl + CW_CNT + (l) * 64 * CSTR; gu32* cursor = counts + 32 * CSTR; \
    DO_PHASE(PH(l, 0), true, \
        if ((l) < 2) { pg8::Gemm g{hb, (const bf16*)(ws + WS_WIN) + (size_t)(l) * NINP * D, M, NINP, D}; pg8::StaticOrder S; S.init(M, NINP, F.G, (int)blockIdx.x); \
            pg8::EpiBf16<0> E{projb, NINP, nullptr, 0, 0, 1.f}; pg8::gemm_phase<pg8::EpiBf16<0>, pg8::StaticOrder, true, true>(F.lds, g, S, E, F.wave); } \
        else { const int NQ = ((l) == 2) ? 3 * D : D; pg8::Gemm g{hb, (const bf16*)(ws + ((l) == 2 ? WS_WQKV : WS_WQ3)), M, NQ, D}; pg8::StaticOrder S; S.init(M, NQ, F.G, (int)blockIdx.x); \
            pg8::EpiBf16<0> E{Qb, D, nullptr, D, (size_t)M * D, QSCALE}; pg8::gemm_phase<pg8::EpiBf16<0>, pg8::StaticOrder, true, true>(F.lds, g, S, E, F.wave); } ); \
    DO_PHASE(PH(l, 1), (l) < 2, \
        phase_dn_prep(F, hb, (const bf16*)(ws + WS_WG) + (size_t)(l) * 16 * D, projb, args.in[2] + (size_t)(l) * 4 * 3072, args.in[3] + (l) * 8, args.in[4] + (l) * 8, (bf16*)(ws + WS_WNEG), (bf16*)(ws + WS_QDEC), (bf16*)(ws + WS_KDEC), (bf16*)(ws + WS_ATT), (float*)(ws + WS_U), (float*)(ws + WS_GLAST)); ); \
    DO_PHASE(PH(l, 2), (l) < 2, \
        if (F.vcu >= 64) { if (rep_ != 1 && rep_ < 8) p0_moe_weights(F, args, 2 * (l), F.vcu - 64, F.G - 64); } \
        else if (rep_ != 2) phase_dn_scan(F, (const bf16*)(ws + WS_WNEG), (const bf16*)(ws + WS_KDEC), (const float*)(ws + WS_U), (const float*)(ws + WS_GLAST), (bf16*)(ws + WS_SBUF), (bf16*)(ws + WS_VBUF), rep_ >= 8 ? (rep_ & 7) : 0); ); \
    DO_PHASE(PH(l, 3), (l) < 2, \
        phase_dn_out(F, (const bf16*)(ws + WS_QDEC), (const bf16*)(ws + WS_ATT), (const bf16*)(ws + WS_SBUF), (const bf16*)(ws + WS_VBUF), projb, args.in[5] + (l) * 128, onb); ); \
    DO_PHASE(PH(l, 1), (l) >= 2, \
        const attn_body::AttnTensors AT{(const attn_body::bf16*)Qb, (const attn_body::bf16*)Kb, (const attn_body::bf16*)(ws + WS_VB), (attn_body::bf16*)projb, (attn_body::bf16*)(projb + (size_t)M * D)}; \
        const attn_body::StaticOrder S((int)F.G, (int)blockIdx.x); \
        attn_body::attn_phase<attn_body::StaticOrder>((char*)lds, AT, S, F.wave); ); \
    DO_PHASE(PH(l, 3), (l) >= 2, \
        phase_attn_combine(F, projb, projb + (size_t)M * D, args.in[9] + ((l) - 2) * 256, args.in[10] + ((l) - 2) * 128, args.lam_init[(l) & 1], onb); ); \
    DO_PHASE(PH(l, 4), true, \
        const bf16* W = ((l) < 2) ? (const bf16*)(ws + WS_WAOUT) + (size_t)(l) * D * D : (const bf16*)(ws + WS_WBOUT) + (size_t)((l) - 2) * D * D; \
        pg8::Gemm g{onb, W, M, D, D}; pg8::StaticOrder S; S.init(M, D, F.G, (int)blockIdx.x); \
        pg8::EpiBf16<0> E{mixb, D, nullptr, 0, 0, 1.f}; pg8::gemm_phase<pg8::EpiBf16<0>, pg8::StaticOrder, true, true>(F.lds, g, S, E, F.wave); ); \
    DO_PHASE(PH(l, 5), true, \
        phase_ln1_router(F, ((l) == 0) ? args.in[0] : nullptr, hb, mixb, args.in[12] + (l) * D, args.in[13] + (l) * D, h1b, (const bf16*)(ws + WS_WR) + (size_t)(l) * 48 * D, eid, gate, rep_ ? F.ctl + 131072 : counts); ); \
    DO_PHASE(PH(l, 6), true, phase_scatter(F, counts, rep_ ? F.ctl + 131072 + 4096 : cursor, eid, h1b, rep_ ? yrows : xrows, rep_ ? (int*)hid : apos); ); \
    DO_PHASE(PH(l, 7), true, const int ntiles = moe_layout(F, counts, psl, tile_e); \
        pg8::Gemm g{xrows, (const bf16*)(ws + WS_W13) + (size_t)(l) * 32 * 1024 * 1024, NROWS2, 1024, 1024}; pg8::MoeOrder S{ntiles * 4, F.G, F.vcu, tile_e}; \
        pg8::EpiSwiGLU E{hid, 512}; pg8::gemm_phase<pg8::EpiSwiGLU, pg8::MoeOrder, true, true>(F.lds, g, S, E, F.wave); ); \
    DO_PHASE(PH(l, 8), true, const int ntiles = moe_layout(F, counts, psl, tile_e); \
        pg8::Gemm g{hid, (const bf16*)(ws + WS_W2) + (size_t)(l) * 32 * 1024 * 512, NROWS2, 1024, 512}; pg8::MoeOrder S{ntiles * 4, F.G, F.vcu, tile_e}; \
        pg8::EpiBf16G E{yrows, 1024, 3}; pg8::gemm_phase<pg8::EpiBf16G, pg8::MoeOrder, true, true>(F.lds, g, S, E, F.wave); ); \
    DO_PHASE(PH(l, 9), true, \
        phase_combine_ln2(F, h1b, yrows, apos, gate, args.in[14] + (l) * D, args.in[15] + (l) * D, ((l) == 3) ? args.out : nullptr, hb); ); \
    } while (0)
    LAYER(0); LAYER(1); LAYER(2); LAYER(3);
#ifdef PROBE_A
    if (blockIdx.x == 0 && F.wave == 0 && __builtin_amdgcn_mbcnt_hi(~0u, __builtin_amdgcn_mbcnt_lo(~0u, 0u)) == 0u) {
        asm volatile("s_waitcnt vmcnt(0)" ::: "memory");
        volatile LAS unsigned long long* st = (volatile LAS unsigned long long*)(F.lds + STAMP_OFF);
        const float da = (PROBE_A >= 0) ? (float)(st[PROBE_A + 1] - st[PROBE_A]) * 0.01f : 1000.f;
        const float db = (PROBE_B >= 0) ? (float)(st[PROBE_B + 1] - st[PROBE_B]) * 0.01f : 0.f;
        args.out[0] = da; args.out[1] = db;
    }
#endif
#undef LAYER
#undef IN
#undef SEAM
#undef DO_PHASE
#undef STAMP
}

__global__ __launch_bounds__(256) void b2f_k(const unsigned short* __restrict__ src, int lds_, float* __restrict__ dst, int ldd, int cols, float scale) {
    const int row = blockIdx.x; for (int c = threadIdx.x; c < cols; c += 256) dst[(size_t)row * ldd + c] = __uint_as_float((unsigned)src[(size_t)row * lds_ + c] << 16) * scale;
}
__global__ __launch_bounds__(256) void f2b_k(const float* __restrict__ src, int lds_, unsigned short* __restrict__ dst, int ldd, int cols) {
    const int row = blockIdx.x; for (int c = threadIdx.x; c < cols; c += 256) dst[(size_t)row * ldd + c] = (unsigned short)f2bf(src[(size_t)row * lds_ + c]);
}

extern "C" void kernel_launch(void* const* d_in, const int* in_sizes, int n_in, void* d_out, int out_size, void* d_ws, size_t ws_size, hipStream_t stream) {
    static int grid = 0;
    if (grid == 0) {
        int dev = 0, cus = 0;
        if (hipGetDevice(&dev) != hipSuccess || hipDeviceGetAttribute(&cus, hipDeviceAttributeMultiprocessorCount, dev) != hipSuccess) { fprintf(stderr, "kernel_launch: device query failed\n"); grid = -1; return; }
        if (hipFuncSetAttribute((const void*)mega, hipFuncAttributeMaxDynamicSharedMemorySize, LDS_BYTES) != hipSuccess) { fprintf(stderr, "kernel_launch: hipFuncSetAttribute failed\n"); grid = -1; return; }
        int per_cu = 0; (void)hipOccupancyMaxActiveBlocksPerMultiprocessor(&per_cu, (const void*)mega, NWAVES * 64, LDS_BYTES); (void)hipGetLastError();
        if (per_cu < 1) fprintf(stderr, "kernel_launch: occupancy query says %d blocks per CU\n", per_cu);
        grid = cus;
        if (grid != 256) { fprintf(stderr, "kernel_launch: this kernel is built for a 256-CU device (got %d CUs); nothing launched\n", grid); grid = -1; return; }
    }
    if (grid < 0) return;
    unsigned char* ws = (unsigned char*)d_ws;
    if (WS_DN_END > ws_size) { fprintf(stderr, "kernel_launch: workspace too small: need %zu have %zu\n", (size_t)WS_DN_END, ws_size); return; }
    (void)hipMemsetAsync(ws + WS_CTL, 0, CTL_ZERO_BYTES, stream);
    Args a{};
    for (int i = 0; i < 20; ++i) a.in[i] = (const float*)d_in[i];
    a.out = (float*)d_out; a.ws = ws; a.lam_init[0] = (float)(0.8 - 0.6 * exp(-0.3 * 2.0)); a.lam_init[1] = (float)(0.8 - 0.6 * exp(-0.3 * 3.0));
    int nlaunch = 0;
    auto mk = [&](int lo, int hi) { a.ph_lo = lo; a.ph_hi = hi; a.bar_region = nlaunch++; hipLaunchKernelGGL(mega, dim3(grid), dim3(NWAVES * 64), LDS_BYTES, stream, a); };
#ifndef MULTI_LAUNCH
    mk(0, PH(3, 9) + 1);
#else
    mk(0, 1);
    for (int l = 0; l < 4; ++l) mk(PH(l, 0), PH(l, 9) + 1);
#endif
}
```

```cpp
#include <hip/hip_runtime.h>
#include <stdint.h>
#include <stdio.h>
#include <math.h>
#include <cstdint>
namespace pg8 {
#define PG8_LAS __attribute__((address_space(3)))
typedef unsigned short bf16_t;
typedef short bf16x8 __attribute__((ext_vector_type(8)));
typedef float f32x4 __attribute__((ext_vector_type(4)));
typedef unsigned u32x4 __attribute__((ext_vector_type(4)));
constexpr int BM = 256, BK = 64, HALF = 128, HTB = HALF * BK * 2  , STAGE_BYTES = 8 * HTB, NXCD = 8, WGM = 8;

__host__ __device__ __forceinline__ int lds_byte(int r, int c) { const int st = (r >> 4) * 2 + (c >> 5), rr = r & 15, cc = c & 31, ob = rr * 64 + cc * 2; return st * 1024 + (ob ^ (((ob >> 9) & 1) << 5)); }
__host__ __device__ __forceinline__ void stage_rc(int b, int& R, int& C) { const int st = b / 1024, sb = b % 1024, swz = sb ^ (((sb >> 9) & 1) << 5); R = (st >> 1) * 16 + swz / 64; C = (st & 1) * 32 + (swz % 64) / 2; }
__host__ __device__ __forceinline__ int perm32(int rho) { const int n = rho >> 4, i = rho & 15; return 8 * (i >> 2) + 4 * n + (i & 3); }

struct Unit { int pm, pn; };
struct Gemm { const bf16_t* A; const bf16_t* Bt; int M, N, K; };

struct StaticOrder {
    int nM, nN, nwg, G, c;
    __host__ __device__ void init(int M, int N, int G_, int c_) { nM = M / BM; nN = N / BM; nwg = nM * nN; G = G_; c = c_; }
    __host__ __device__ bool next(int i, Unit& u) const {
        const long L = (long)i * G + c; if (L >= nwg) return false;
        int wgid = (int)L; { const int q = nwg / NXCD, r = nwg % NXCD, xcd = wgid % NXCD, off = wgid / NXCD; wgid = (xcd < r ? xcd * (q + 1) : r * (q + 1) + (xcd - r) * q) + off; }
        const int nig = WGM * nN, gid = wgid / nig, fm = gid * WGM, gsz = (nM - fm) < WGM ? (nM - fm) : WGM;
        u.pm = fm + ((wgid % nig) % gsz); u.pn = (wgid % nig) / gsz; return true;
    }
    __device__ __forceinline__ void a_ready(const Unit&) const {}
    __device__ __forceinline__ void done(const Unit&) const {}
};

__device__ __forceinline__ void st16_wt(void* p, u32x4 v) { asm volatile("global_store_dwordx4 %0, %1, off sc1\n\ts_nop 1" :: "v"(p), "v"(v) : "memory"); }
__device__ __forceinline__ unsigned cvt_pk_bf16(float lo, float hi) { unsigned r; asm volatile("v_cvt_pk_bf16_f32 %0, %1, %2" : "=v"(r) : "v"(lo), "v"(hi)); return r; }
typedef float f32x2 __attribute__((ext_vector_type(2)));
__device__ __forceinline__ f32x2 gelu_pk(f32x2 v) {
    const f32x2 av = __builtin_elementwise_abs(v), d = av * 0.2316418882f + 1.0f;
    f32x2 t; t.x = __builtin_amdgcn_rcpf(d.x); t.y = __builtin_amdgcn_rcpf(d.y);
    f32x2 q = t * 0.5307027145f + (-0.7265760135f); q = q * t + 0.7107068705f; q = q * t + (-0.142248368f); q = q * t + 0.127414796f; q = q * t;
    const f32x2 s = (v * v) * (-0.72134752044f);
    f32x2 e; e.x = __builtin_amdgcn_exp2f(s.x); e.y = __builtin_amdgcn_exp2f(s.y);
    const f32x2 m = v * (q * e), r = v - m;
    f32x2 o; o.x = v.x < 0.f ? m.x : r.x; o.y = v.y < 0.f ? m.y : r.y; return o;
}

template <int ACT  > struct EpiBf16 {
    static constexpr bool PERM = true, AFTER_DRAIN = false; static_assert(ACT == 0 || ACT == 1, "EpiBf16: ACT is 0 (none) or 1 (gelu_pk)");
    bf16_t* O; int ldc; const float* bias; int split_cols; size_t split_stride; float scale0;
    __device__ __forceinline__ void operator()(const f32x4 (&acc)[2][2][4][2], const Unit& u, int wr, int wc, int fr, int fq) const {
        const int row0 = u.pm * BM + wr * 64 + fr; int colt = u.pn * BM; bf16_t* base = O;
        float sc = 1.f; if (split_cols) { const int t = colt / split_cols; base += (size_t)t * split_stride; colt -= t * split_cols; if (t == 0) sc = scale0; }
        const int col0 = colt + wc * 32 + 8 * fq, bcol0 = u.pn * BM + wc * 32 + 8 * fq;
        f32x4 bv[2][2];
#pragma unroll
        for (int bj = 0; bj < 2; ++bj)
#pragma unroll
            for (int n = 0; n < 2; ++n) bv[bj][n] = bias ? *(const f32x4*)(bias + bcol0 + bj * HALF + 4 * n) : (f32x4){0.f, 0.f, 0.f, 0.f};
#pragma unroll
        for (int ai = 0; ai < 2; ++ai)
#pragma unroll
            for (int m = 0; m < 4; ++m) { bf16_t* rowp = base + (size_t)(row0 + ai * HALF + m * 16) * ldc + col0;
#pragma unroll
                for (int bj = 0; bj < 2; ++bj) { f32x4 v0 = acc[ai][bj][m][0] + bv[bj][0], v1 = acc[ai][bj][m][1] + bv[bj][1];
                    if (ACT == 1) { f32x2 a = gelu_pk((f32x2){v0[0], v0[1]}), b = gelu_pk((f32x2){v0[2], v0[3]}), c = gelu_pk((f32x2){v1[0], v1[1]}), d = gelu_pk((f32x2){v1[2], v1[3]});
                        v0 = (f32x4){a.x, a.y, b.x, b.y}; v1 = (f32x4){c.x, c.y, d.x, d.y}; }
                    v0 = v0 * sc; v1 = v1 * sc; u32x4 w; w.x = cvt_pk_bf16(v0[0], v0[1]); w.y = cvt_pk_bf16(v0[2], v0[3]); w.z = cvt_pk_bf16(v1[0], v1[1]); w.w = cvt_pk_bf16(v1[2], v1[3]);
                    st16_wt(rowp + bj * HALF, w); } }
    }
};

struct PanelStats {
    unsigned* xbuf;
    unsigned* cnt;
    unsigned* tmo;
    int ntn; float eps;
    unsigned code;
    __device__ __forceinline__ bool run(const f32x4 (&v)[2][2][4][2], const Unit& u, int wr, int wc, int fr, int fq, PG8_LAS unsigned char* lds, int wid, int lane) const {
        typedef float f32x2v __attribute__((ext_vector_type(2)));
        PG8_LAS f32x2v* P = (PG8_LAS f32x2v*)lds;
        PG8_LAS f32x2v* S = (PG8_LAS f32x2v*)(lds + 8192);
        PG8_LAS unsigned* flag = (PG8_LAS unsigned*)(lds + 8192 + 2048);
#pragma unroll
        for (int ai = 0; ai < 2; ++ai)
#pragma unroll
            for (int m = 0; m < 4; ++m) {
                float s = 0.f;
#pragma unroll
                for (int bj = 0; bj < 2; ++bj)
#pragma unroll
                    for (int n = 0; n < 2; ++n) { const f32x4 x = v[ai][bj][m][n]; s += (x[0] + x[1]) + (x[2] + x[3]); }
                s += __shfl_xor(s, 16); s += __shfl_xor(s, 32);
                const float mw = s * (1.0f / 64.0f); float q = 0.f;
#pragma unroll
                for (int bj = 0; bj < 2; ++bj)
#pragma unroll
                    for (int n = 0; n < 2; ++n) { const f32x4 d = v[ai][bj][m][n] - mw; q += (d[0] * d[0] + d[1] * d[1]) + (d[2] * d[2] + d[3] * d[3]); }
                q += __shfl_xor(q, 16); q += __shfl_xor(q, 32);
                if (fq == 0) P[(ai * HALF + wr * 64 + m * 16 + fr) * 4 + wc] = (f32x2v){mw, q};
            }
        asm volatile("s_waitcnt lgkmcnt(0)" ::: "memory"); __builtin_amdgcn_s_barrier(); asm volatile("" ::: "memory");
#if defined(BROKEN_EXCHANGE_NO_WAIT)
#warning BROKEN CONTROL BUILD: the row-statistics exchange does not wait; results are wrong by design
        if (blockIdx.x >= 64) { const long long t0_ = clock64(); while (clock64() - t0_ < 60000) __builtin_amdgcn_s_sleep(8); }
#endif
        const int row = wid * 32 + (lane & 31);
        if (lane < 32) {
            const f32x2v a = P[row * 4 + 0], b = P[row * 4 + 1], c = P[row * 4 + 2], d = P[row * 4 + 3];
            const float mt = (a.x + b.x + c.x + d.x) * 0.25f;
            const float da = a.x - mt, db = b.x - mt, dc = c.x - mt, dd = d.x - mt;
            const float m2 = (a.y + b.y) + (c.y + d.y) + 64.0f * ((da * da + db * db) + (dc * dc + dd * dd));
            unsigned long long* slot = (unsigned long long*)xbuf + ((size_t)(u.pm * BM + row) * 4 + u.pn);
            __hip_atomic_store(slot, ((unsigned long long)__float_as_uint(m2) << 32) | __float_as_uint(mt), __ATOMIC_RELAXED, __HIP_MEMORY_SCOPE_AGENT);
        }
        asm volatile("s_waitcnt vmcnt(0)" ::: "memory");
        if (lane == 0) __hip_atomic_fetch_add(cnt + 64 * u.pm, 1u, __ATOMIC_RELAXED, __HIP_MEMORY_SCOPE_AGENT);
        if (wid == 0) {
            bool dead = false; const unsigned long long t0 = __builtin_amdgcn_s_memrealtime(); const unsigned want = 8u * (unsigned)ntn;
            for (;;) {
#if defined(BROKEN_EXCHANGE_NO_WAIT)
                break;
#endif
                if ((unsigned)__builtin_amdgcn_readfirstlane(__hip_atomic_load(cnt + 64 * u.pm, __ATOMIC_RELAXED, __HIP_MEMORY_SCOPE_AGENT)) >= want) break;
                if (__builtin_amdgcn_s_memrealtime() - t0 > 2000000ull) {
                    if (lane == 0) { unsigned expect = 0u; __hip_atomic_compare_exchange_strong(tmo + 1, &expect, code | (unsigned)(u.pm & 0xff), __ATOMIC_RELAXED, __ATOMIC_RELAXED, __HIP_MEMORY_SCOPE_AGENT);
                                     __hip_atomic_store(tmo, 1u, __ATOMIC_RELAXED, __HIP_MEMORY_SCOPE_AGENT); }
                    dead = true; break; }
                __builtin_amdgcn_s_sleep(2);
            }
            __builtin_amdgcn_fence(__ATOMIC_ACQUIRE, "agent");
            if (lane == 0) flag[0] = dead ? 1u : 0u;
        }
        asm volatile("s_waitcnt vmcnt(0) lgkmcnt(0)" ::: "memory"); __builtin_amdgcn_s_barrier(); asm volatile("" ::: "memory");
        const bool bad = flag[0] != 0u;
        if (lane < 32) {
            const unsigned long long* slot = (const unsigned long long*)xbuf + (size_t)(u.pm * BM + row) * 4; float mt[4], m2[4]; float ms = 0.f;
#pragma unroll
            for (int t = 0; t < 4; ++t) { if (t < ntn) { const unsigned long long w = __hip_atomic_load(slot + t, __ATOMIC_RELAXED, __HIP_MEMORY_SCOPE_AGENT); mt[t] = __uint_as_float((unsigned)w); m2[t] = __uint_as_float((unsigned)(w >> 32)); } else { mt[t] = 0.f; m2[t] = 0.f; } ms += mt[t]; }
            const float mean = ms / (float)ntn; float q = 0.f;
#pragma unroll
            for (int t = 0; t < 4; ++t) if (t < ntn) { const float dm = mt[t] - mean; q += m2[t] + 256.0f * dm * dm; }
            S[row] = (f32x2v){mean, 1.0f / sqrtf(q / (256.0f * (float)ntn) + eps)};
        }
        asm volatile("s_waitcnt lgkmcnt(0)" ::: "memory"); __builtin_amdgcn_s_barrier(); asm volatile("" ::: "memory");
        return bad;
    }
};
struct EpiLnRes {
    static constexpr bool PERM = false, AFTER_DRAIN = true;
    const float* base; float* out; int ldc; const float* bias; PanelStats st; unsigned poison;
    __device__ __forceinline__ void fused(f32x4 (&acc)[2][2][4][2], const Unit& u, int wr, int wc, int fr, int fq, PG8_LAS unsigned char* lds, int wid, int lane) const {
        typedef float f32x2v __attribute__((ext_vector_type(2)));
        const PG8_LAS f32x2v* S = (const PG8_LAS f32x2v*)(lds + 8192);
        const int col0 = u.pn * BM + wc * 32 + 4 * fq;
#pragma unroll
        for (int bj = 0; bj < 2; ++bj)
#pragma unroll
            for (int n = 0; n < 2; ++n) { const f32x4 bv = bias ? *(const f32x4*)(bias + col0 + bj * HALF + n * 16) : (f32x4){0.f, 0.f, 0.f, 0.f};
#pragma unroll
                for (int ai = 0; ai < 2; ++ai)
#pragma unroll
                    for (int m = 0; m < 4; ++m) acc[ai][bj][m][n] += bv; }
        f32x4 pre[4][2][2];
#pragma unroll
        for (int m = 0; m < 4; ++m) { const size_t off = (size_t)(u.pm * BM + wr * 64 + m * 16 + fr) * ldc + col0;
#pragma unroll
            for (int bj = 0; bj < 2; ++bj)
#pragma unroll
                for (int n = 0; n < 2; ++n) pre[m][bj][n] = *(const f32x4*)(base + off + bj * HALF + n * 16); }
        const bool bad = st.run(acc, u, wr, wc, fr, fq, lds, wid, lane) || poison != 0u;
        const float qnan = __builtin_nanf("");
#pragma unroll
        for (int ai = 0; ai < 2; ++ai)
#pragma unroll
            for (int m = 0; m < 4; ++m) { const int r = ai * HALF + wr * 64 + m * 16 + fr; const f32x2v sr = S[r]; const size_t off = (size_t)(u.pm * BM + r) * ldc + col0;
#pragma unroll
                for (int bj = 0; bj < 2; ++bj)
#pragma unroll
                    for (int n = 0; n < 2; ++n) { const f32x4 bs = ai == 0 ? pre[m][bj][n] : *(const f32x4*)(base + off + bj * HALF + n * 16); f32x4 o = bs + (acc[ai][bj][m][n] - sr.x) * sr.y;
                        if (bad) o = (f32x4){qnan, qnan, qnan, qnan}; *(f32x4*)(out + off + bj * HALF + n * 16) = o; }
                if (m & 1) asm volatile("" ::: "memory"); }
    }
};
struct EpiLnResLn {
    static constexpr bool PERM = false, AFTER_DRAIN = true;
    const float* base; float* out; bf16_t* xn; int ldc; const float* bias; PanelStats st1, st2; unsigned poison;
    __device__ __forceinline__ void fused(f32x4 (&acc)[2][2][4][2], const Unit& u, int wr, int wc, int fr, int fq, PG8_LAS unsigned char* lds, int wid, int lane) const {
        typedef float f32x2v __attribute__((ext_vector_type(2))); typedef unsigned u32x2v __attribute__((ext_vector_type(2)));
        const PG8_LAS f32x2v* S = (const PG8_LAS f32x2v*)(lds + 8192);
        const int col0 = u.pn * BM + wc * 32 + 4 * fq;
#pragma unroll
        for (int bj = 0; bj < 2; ++bj)
#pragma unroll
            for (int n = 0; n < 2; ++n) { const f32x4 bv = bias ? *(const f32x4*)(bias + col0 + bj * HALF + n * 16) : (f32x4){0.f, 0.f, 0.f, 0.f};
#pragma unroll
                for (int ai = 0; ai < 2; ++ai)
#pragma unroll
                    for (int m = 0; m < 4; ++m) acc[ai][bj][m][n] += bv; }
        bool bad = st1.run(acc, u, wr, wc, fr, fq, lds, wid, lane) || poison != 0u;
        const float qnan = __builtin_nanf("");
#pragma unroll
        for (int ai = 0; ai < 2; ++ai)
#pragma unroll
            for (int m = 0; m < 4; ++m) { const int r = ai * HALF + wr * 64 + m * 16 + fr; const f32x2v sr = S[r]; const size_t off = (size_t)(u.pm * BM + r) * ldc + col0;
#pragma unroll
                for (int bj = 0; bj < 2; ++bj)
#pragma unroll
                    for (int n = 0; n < 2; ++n) { const f32x4 bs = *(const f32x4*)(base + off + bj * HALF + n * 16); acc[ai][bj][m][n] = bs + (acc[ai][bj][m][n] - sr.x) * sr.y; }
                asm volatile("" : "+v"(acc[ai][0][m][0]), "+v"(acc[ai][0][m][1]), "+v"(acc[ai][1][m][0]), "+v"(acc[ai][1][m][1]));
                if (m & 1) asm volatile("" ::: "memory"); }
        const bool bad1 = bad;
        bad = st2.run(acc, u, wr, wc, fr, fq, lds, wid, lane) || bad;
#pragma unroll
        for (int ai = 0; ai < 2; ++ai)
#pragma unroll
            for (int m = 0; m < 4; ++m) { const int r = ai * HALF + wr * 64 + m * 16 + fr; const f32x2v sr = S[r]; const size_t off = (size_t)(u.pm * BM + r) * ldc + col0;
#pragma unroll
                for (int bj = 0; bj < 2; ++bj)
#pragma unroll
                    for (int n = 0; n < 2; ++n) { const f32x4 x1 = acc[ai][bj][m][n]; *(f32x4*)(out + off + bj * HALF + n * 16) = bad1 ? (f32x4){qnan, qnan, qnan, qnan} : x1;
                        const f32x4 o = (x1 - sr.x) * sr.y; u32x2v w; w.x = cvt_pk_bf16(o[0], o[1]); w.y = cvt_pk_bf16(o[2], o[3]);
                        if (bad) { w.x = 0x7fc07fc0u; w.y = 0x7fc07fc0u; } *(u32x2v*)(xn + off + bj * HALF + n * 16) = w; }
                asm volatile("" ::: "memory"); }
    }
};

template <class Epi, class Sched, bool ALIGN_EPI = false, bool SP2 = false>
__device__ __forceinline__ void gemm_phase(PG8_LAS unsigned char* lds, const Gemm g, const Sched& S, const Epi& E, const int wave_id) {
    int tid_ = wave_id * 64 + (int)__builtin_amdgcn_mbcnt_hi(~0u, __builtin_amdgcn_mbcnt_lo(~0u, 0u)); asm volatile("" : "+v"(tid_));
    const int tid = tid_, wid = __builtin_amdgcn_readfirstlane(tid >> 6), lane = tid & 63, wr = wid >> 2, wc = wid & 3, fr = lane & 15, fq = lane >> 4;
    const int K = g.K, nt = K / BK;
    unsigned voffA[2], voffB[2];
#pragma unroll
    for (int i = 0; i < 2; ++i) { int R, C; stage_rc(tid * 16 + i * 8192, R, C); const int Rb = Epi::PERM ? ((R & ~31) + perm32(R & 31)) : R;
        voffA[i] = (unsigned)(R * K + C) * 2u; voffB[i] = (unsigned)(Rb * K + C) * 2u; }
    const size_t kstep = (size_t)(BK * 2);
    const size_t hstep = (size_t)HALF * K * 2;
    const size_t tstep = 2 * hstep;
    const unsigned ldsw = (unsigned)wid * 1024u;
    const int aoff = lds_byte(wr * 64 + fr, fq * 8), boff = lds_byte(wc * 32 + fr, fq * 8);
#define PG8_SA(b, h) (((b) * 2 + (h)) * HTB)
#define PG8_SB(b, h) ((4 + (b) * 2 + (h)) * HTB)
#define PG8_STAGE(bufoff, gbase, voff) do { _Pragma("unroll") for (int _i = 0; _i < 2; ++_i) \
        __builtin_amdgcn_global_load_lds((const unsigned*)((const char*)(gbase) + (voff)[_i]), (PG8_LAS unsigned*)(lds + (bufoff) + ldsw + _i * 8192), 16, 0, 0); } while (0)
#define PG8_LDA(dst, b, h) do { _Pragma("unroll") for (int m = 0; m < 4; ++m) _Pragma("unroll") for (int k = 0; k < 2; ++k) dst[m][k] = *(const PG8_LAS bf16x8*)(lds + PG8_SA(b, h) + aoff + m * 2048 + k * 1024); } while (0)
#define PG8_LDB(dst, b, h) do { _Pragma("unroll") for (int n = 0; n < 2; ++n) _Pragma("unroll") for (int k = 0; k < 2; ++k) dst[n][k] = *(const PG8_LAS bf16x8*)(lds + PG8_SB(b, h) + boff + n * 2048 + k * 1024); } while (0)
#define PG8_MMA(ai, bj, At, Bt) do { __builtin_amdgcn_s_setprio(1); _Pragma("unroll") for (int m = 0; m < 4; ++m) _Pragma("unroll") for (int n = 0; n < 2; ++n) _Pragma("unroll") for (int k = 0; k < 2; ++k) \
        acc[ai][bj][m][n] = __builtin_amdgcn_mfma_f32_16x16x32_bf16(Bt[n][k], At[m][k], acc[ai][bj][m][n], 0, 0, 0); __builtin_amdgcn_s_setprio(0); } while (0)
#define PG8_WAIT_V(n) asm volatile("s_waitcnt vmcnt(" #n ")" ::: "memory")
#define PG8_WAIT_L(n) asm volatile("s_waitcnt lgkmcnt(" #n ")" ::: "memory")
#define PG8_BAR __builtin_amdgcn_s_barrier()
#define PG8_SCHED __builtin_amdgcn_sched_barrier(0)
    Unit cur, nxt; int ui = 0;
    if (!S.next(0, cur)) return;
    f32x4 acc[2][2][4][2];
#pragma unroll
    for (int a = 0; a < 2; ++a)
#pragma unroll
        for (int b = 0; b < 2; ++b)
#pragma unroll
            for (int m = 0; m < 4; ++m)
#pragma unroll
                for (int n = 0; n < 2; ++n) acc[a][b][m][n] = (f32x4){0.f, 0.f, 0.f, 0.f};
    bf16x8 At[4][2], B0[2][2], B1[2][2];
    const char* cA = (const char*)g.A + (size_t)cur.pm * tstep; const char* cB = (const char*)g.Bt + (size_t)cur.pn * tstep;
    S.a_ready(cur);
    if constexpr (SP2) {
        PG8_STAGE(PG8_SB(0, 0), cB, voffB); PG8_STAGE(PG8_SB(0, 1), cB + hstep, voffB); PG8_STAGE(PG8_SA(0, 0), cA, voffA); PG8_STAGE(PG8_SA(0, 1), cA + hstep, voffA);
        if (wr == 1) PG8_BAR;
        PG8_WAIT_V(2); PG8_BAR;
        PG8_STAGE(PG8_SB(1, 0), cB + kstep, voffB); PG8_STAGE(PG8_SA(1, 0), cA + kstep, voffA); PG8_STAGE(PG8_SB(1, 1), cB + hstep + kstep, voffB);
        PG8_WAIT_V(6); PG8_BAR;
    } else {
        PG8_STAGE(PG8_SB(0, 0), cB, voffB); PG8_STAGE(PG8_SA(0, 0), cA, voffA); PG8_STAGE(PG8_SB(0, 1), cB + hstep, voffB); PG8_STAGE(PG8_SA(0, 1), cA + hstep, voffA);
        if (wr == 1) PG8_BAR;
        PG8_WAIT_V(4); PG8_BAR;
        PG8_STAGE(PG8_SB(1, 0), cB + kstep, voffB); PG8_STAGE(PG8_SA(1, 0), cA + kstep, voffA); PG8_STAGE(PG8_SB(1, 1), cB + hstep + kstep, voffB);
        PG8_WAIT_V(6); PG8_BAR;
    }
    for (;;) {
        const bool has_next = S.next(ui + 1, nxt);
        const char* nA = has_next ? (const char*)g.A + (size_t)nxt.pm * tstep : cA; const char* nB = has_next ? (const char*)g.Bt + (size_t)nxt.pn * tstep : cB;
        for (int t = 0; t < nt; t += 2) {
            const bool last = (t == nt - 2);
            const char* a1 = cA + (size_t)(t + 1) * kstep;
            const char* a2 = last ? nA : cA + (size_t)(t + 2) * kstep; const char* b2 = last ? nB : cB + (size_t)(t + 2) * kstep;
            const char* a3 = a2 + kstep; const char* b3 = b2 + kstep;
            if (last && has_next) S.a_ready(nxt);
            if constexpr (SP2) {
            PG8_LDB(B0, 0, 0); PG8_LDB(B1, 0, 1); PG8_SCHED; PG8_LDA(At, 0, 0); PG8_STAGE(PG8_SA(1, 1), a1 + hstep, voffA);
            PG8_WAIT_V(8); PG8_WAIT_L(0); PG8_BAR; PG8_MMA(0, 0, At, B0); PG8_MMA(0, 1, At, B1); PG8_BAR; PG8_SCHED;
            PG8_LDA(At, 0, 1); PG8_STAGE(PG8_SB(0, 0), b2, voffB); PG8_STAGE(PG8_SB(0, 1), b2 + hstep, voffB); PG8_STAGE(PG8_SA(0, 0), a2, voffA);
            PG8_WAIT_V(8); PG8_WAIT_L(0); PG8_BAR; PG8_MMA(1, 0, At, B0); PG8_MMA(1, 1, At, B1); PG8_BAR; PG8_SCHED;
            PG8_LDB(B0, 1, 0); PG8_LDB(B1, 1, 1); PG8_SCHED; PG8_LDA(At, 1, 0); PG8_STAGE(PG8_SA(0, 1), a2 + hstep, voffA);
            PG8_WAIT_V(8); PG8_WAIT_L(0); PG8_BAR; PG8_MMA(0, 0, At, B0); PG8_MMA(0, 1, At, B1); PG8_BAR; PG8_SCHED;
            PG8_LDA(At, 1, 1); PG8_STAGE(PG8_SB(1, 0), b3, voffB); PG8_STAGE(PG8_SB(1, 1), b3 + hstep, voffB); PG8_STAGE(PG8_SA(1, 0), a3, voffA);
            PG8_WAIT_V(8); PG8_WAIT_L(0); PG8_BAR; PG8_MMA(1, 0, At, B0); PG8_MMA(1, 1, At, B1); PG8_BAR; PG8_SCHED;
            } else {
            PG8_LDB(B0, 0, 0); PG8_SCHED; PG8_LDA(At, 0, 0); PG8_STAGE(PG8_SA(1, 1), a1 + hstep, voffA);
            PG8_WAIT_L(8); PG8_BAR; PG8_WAIT_L(0); PG8_MMA(0, 0, At, B0); PG8_BAR; PG8_SCHED;
            PG8_LDB(B1, 0, 1); PG8_STAGE(PG8_SB(0, 0), b2, voffB);
            PG8_BAR; PG8_WAIT_L(0); PG8_MMA(0, 1, At, B1); PG8_BAR;
            PG8_LDA(At, 0, 1); PG8_STAGE(PG8_SA(0, 0), a2, voffA);
            PG8_BAR; PG8_WAIT_L(0); PG8_MMA(1, 0, At, B0); PG8_BAR; PG8_SCHED;
            PG8_STAGE(PG8_SB(0, 1), b2 + hstep, voffB);
            PG8_WAIT_V(6); PG8_BAR; PG8_MMA(1, 1, At, B1); PG8_BAR;
            PG8_LDB(B0, 1, 0); PG8_SCHED; PG8_LDA(At, 1, 0); PG8_STAGE(PG8_SA(0, 1), a2 + hstep, voffA);
            PG8_WAIT_L(8); PG8_BAR; PG8_WAIT_L(0); PG8_MMA(0, 0, At, B0); PG8_BAR; PG8_SCHED;
            PG8_LDB(B1, 1, 1); PG8_STAGE(PG8_SB(1, 0), b3, voffB);
            PG8_BAR; PG8_WAIT_L(0); PG8_MMA(0, 1, At, B1); PG8_BAR;
            PG8_LDA(At, 1, 1); PG8_STAGE(PG8_SA(1, 0), a3, voffA);
            PG8_BAR; PG8_WAIT_L(0); PG8_MMA(1, 0, At, B0); PG8_BAR; PG8_SCHED;
            PG8_STAGE(PG8_SB(1, 1), b3 + hstep, voffB);
            PG8_WAIT_V(6); PG8_BAR; PG8_MMA(1, 1, At, B1); PG8_BAR;
            }
        }
        if constexpr (ALIGN_EPI) { if (wr == 0) PG8_BAR; }
        if constexpr (!Epi::AFTER_DRAIN) { E(acc, cur, wr, wc, fr, fq); S.done(cur); }
        if (!has_next) break;
#pragma unroll
        for (int a = 0; a < 2; ++a)
#pragma unroll
            for (int b = 0; b < 2; ++b)
#pragma unroll
                for (int m = 0; m < 4; ++m)
#pragma unroll
                    for (int n = 0; n < 2; ++n) acc[a][b][m][n] = (f32x4){0.f, 0.f, 0.f, 0.f};
        cur = nxt; cA = nA; cB = nB; ++ui;
        if constexpr (ALIGN_EPI) { if (wr == 1) PG8_BAR; }
    }
    PG8_WAIT_V(0);
    if constexpr (!ALIGN_EPI) { if (wr == 0) PG8_BAR; }
    PG8_BAR;
    if constexpr (Epi::AFTER_DRAIN) { E.fused(acc, cur, wr, wc, fr, fq, lds, wid, lane); S.done(cur); }
#undef PG8_SA
#undef PG8_SB
#undef PG8_STAGE
#undef PG8_LDA
#undef PG8_LDB
#undef PG8_MMA
#undef PG8_WAIT_V
#undef PG8_WAIT_L
#undef PG8_BAR
#undef PG8_SCHED
}
}
namespace pg8 {
struct EpiF32 {
    static constexpr bool PERM = false, AFTER_DRAIN = false;
    float* C; int ldc;
    __device__ __forceinline__ void operator()(const f32x4 (&acc)[2][2][4][2], const Unit& u, int wr, int wc, int fr, int fq) const {
        const int row0 = u.pm * BM + wr * 64 + fr, col0 = u.pn * BM + wc * 32 + 4 * fq;
#pragma unroll
        for (int ai = 0; ai < 2; ++ai)
#pragma unroll
            for (int m = 0; m < 4; ++m) { float* rowp = C + (size_t)(row0 + ai * HALF + m * 16) * ldc + col0;
#pragma unroll
                for (int bj = 0; bj < 2; ++bj)
#pragma unroll
                    for (int n = 0; n < 2; ++n) *(f32x4*)(rowp + bj * HALF + n * 16) = acc[ai][bj][m][n]; }
    }
};
struct EpiBf16G {
    static constexpr bool PERM = true, AFTER_DRAIN = false;
    bf16_t* O; int ldc; int pnmask;
    __device__ __forceinline__ void operator()(const f32x4 (&acc)[2][2][4][2], const Unit& u, int wr, int wc, int fr, int fq) const {
        const int row0 = u.pm * BM + wr * 64 + fr, col0 = (u.pn & pnmask) * BM + wc * 32 + 8 * fq;
#pragma unroll
        for (int ai = 0; ai < 2; ++ai)
#pragma unroll
            for (int m = 0; m < 4; ++m) { bf16_t* rowp = O + (size_t)(row0 + ai * HALF + m * 16) * ldc + col0;
#pragma unroll
                for (int bj = 0; bj < 2; ++bj) { const f32x4 v0 = acc[ai][bj][m][0], v1 = acc[ai][bj][m][1];
                    u32x4 w; w.x = cvt_pk_bf16(v0[0], v0[1]); w.y = cvt_pk_bf16(v0[2], v0[3]); w.z = cvt_pk_bf16(v1[0], v1[1]); w.w = cvt_pk_bf16(v1[2], v1[3]);
                    st16_wt(rowp + bj * HALF, w); } }
    }
};
__device__ __forceinline__ float silu_fast(float x) { return x * __builtin_amdgcn_rcpf(1.f + __builtin_amdgcn_exp2f(-1.4426950408889634f * x)); }
struct EpiSwiGLU {
    static constexpr bool PERM = true, AFTER_DRAIN = false;
    bf16_t* O; int ldc;
    __device__ __forceinline__ void operator()(const f32x4 (&acc)[2][2][4][2], const Unit& u, int wr, int wc, int fr, int fq) const {
        const int row0 = u.pm * BM + wr * 64 + fr, col0 = (u.pn & 3) * HALF + wc * 32 + 8 * fq;
#pragma unroll
        for (int ai = 0; ai < 2; ++ai)
#pragma unroll
            for (int m = 0; m < 4; ++m) { bf16_t* rowp = O + (size_t)(row0 + ai * HALF + m * 16) * ldc + col0;
                const f32x4 a0 = acc[ai][0][m][0], a1 = acc[ai][0][m][1], g0 = acc[ai][1][m][0], g1 = acc[ai][1][m][1];
                u32x4 w; w.x = cvt_pk_bf16(silu_fast(a0[0]) * g0[0], silu_fast(a0[1]) * g0[1]); w.y = cvt_pk_bf16(silu_fast(a0[2]) * g0[2], silu_fast(a0[3]) * g0[3]);
                w.z = cvt_pk_bf16(silu_fast(a1[0]) * g1[0], silu_fast(a1[1]) * g1[1]); w.w = cvt_pk_bf16(silu_fast(a1[2]) * g1[2], silu_fast(a1[3]) * g1[3]);
                st16_wt(rowp, w); }
    }
};
struct MoeOrder {
    int nunits, G, v; const PG8_LAS int* tile_e;
    __device__ __forceinline__ bool next(int i, Unit& u) const { const int L = i * G + v; if (L >= nunits) return false; const int t = L >> 2; u.pm = t; u.pn = __builtin_amdgcn_readfirstlane(tile_e[t]) * 4 + (L & 3); return true; }
    __device__ __forceinline__ void a_ready(const Unit&) const {}
    __device__ __forceinline__ void done(const Unit&) const {}
};
}
#include <hip/hip_bf16.h>
#include <cmath>
namespace attn_body {
using bf16=__hip_bfloat16;
using bf16x8=__attribute__((ext_vector_type(8)))short;
using s16x4=__attribute__((ext_vector_type(4)))short;
using f32x16=__attribute__((ext_vector_type(16)))float;
using u32x4=__attribute__((ext_vector_type(4)))unsigned;
constexpr int BATCH=2,NHEAD=16,SEQ=8192,D=64,DM=NHEAD*D;
constexpr int NW=8,QBLK=32,QB=QBLK*NW,KVBLK=64,NQB=SEQ/QB;
constexpr int ATTN_PITCH=DM, ATTN_UNIT_ROWS=QB;
__device__ __forceinline__ int crow(int r,int hi){return (r&3)+8*(r>>2)+4*hi;}
#define SBAR() __builtin_amdgcn_sched_barrier(0)
__device__ __forceinline__ void cmask(f32x16&p0,f32x16&p1,int jb,int qrel,int hi){
  const float NEG=-INFINITY; int kb=64*jb+4*hi;
  #pragma unroll
  for(int r=0;r<16;++r){int kv=kb+(r&3)+8*(r>>2); if(kv>qrel)p0[r]=NEG; if(kv+32>qrel)p1[r]=NEG;}
}

constexpr int NSLOT=3, SLOTB=8192, VSLOTB=16384;
constexpr int LDS_K=0, LDS_V=NSLOT*SLOTB, LDS_WS=LDS_V+NSLOT*VSLOTB, LDS_OST=LDS_WS+NW*64*4, LDS_BYTES=LDS_OST+NW*4096;
constexpr float C2=0.125f*1.4426950408889634f;
__device__ __forceinline__ void glds16(const void*gsrc,unsigned lds_dst){unsigned keep;
  asm volatile("s_mov_b32 %0, m0\n\ts_mov_b32 m0, %2\n\ts_nop 0\n\tglobal_load_lds_dwordx4 %1, off\n\ts_mov_b32 m0, %0":"=&s"(keep):"v"(gsrc),"s"(lds_dst):"memory");}
__device__ __forceinline__ float max3f(float a,float b,float c){float r;asm("v_max3_f32 %0, %1, %2, %3":"=v"(r):"v"(a),"v"(b),"v"(c));return r;}
__device__ __forceinline__ float max2f(float a,float b){float r;asm("v_max_f32_e32 %0, %1, %2":"=v"(r):"v"(a),"v"(b));return r;}
__device__ __forceinline__ float fadd_s(float a,float b){float r;asm("v_add_f32_e32 %0, %1, %2":"=v"(r):"v"(a),"v"(b));return r;}
__device__ __forceinline__ float fsub_s(float a,float b){float r;asm("v_sub_f32_e32 %0, %1, %2":"=v"(r):"v"(a),"v"(b));return r;}
typedef float f32x2_t __attribute__((ext_vector_type(2))); typedef __bf16 bf16x2_t __attribute__((ext_vector_type(2)));
__device__ __forceinline__ unsigned cvtpk_s(float lo,float hi){f32x2_t v={lo,hi};bf16x2_t b=__builtin_convertvector(v,bf16x2_t);return __builtin_bit_cast(unsigned,b);}
#define WAIT_BAR(N) asm volatile("s_waitcnt vmcnt(" #N ") lgkmcnt(0)\n\ts_barrier":::"memory")

__device__ __forceinline__ void qkt(f32x16&p0,f32x16&p1,const char*Kslot,const bf16x8*qr,const f32x16&negm,int r32,int hi){
  const char*kb=Kslot+hi*1024+r32*16;
  #pragma unroll
  for(int d0=0;d0<4;++d0){
    const bf16x8 b0=*reinterpret_cast<const bf16x8*>(kb+d0*2048);
    const bf16x8 b1=*reinterpret_cast<const bf16x8*>(kb+d0*2048+512);
    if(d0==0){p0=__builtin_amdgcn_mfma_f32_32x32x16_bf16(b0,qr[0],negm,0,0,0);p1=__builtin_amdgcn_mfma_f32_32x32x16_bf16(b1,qr[0],negm,0,0,0);}
    else{p0=__builtin_amdgcn_mfma_f32_32x32x16_bf16(b0,qr[d0],p0,0,0,0);p1=__builtin_amdgcn_mfma_f32_32x32x16_bf16(b1,qr[d0],p1,0,0,0);}}
}
typedef __attribute__((address_space(3))) const char* lds_cptr;
typedef short v4i16_t __attribute__((ext_vector_type(4)));
__device__ __forceinline__ void kload8(bf16x8*kf,lds_cptr kp){
  kf[0]=*(const __attribute__((address_space(3))) bf16x8*)(kp);      kf[1]=*(const __attribute__((address_space(3))) bf16x8*)(kp+512);
  kf[2]=*(const __attribute__((address_space(3))) bf16x8*)(kp+2048); kf[3]=*(const __attribute__((address_space(3))) bf16x8*)(kp+2560);
  kf[4]=*(const __attribute__((address_space(3))) bf16x8*)(kp+4096); kf[5]=*(const __attribute__((address_space(3))) bf16x8*)(kp+4608);
  kf[6]=*(const __attribute__((address_space(3))) bf16x8*)(kp+6144); kf[7]=*(const __attribute__((address_space(3))) bf16x8*)(kp+6656);
}
__device__ __forceinline__ void kload2(bf16x8*kf,lds_cptr kp,int j){ kf[2*j]=*(const __attribute__((address_space(3))) bf16x8*)(kp+j*2048); kf[2*j+1]=*(const __attribute__((address_space(3))) bf16x8*)(kp+j*2048+512); }
__device__ __forceinline__ s16x4 vtr(lds_cptr p){ return __builtin_bit_cast(s16x4,__builtin_amdgcn_ds_read_tr16_b64_v4i16((__attribute__((address_space(3))) v4i16_t*)p)); }
__device__ __forceinline__ float rowmax(const f32x16&p0,const f32x16&p1){
  float a=max3f(p0[0],p0[1],p1[0]),b=max3f(p0[2],p0[3],p1[1]);a=max3f(a,p1[2],p1[3]);
  #pragma unroll
  for(int r=4;r<16;r+=4){a=max3f(a,p0[r],p0[r+1]);b=max3f(b,p0[r+2],p0[r+3]);a=max3f(a,p1[r],p1[r+1]);b=max3f(b,p1[r+2],p1[r+3]);}
  const float m=max2f(a,b);
  auto rr=__builtin_amdgcn_permlane32_swap(__float_as_uint(m),__float_as_uint(m),false,false);
  return max2f(__uint_as_float(rr[0]),__uint_as_float(rr[1]));
}
__device__ __forceinline__ void pv(f32x16*o,int vb,bf16x8 pa0,bf16x8 pa1,bf16x8 pa2,bf16x8 pa3){
  #pragma unroll
  for(int d0=0;d0<4;++d0){s16x4 lo[4],hi[4];
    #pragma unroll
    for(int ks=0;ks<4;++ks){
      asm volatile("ds_read_b64_tr_b16 %0,%1 offset:%c2":"=&v"(lo[ks]):"v"(vb),"i"(d0*4096+ks*1024):"memory");
      asm volatile("ds_read_b64_tr_b16 %0,%1 offset:%c2":"=&v"(hi[ks]):"v"(vb),"i"(d0*4096+ks*1024+512):"memory");}
    asm volatile("s_waitcnt lgkmcnt(0)":::"memory");SBAR();
    #define PK(k) (bf16x8){lo[k][0],lo[k][1],lo[k][2],lo[k][3],hi[k][0],hi[k][1],hi[k][2],hi[k][3]}
    o[d0]=__builtin_amdgcn_mfma_f32_32x32x16_bf16(pa0,PK(0),o[d0],0,0,0);
    o[d0]=__builtin_amdgcn_mfma_f32_32x32x16_bf16(pa1,PK(1),o[d0],0,0,0);
    o[d0]=__builtin_amdgcn_mfma_f32_32x32x16_bf16(pa2,PK(2),o[d0],0,0,0);
    o[d0]=__builtin_amdgcn_mfma_f32_32x32x16_bf16(pa3,PK(3),o[d0],0,0,0);
    #undef PK
  }
}

#ifndef ATTN_STORE16
#define ATTN_STORE16(p,v) (*(u32x4*)(p)=(v))
#endif
template<int THRL> __device__ __forceinline__ void attn_unit(int b,int h,int hv,int qb,const bf16*Q,const bf16*__restrict__ K,const bf16*__restrict__ V,bf16*O,char*shm,const int wave_id){
  int tid_=wave_id*64+(int)__builtin_amdgcn_mbcnt_hi(~0u,__builtin_amdgcn_mbcnt_lo(~0u,0u)); asm volatile("":"+v"(tid_)); const int tid=tid_,lane=tid&63,r32=lane&31,hi=lane>>5; const int wid=__builtin_amdgcn_readfirstlane(tid>>6);
  const long rowbase=(long)b*SEQ; const int q0=qb*QB;
  const bf16*Qw=Q+(rowbase+q0+wid*QBLK)*DM+h*D;
  const bf16*Kh=K+rowbase*DM+h*D,*Vh=V+rowbase*DM+hv*128;
  const unsigned lds0=(unsigned)(uintptr_t)shm;
  float*wsf=(float*)(shm+LDS_WS)+wid*64;
  const bf16*ksrc=Kh+(long)lane*DM+wid*8;
  const bf16*vsrc=Vh+(long)(16*(wid&3)+(lane>>2))*DM+(wid>>2)*32+(lane&3)*8;
  const unsigned kdst=lds0+LDS_K+wid*1024, vdst=lds0+LDS_V+wid*1024;
  #define DMA_K(t,slot) glds16(ksrc+(long)(t)*KVBLK*DM,(unsigned)__builtin_amdgcn_readfirstlane(kdst+(slot)))
  #define DMA_V(t,slot) do{ glds16(vsrc+(long)(t)*KVBLK*DM,(unsigned)__builtin_amdgcn_readfirstlane(vdst+2*(slot))); glds16(vsrc+64+(long)(t)*KVBLK*DM,(unsigned)__builtin_amdgcn_readfirstlane(vdst+2*(slot)+8192)); }while(0)
  const int vb0=(int)(lds0+LDS_V)+((lane>>4)&1)*32+(lane&3)*8+(4*hi+((lane&15)>>2))*64;
  const char*Kbase=shm+LDS_K; bf16x8 kf[8];
  const lds_cptr shm3=(lds_cptr)shm; const lds_cptr kp0=shm3+LDS_K+hi*1024+r32*16; const lds_cptr vp0=shm3+LDS_V+((lane>>4)&1)*32+(lane&3)*8+(4*hi+((lane&15)>>2))*64;
  const int NT=(q0+QB)/KVBLK;
  DMA_K(0,0);DMA_V(0,0);DMA_K(1,SLOTB);
  bf16x8 qr[4];
  #pragma unroll
  for(int d0=0;d0<4;++d0)qr[d0]=*reinterpret_cast<const bf16x8*>(&Qw[(long)r32*DM+d0*16+hi*8]);
  float mhat=0.f,l_reg=0.f;f32x16 o[4];o[0]=f32x16{};o[1]=f32x16{};o[2]=f32x16{};o[3]=f32x16{};const f32x16 zz=f32x16{};
  #define CMASK(P0,P1,t) do{int jb_=(t)-(NT-4); if(jb_>=0){ FRESH_HI(hi_,r32_) cmask(P0,P1,jb_,wid*QBLK+r32_,hi_);} }while(0)
  bool resc=false;
  #define START(P0,P1) do{ const float rm=rowmax(P0,P1); resc=false; \
    { const float dl=rm; mhat=fadd_s(mhat,dl); \
      _Pragma("unroll") for(int r=0;r<16;++r){P0[r]=fsub_s(P0[r],dl);P1[r]=fsub_s(P1[r],dl);} \
      } \
    _Pragma("unroll") for(int r=0;r<16;++r)P0[r]=__builtin_amdgcn_exp2f(P0[r]); }while(0)
  #define FRESH_HI(hi_,r32_) int ln__=(int)__builtin_amdgcn_mbcnt_hi(~0u,__builtin_amdgcn_mbcnt_lo(~0u,0u)); asm volatile("":"+v"(ln__)); const int hi_=ln__>>5,r32_=ln__&31; (void)hi_; (void)r32_;
  #define RESC() do{ if(resc){ FRESH_HI(hi_,r32_) asm volatile("s_waitcnt lgkmcnt(0)":::"memory"); \
      _Pragma("unroll") for(int d_=0;d_<4;++d_) _Pragma("unroll") for(int r=0;r<16;++r)o[d_][r]*=wsf[crow(r,hi_)]; } }while(0)
  f32x16 pA0,pA1,pB0,pB1;
  int sl_prev=0,sl_cur=0,sl_next=SLOTB;
  #define ROT() do{sl_prev=sl_cur;sl_cur=sl_next;sl_next=(sl_next==(NSLOT-1)*SLOTB)?0:sl_next+SLOTB;}while(0)
  DMA_K(2,2*SLOTB);
  WAIT_BAR(3);
  qkt(pA0,pA1,Kbase,qr,zz,r32,hi);asm volatile("s_nop 15\n\ts_nop 7":"+v"(pA0),"+v"(pA1));CMASK(pA0,pA1,0);
  START(pA0,pA1);
  _Pragma("unroll") for(int r=0;r<16;++r)pA1[r]=__builtin_amdgcn_exp2f(pA1[r]);
  WAIT_BAR(0);
  DMA_K(3,0);DMA_V(1,SLOTB);
  ROT();
  kload8(kf,kp0+sl_cur);
  WAIT_BAR(3);
  s16x4 vlo[8],vhi[8]; u32x4 pw0,pw1,pw2,pw3;
  #define PKW(P,B) cvtpk_s(P[B],P[B+1])
  #define PAF(k) __builtin_bit_cast(bf16x8,pw##k)
  #define VFR(i) (bf16x8){vlo[i][0],vlo[i][1],vlo[i][2],vlo[i][3],vhi[i][0],vhi[i][1],vhi[i][2],vhi[i][3]}
  #define PIN(x) asm volatile("":"+v"(x))
  #define MX3(a,b,c) __builtin_fmaxf(__builtin_fmaxf((a),(b)),(c))
  #define GAPA(MF,A0,A1,A2,A3,W0,W1,PW) do{ MF; sacc+=A0; sacc+=A1; sacc+=A2; sacc+=A3; PIN(sacc); W0; W1; PIN(PW); SBAR(); }while(0)
  #define EX(v) __builtin_amdgcn_exp2f(v)
  #define GAPB(MF,RL,X,B) do{ MF; RL; X[B]=EX(X[B]); X[B+1]=EX(X[B+1]); PIN(X); SBAR(); }while(0)
  #define VRD(i) do{ vlo[(i)&7]=vtr(vp_+(((i)>>2)*4096+((i)&3)*1024)); vhi[(i)&7]=vtr(vp_+(((i)>>2)*4096+((i)&3)*1024+512)); }while(0)
  #define KRD(G,j) do{ if(G){ kload2(kf,kp0+sl_next,j); SBAR(); } }while(0)
  #define STEP(C0,C1,P0,P1,t,GK,GV,GL) do{ SBAR(); \
    const lds_cptr vp_=vp0+2*sl_prev; \
    VRD(0); SBAR(); float sacc=(P0[0]+P0[1]); \
    GAPA(C0=__builtin_amdgcn_mfma_f32_32x32x16_bf16(kf[0],qr[0],zz,0,0,0), P0[2],P0[3],P0[4],P0[5],     pw0[0]=PKW(P0,0), pw0[1]=PKW(P0,2), pw0); \
    VRD(4); SBAR(); GAPA(C1=__builtin_amdgcn_mfma_f32_32x32x16_bf16(kf[1],qr[0],zz,0,0,0), P0[6],P0[7],P0[8],P0[9],     pw0[2]=PKW(P0,4), pw0[3]=PKW(P0,6), pw0); \
    VRD(1); SBAR(); GAPA(C0=__builtin_amdgcn_mfma_f32_32x32x16_bf16(kf[2],qr[1],C0,0,0,0),   P0[10],P0[11],P0[12],P0[13], pw1[0]=PKW(P0,8), pw1[1]=PKW(P0,10), pw1); \
    VRD(5); SBAR(); GAPA(C1=__builtin_amdgcn_mfma_f32_32x32x16_bf16(kf[3],qr[1],C1,0,0,0),   P0[14],P0[15],P1[0],P1[1],   pw1[2]=PKW(P0,12),pw1[3]=PKW(P0,14), pw1); \
    VRD(2); SBAR(); GAPA(C0=__builtin_amdgcn_mfma_f32_32x32x16_bf16(kf[4],qr[2],C0,0,0,0),   P1[2],P1[3],P1[4],P1[5],     pw2[0]=PKW(P1,0), pw2[1]=PKW(P1,2), pw2); \
    VRD(6); SBAR(); GAPA(C1=__builtin_amdgcn_mfma_f32_32x32x16_bf16(kf[5],qr[2],C1,0,0,0),   P1[6],P1[7],P1[8],P1[9],     pw2[2]=PKW(P1,4), pw2[3]=PKW(P1,6), pw2); \
    VRD(3); SBAR(); GAPA(C0=__builtin_amdgcn_mfma_f32_32x32x16_bf16(kf[6],qr[3],C0,0,0,0),   P1[10],P1[11],P1[12],P1[13], pw3[0]=PKW(P1,8), pw3[1]=PKW(P1,10), pw3); \
    VRD(7); SBAR(); GAPA(C1=__builtin_amdgcn_mfma_f32_32x32x16_bf16(kf[7],qr[3],C1,0,0,0),   P1[14],P1[15],0.f,0.f,       pw3[2]=PKW(P1,12),pw3[3]=PKW(P1,14), pw3); \
    l_reg+=sacc; \
    _Pragma("unroll") for(int r=0;r<16;++r){C0[r]-=mhat;C1[r]-=mhat;} \
    if(GK){DMA_K((t)+3,sl_cur);} if(GV){DMA_V((t)+1,sl_next);} \
    CMASK(C0,C1,t); \
    { float a=MX3(C0[0],C0[1],C1[0]),b=MX3(C0[2],C0[3],C1[1]); a=MX3(a,C1[2],C1[3]); \
      _Pragma("unroll") for(int r=4;r<16;r+=4){a=MX3(a,C0[r],C0[r+1]);b=MX3(b,C0[r+2],C0[r+3]);a=MX3(a,C1[r],C1[r+1]);b=MX3(b,C1[r+2],C1[r+3]);} \
      float rm=__builtin_fmaxf(a,b); { auto rr=__builtin_amdgcn_permlane32_swap(__float_as_uint(rm),__float_as_uint(rm),false,false); rm=__builtin_fmaxf(__uint_as_float(rr[0]),__uint_as_float(rr[1])); } \
      resc=false; \
      if(__builtin_expect(__any(rm>(float)THRL),0)){ const float dl=__builtin_fmaxf(rm,0.f); mhat+=dl; \
        _Pragma("unroll") for(int r=0;r<16;++r){C0[r]-=dl;C1[r]-=dl;} \
        const float f=__builtin_amdgcn_exp2f(-dl); l_reg*=f; { FRESH_HI(hi_,r32_) if(hi_==0)wsf[r32_]=f; } resc=true; } } \
    SBAR(); \
    GAPB(o[0]=__builtin_amdgcn_mfma_f32_32x32x16_bf16(PAF(0),VFR(0),o[0],0,0,0), VRD(8),  C0,0); \
    GAPB(o[1]=__builtin_amdgcn_mfma_f32_32x32x16_bf16(PAF(0),VFR(4),o[1],0,0,0), VRD(12), C0,2); \
    KRD(GL,0); GAPB(o[0]=__builtin_amdgcn_mfma_f32_32x32x16_bf16(PAF(1),VFR(1),o[0],0,0,0), VRD(9),  C0,4); \
    KRD(GL,1); GAPB(o[1]=__builtin_amdgcn_mfma_f32_32x32x16_bf16(PAF(1),VFR(5),o[1],0,0,0), VRD(13), C0,6); \
    KRD(GL,2); GAPB(o[0]=__builtin_amdgcn_mfma_f32_32x32x16_bf16(PAF(2),VFR(2),o[0],0,0,0), VRD(10), C0,8); \
    KRD(GL,3); GAPB(o[1]=__builtin_amdgcn_mfma_f32_32x32x16_bf16(PAF(2),VFR(6),o[1],0,0,0), VRD(14), C0,10); \
    GAPB(o[0]=__builtin_amdgcn_mfma_f32_32x32x16_bf16(PAF(3),VFR(3),o[0],0,0,0), VRD(11), C0,12); \
    GAPB(o[1]=__builtin_amdgcn_mfma_f32_32x32x16_bf16(PAF(3),VFR(7),o[1],0,0,0), VRD(15), C0,14); \
    GAPB(o[2]=__builtin_amdgcn_mfma_f32_32x32x16_bf16(PAF(0),VFR(0),o[2],0,0,0), (void)0, C1,0); \
    GAPB(o[3]=__builtin_amdgcn_mfma_f32_32x32x16_bf16(PAF(0),VFR(4),o[3],0,0,0), (void)0, C1,2); \
    GAPB(o[2]=__builtin_amdgcn_mfma_f32_32x32x16_bf16(PAF(1),VFR(1),o[2],0,0,0), (void)0, C1,4); \
    GAPB(o[3]=__builtin_amdgcn_mfma_f32_32x32x16_bf16(PAF(1),VFR(5),o[3],0,0,0), (void)0, C1,6); \
    GAPB(o[2]=__builtin_amdgcn_mfma_f32_32x32x16_bf16(PAF(2),VFR(2),o[2],0,0,0), (void)0, C1,8); \
    GAPB(o[3]=__builtin_amdgcn_mfma_f32_32x32x16_bf16(PAF(2),VFR(6),o[3],0,0,0), (void)0, C1,10); \
    GAPB(o[2]=__builtin_amdgcn_mfma_f32_32x32x16_bf16(PAF(3),VFR(3),o[2],0,0,0), (void)0, C1,12); \
    GAPB(o[3]=__builtin_amdgcn_mfma_f32_32x32x16_bf16(PAF(3),VFR(7),o[3],0,0,0), (void)0, C1,14); \
    }while(0)
  int t=1;
  #undef CMASK
  #define CMASK(P0,P1,t) do{}while(0)
  for(;t+5<NT;t+=2){
    STEP(pB0,pB1,pA0,pA1,t,true,true,true);     WAIT_BAR(3); RESC(); ROT();
    STEP(pA0,pA1,pB0,pB1,t+1,true,true,true);   WAIT_BAR(3); RESC(); ROT();
  }
  #undef CMASK
  #define CMASK(P0,P1,t) do{int jb_=(t)-(NT-4); if(jb_>=0){ FRESH_HI(hi_,r32_) cmask(P0,P1,jb_,wid*QBLK+r32_,hi_);} }while(0)
  #define ENDW(tt) do{ if((tt)+3<NT){WAIT_BAR(3);} else if((tt)+2<NT){WAIT_BAR(2);} else {WAIT_BAR(0);} }while(0)
  for(;t+1<NT;t+=2){
    STEP(pB0,pB1,pA0,pA1,t,(t+3<NT),(t+1<NT),(t+1<NT));       ENDW(t);   RESC(); ROT();
    STEP(pA0,pA1,pB0,pB1,t+1,(t+4<NT),(t+2<NT),(t+2<NT));     ENDW(t+1); RESC(); ROT();
  }
  STEP(pB0,pB1,pA0,pA1,NT-1,false,false,false); RESC();
  { float sacc=pB0[0]+pB0[1]; _Pragma("unroll") for(int r=2;r<16;++r)sacc+=pB0[r]; _Pragma("unroll") for(int r=0;r<16;++r)sacc+=pB1[r]; l_reg+=sacc;
    pw0=(u32x4){PKW(pB0,0),PKW(pB0,2),PKW(pB0,4),PKW(pB0,6)};pw1=(u32x4){PKW(pB0,8),PKW(pB0,10),PKW(pB0,12),PKW(pB0,14)};pw2=(u32x4){PKW(pB1,0),PKW(pB1,2),PKW(pB1,4),PKW(pB1,6)};pw3=(u32x4){PKW(pB1,8),PKW(pB1,10),PKW(pB1,12),PKW(pB1,14)};
    SBAR(); pv(o,vb0+2*sl_cur,PAF(0),PAF(1),PAF(2),PAF(3)); }
  #undef PKW
  #undef PAF
  #undef VFR
  #undef PIN
  #undef MX3
  #undef GAPA
  #undef GAPB
  #undef EX
  #undef VRD
  #undef KRD
  #undef STEP
  #undef ENDW
  {auto rr=__builtin_amdgcn_permlane32_swap(__float_as_uint(l_reg),__float_as_uint(l_reg),false,false);l_reg=__uint_as_float(rr[0])+__uint_as_float(rr[1]);}
  FRESH_HI(hie,r32e)
  if(hie==0)wsf[32+r32e]=l_reg;asm volatile("s_waitcnt lgkmcnt(0)":::"memory");
  float rli[16];
  #pragma unroll
  for(int r=0;r<16;++r)rli[r]=__builtin_amdgcn_rcpf(wsf[32+crow(r,hie)]);
  bf16*Ow=O+(rowbase+q0+wid*QBLK)*DM+hv*128;
  { bf16*stg=(bf16*)(shm+LDS_OST)+wid*2048;
    #pragma unroll
    for(int hf=0;hf<2;++hf){
      #pragma unroll
      for(int r=0;r<16;++r){const int orow=crow(r,hie);
        #pragma unroll
        for(int d0=0;d0<2;++d0)stg[orow*64+d0*32+r32e]=__float2bfloat16(o[2*hf+d0][r]*rli[r]);}
      asm volatile("s_waitcnt lgkmcnt(0)":::"memory");
      #pragma unroll
      for(int i=0;i<4;++i){const int row=i*8+(ln__>>3),ch=ln__&7; const u32x4 v=*(const u32x4*)(stg+row*64+ch*8); ATTN_STORE16(Ow+(long)row*DM+hf*64+ch*8,v);}
      asm volatile("s_waitcnt lgkmcnt(0)":::"memory"); } }
  asm volatile("s_waitcnt lgkmcnt(0)\n\ts_barrier":::"memory");
  #undef DMA_K
  #undef DMA_V
  #undef CMASK
  #undef START
  #undef RESC
  #undef FRESH_HI
  #undef ROT
}
constexpr int ATTN_LDS_BYTES=LDS_BYTES;
struct AttnTensors { const bf16* Q; const bf16* K; const bf16* V; bf16* O1; bf16* O2; };
struct AttnUnit { int bh; int qb; };
struct StaticOrder {
  int vcu;
  __device__ __forceinline__ explicit StaticOrder(int grid,int block):vcu((block%8)*(grid/8)+block/8){}
  __device__ __forceinline__ bool next(int i,AttnUnit&u)const{ if(i>=4)return false; const int s=vcu&7; u.bh=vcu>>3; u.qb=(i==0)?s:(i==1)?15-s:(i==2)?16+s:31-s; return true; }
  __device__ __forceinline__ void a_ready(const AttnUnit&)const{}
  __device__ __forceinline__ void done(const AttnUnit&)const{}
};
template<class Sched,int THRL=8> __device__ __forceinline__ void attn_phase(char*lds,const AttnTensors&T,const Sched&S,const int wave_id){
  AttnUnit u;
  for(int i=0;S.next(i,u);++i){ S.a_ready(u); const int b=u.bh>>4,hq=u.bh&15; attn_unit<THRL>(b,hq,hq>>1,u.qb,T.Q,T.K,T.V,(hq&1)?T.O2:T.O1,lds,wave_id); S.done(u); }
}
#undef SBAR
#undef WAIT_BAR
}
#define GAS __attribute__((address_space(1)))
#define LAS __attribute__((address_space(3)))
typedef unsigned short bf16;
typedef unsigned v4u __attribute__((ext_vector_type(4)));
typedef float f32x4 __attribute__((ext_vector_type(4)));
typedef short bf16x8 __attribute__((ext_vector_type(8)));
typedef GAS unsigned gu32;
typedef GAS unsigned long long gu64;
#define RLX_AGENT __ATOMIC_RELAXED, __HIP_MEMORY_SCOPE_AGENT
#define LDS_WAIT() asm volatile("s_waitcnt lgkmcnt(0)" ::: "memory")
#define VM_WAIT() asm volatile("s_waitcnt vmcnt(0)" ::: "memory")
__device__ __forceinline__ unsigned long long rt() { return __builtin_amdgcn_s_memrealtime(); }
typedef float f32x2_hw __attribute__((ext_vector_type(2))); typedef __bf16 bf16x2_hw __attribute__((ext_vector_type(2)));
__device__ __forceinline__ unsigned pk2(float lo, float hi) { const f32x2_hw v = {lo, hi}; const bf16x2_hw b = __builtin_convertvector(v, bf16x2_hw); return __builtin_bit_cast(unsigned, b); }
__device__ __forceinline__ unsigned f2bf(float f) { return pk2(f, 0.f) & 0xffffu; }
__device__ __forceinline__ void st16g(void* p, v4u v) { asm volatile("global_store_dwordx4 %0, %1, off sc1\n\ts_nop 1" :: "v"(p), "v"(v) : "memory"); }
__device__ __forceinline__ void st8g(void* p, unsigned long long v) { asm volatile("global_store_dwordx2 %0, %1, off sc1\n\ts_nop 1" :: "v"(p), "v"(v) : "memory"); }

#define XB_TMO      128
#define XB_XCNT(j)  (256  + 64 * (j))
#define XB_XSUB(j)  (1280 + 64 * (j))
#define XB_XGEN(j)  (2304 + 64 * (j))
#define XB_TOP      3328
#define XB_TOPGEN   3392
#define XCD_BAR_WORDS 3456
#define XB_SPIN_CAP (1u << 18)

__device__ __forceinline__ unsigned xb_ld(unsigned* p)              { return __hip_atomic_load(p, __ATOMIC_RELAXED, __HIP_MEMORY_SCOPE_AGENT); }
__device__ __forceinline__ unsigned xb_add(unsigned* p, unsigned v) { return __hip_atomic_fetch_add(p, v, __ATOMIC_RELAXED, __HIP_MEMORY_SCOPE_AGENT); }
__device__ __forceinline__ unsigned xb_xcc_id() { return (unsigned)__builtin_amdgcn_s_getreg((3 << 11) | 20) & 0xFu; }
#define XB_SPIN(cond, bar) do { unsigned _sp = 0; while (cond) { __builtin_amdgcn_s_sleep(1); \
    if ((++_sp & 255u) == 0u) { if (xb_ld(&(bar)[XB_TMO])) break; if (_sp > XB_SPIN_CAP) { atomicAdd(&(bar)[XB_TMO], 1u); break; } } } } while (0)

struct XcdBarrier {
    unsigned* bar; unsigned x;
    volatile LAS unsigned* st;
};

__device__ __forceinline__ XcdBarrier xcd_barrier_post(unsigned* bar, volatile LAS unsigned* st, const int wave_id) {
    XcdBarrier b; b.bar = bar; b.x = xb_xcc_id(); b.st = st;
    if (wave_id == 0 && __builtin_amdgcn_mbcnt_hi(~0u, __builtin_amdgcn_mbcnt_lo(~0u, 0u)) == 0u) (void)xb_add(&bar[XB_XCNT(b.x)], 1u);
    return b;
}
__device__ __forceinline__ void xcd_barrier_complete(unsigned* bar, unsigned x, unsigned& nloc, unsigned& nx) {
    const unsigned G = gridDim.x * gridDim.y * gridDim.z;
    unsigned sum, cnt, mine, sp = 0u;
    for (;;) {
        sum = 0u; cnt = 0u; mine = 0u;
#pragma unroll
        for (unsigned j = 0; j < 16; ++j) { const unsigned c = xb_ld(&bar[XB_XCNT(j)]); sum += c; cnt += (c > 0u) ? 1u : 0u; mine = (j == x) ? c : mine; }
        if (sum == G) break;
        __builtin_amdgcn_s_sleep(1);
        if ((++sp & 255u) == 0u) { if (xb_ld(&bar[XB_TMO])) break; if (sp > XB_SPIN_CAP) { atomicAdd(&bar[XB_TMO], 1u); break; } }
    }
    nloc = mine > 0u ? mine : 1u; nx = cnt > 0u ? cnt : 1u;
}

__device__ __forceinline__ void xcd_barrier(const XcdBarrier& b, const int wave_id) {
    asm volatile("s_waitcnt vmcnt(0)" ::: "memory");
    __syncthreads();
    if (wave_id == 0 && __builtin_amdgcn_mbcnt_hi(~0u, __builtin_amdgcn_mbcnt_lo(~0u, 0u)) == 0u) {
        unsigned* bar = b.bar;
        __builtin_amdgcn_s_waitcnt(0);
        unsigned nloc = b.st[0], nx = b.st[1];
        if (nloc == 0u) { xcd_barrier_complete(bar, b.x, nloc, nx); b.st[0] = nloc; b.st[1] = nx; }
        const unsigned old = xb_add(&bar[XB_XSUB(b.x)], 1u);
        const unsigned gen = old / nloc;
        if (old + 1u == (gen + 1u) * nloc) {
            __builtin_amdgcn_fence(__ATOMIC_RELEASE, "agent");
            asm volatile("s_waitcnt vmcnt(0)" ::: "memory");
            const unsigned og = xb_add(&bar[XB_TOP], 1u);
            const unsigned tg = og / nx;
            if (og + 1u == (tg + 1u) * nx) xb_add(&bar[XB_TOPGEN], 1u);
            else XB_SPIN(xb_ld(&bar[XB_TOPGEN]) == tg, bar);
            __builtin_amdgcn_fence(__ATOMIC_ACQUIRE, "agent");
            xb_add(&bar[XB_XGEN(b.x)], 1u);
            asm volatile("s_waitcnt vmcnt(0)" ::: "memory");
        } else {
            XB_SPIN(xb_ld(&bar[XB_XGEN(b.x)]) == gen, bar);
            __builtin_amdgcn_fence(__ATOMIC_ACQUIRE, "agent");
            asm volatile("s_waitcnt vmcnt(0)" ::: "memory");
        }
    }
    __syncthreads();
}
constexpr int NWAVES = 8;
constexpr int T = 8192, D = 1024, M = 16384;
constexpr int NINP = 4096;
constexpr int NEXP = 32, NROWS2 = 40960, NTILE2 = NROWS2 / 256;
constexpr float LN_EPS = 1e-5f, RMS_EPS = 1e-6f, ALPHA = 1.6817928305074292f;
constexpr float QSCALE = 0.125f * 1.4426950408889634f;

constexpr size_t al256(size_t x) { return (x + 255) & ~(size_t)255; }
constexpr size_t WS_CTL = 0, CTL_ZERO_BYTES = 1u << 20;
constexpr size_t WS_WIN = WS_CTL + CTL_ZERO_BYTES;
constexpr size_t WS_WAOUT = WS_WIN + (size_t)2 * NINP * D * 2;
constexpr size_t WS_WQKV = WS_WAOUT + (size_t)2 * D * D * 2;
constexpr size_t WS_WQ3 = WS_WQKV + (size_t)3 * D * D * 2;
constexpr size_t WS_WBOUT = WS_WQ3 + (size_t)D * D * 2;
constexpr size_t WS_WR = WS_WBOUT + (size_t)2 * D * D * 2;
constexpr size_t WS_WG = WS_WR + (size_t)4 * 48 * D * 2;
constexpr size_t WS_W13 = WS_WG + (size_t)2 * 16 * D * 2;
constexpr size_t WS_W2 = WS_W13 + (size_t)4 * 32 * 1024 * 1024 * 2;
constexpr size_t WS_H = WS_W2 + (size_t)4 * 32 * 1024 * 512 * 2;
constexpr size_t WS_HB = WS_H + (size_t)M * D * 4;
constexpr size_t WS_H1 = WS_HB + (size_t)M * D * 2;
constexpr size_t WS_H1B = WS_H1 + (size_t)M * D * 4;
constexpr size_t WS_PROJ = WS_H1B + (size_t)M * D * 2;
constexpr size_t WS_KB = WS_PROJ + (size_t)M * NINP * 2;
constexpr size_t WS_VB = WS_KB + (size_t)M * D * 2;
constexpr size_t WS_ON = WS_VB + (size_t)M * D * 2;
constexpr size_t WS_MIX = WS_ON + (size_t)M * D * 2;
constexpr size_t WS_EID = WS_MIX + (size_t)M * D * 4;
constexpr size_t WS_GATE = WS_EID + (size_t)2 * M * 4;
constexpr size_t WS_APOS = WS_GATE + (size_t)2 * M * 4;
constexpr size_t WS_XROWS = WS_APOS + (size_t)2 * M * 4;
constexpr size_t WS_HID = WS_XROWS + (size_t)NROWS2 * 1024 * 2;
constexpr size_t WS_YROWS = WS_HID + (size_t)NROWS2 * 512 * 2;
constexpr size_t WS_FAST_END = WS_YROWS + (size_t)NROWS2 * 1024 * 2;
constexpr int CW_BAR = 4096;
constexpr int CW_CNT = 16384, CSTR = 64;
constexpr int LDS_BYTES = 147456, RING_BYTES = 131072, LDSCTL_OFF = RING_BYTES, MISC_OFF = LDSCTL_OFF + 320, TILEE_OFF = MISC_OFF + 128;
constexpr int PREP_SC_OFF = TILEE_OFF + 4 * NTILE2 + 64;
constexpr int STAMP_OFF = PREP_SC_OFF + 8 * 768;
constexpr int SCAN_O_OFF = (STAMP_OFF + 48 * 8 + 15) & ~15;
static_assert(SCAN_O_OFF + 4 * 2048 <= LDS_BYTES, "LDS map");

#define PHASE_IDS int tid_o_ = F.wave * 64 + (int)__builtin_amdgcn_mbcnt_hi(~0u, __builtin_amdgcn_mbcnt_lo(~0u, 0u)); asm volatile("" : "+v"(tid_o_)); const int tid = tid_o_, lane = tid & 63; (void)tid; (void)lane;
struct Frame {
    LAS unsigned char* lds; volatile LAS unsigned* MISC; gu32* ctl;
    int wave, vcu, G;
    unsigned char* ws;
};
struct Args { const float* in[20]; float* out; unsigned char* ws; int ph_lo, ph_hi, bar_region, pad; float lam_init[2]; };

__device__ __forceinline__ float wave_sum(float v) {
#pragma unroll
    for (int o = 1; o < 64; o <<= 1) v += __shfl_xor(v, o);
    return v;
}
__device__ __forceinline__ void p0_item_load(f32x4 (&x)[8], const float* W, int ldw, int nvalid, int k0, int n0, int lane) {
    const int c4 = lane & 7, kr = lane >> 3; const bool ok = (n0 + 4 * c4) < nvalid;
#pragma unroll
    for (int i = 0; i < 8; ++i) x[i] = ok ? *(const GAS f32x4*)(W + (size_t)(k0 + kr + 8 * i) * ldw + n0 + 4 * c4) : (f32x4){0.f, 0.f, 0.f, 0.f};
}
__device__ __forceinline__ void p0_item_store(const f32x4 (&x)[8], bf16* WT, int ldt, int drow0, int k0, LAS float* scr, int lane) {
    const int c4 = lane & 7, kr = lane >> 3;
#pragma unroll
    for (int i = 0; i < 8; ++i) *(LAS f32x4*)(scr + (kr + 8 * i) * 36 + ((4 * c4 + 4 * i) & 31)) = x[i];
    LDS_WAIT(); asm volatile("" ::: "memory");
    const int c = lane & 7;
#pragma unroll
    for (int j = 0; j < 4; ++j) { const int n = (lane >> 3) + 8 * j; const LAS float* sp = scr + (8 * c) * 36 + ((n + 4 * c) & 31);
        v4u o; o.x = pk2(sp[0 * 36], sp[1 * 36]); o.y = pk2(sp[2 * 36], sp[3 * 36]); o.z = pk2(sp[4 * 36], sp[5 * 36]); o.w = pk2(sp[6 * 36], sp[7 * 36]);
        *(GAS v4u*)(WT + (size_t)(drow0 + n) * ldt + k0 + 8 * c) = o; }
    LDS_WAIT(); asm volatile("" ::: "memory");
}
__device__ __forceinline__ void p0_transpose_item(const float* W, int ldw, int nvalid, bf16* WT, int ldt, int drow0, int k0, int n0, LAS float* scr, int lane) {
    f32x4 x[8]; p0_item_load(x, W, ldw, nvalid, k0, n0, lane); p0_item_store(x, WT, ldt, drow0, k0, scr, lane);
}
__device__ __forceinline__ bool p0_job(int& r, const float* W, int K, int N, int ldw, int nblk, bf16* WT, int drow_base, bool w13perm, LAS float* scr, int lane) {
    const int items = (K / 64) * nblk;
    if (r >= items) { r -= items; return false; }
    const int kb = r / nblk, nb = r % nblk, n0 = nb * 32;
    int drow0 = drow_base + n0;
    if (w13perm) drow0 = drow_base + ((n0 & 511) >> 7) * 256 + (n0 >> 9) * 128 + (n0 & 127);
    p0_transpose_item(W, ldw, N, WT, K, drow0, kb * 64, n0, scr, lane);
    return true;
}
__device__ __forceinline__ void p0_prologue(Frame& F, const Args& a) {
    PHASE_IDS
    LAS float* scr = (LAS float*)(F.lds + F.wave * 16384);
    const int gw = F.vcu * NWAVES + F.wave, NGW = F.G * NWAVES;
    bf16* win = (bf16*)(F.ws + WS_WIN); bf16* waout = (bf16*)(F.ws + WS_WAOUT); bf16* wqkv = (bf16*)(F.ws + WS_WQKV); bf16* wq3 = (bf16*)(F.ws + WS_WQ3);
    bf16* wbout = (bf16*)(F.ws + WS_WBOUT); bf16* wr = (bf16*)(F.ws + WS_WR);
    constexpr int I_IN = 16 * 128, I_SQ = 16 * 32, I_KV = 16 * 64;
    constexpr int NSMALL = 2 * I_IN + 2 * I_SQ + I_KV + 2 * I_SQ + 2 * I_SQ;
    for (int it = gw; it < NSMALL; it += NGW) {
        int r = it;
        bool done = false;
        for (int l = 0; l < 2 && !done; ++l) done = p0_job(r, a.in[1] + (size_t)l * D * 4112, D, 4096, 4112, 128, win + (size_t)l * NINP * D, 0, false, scr, lane);
        for (int l = 0; l < 2 && !done; ++l) done = p0_job(r, a.in[6] + (size_t)l * D * D, D, D, D, 32, waout + (size_t)l * D * D, 0, false, scr, lane);
        if (!done) done = p0_job(r, a.in[7], D, 2048, 2048, 64, wqkv, 1024, false, scr, lane);
        if (!done) done = p0_job(r, a.in[8], D, D, D, 32, wqkv, 0, false, scr, lane);
        if (!done) done = p0_job(r, a.in[8] + (size_t)D * D, D, D, D, 32, wq3, 0, false, scr, lane);
        for (int l = 0; l < 2 && !done; ++l) done = p0_job(r, a.in[11] + (size_t)l * D * D, D, D, D, 32, wbout + (size_t)l * D * D, 0, false, scr, lane);
    }
    { const int gt = (F.vcu * NWAVES + F.wave) * 64 + lane, NT = F.G * NWAVES * 64;
      { bf16* wgt = (bf16*)(F.ws + WS_WG); for (int i = gt; i < 2 * 16 * D; i += NT) { const int l = i / (16 * D), n = (i / D) % 16, k = i % D; wgt[i] = (bf16)f2bf(a.in[1][((size_t)l * D + k) * 4112 + 4096 + n]); } }
      for (int i = gt; i < 4 * 48 * D; i += NT) { const int l = i / (48 * D), n = (i / D) % 48, k = i % D;
          const float v = n < 4 ? a.in[16][((size_t)l * D + k) * 4 + n] : (n < 36 ? a.in[17][((size_t)l * D + k) * 32 + (n - 4)] : 0.f); wr[i] = (bf16)f2bf(v); }
      bf16* hb = (bf16*)(F.ws + WS_HB); const float* x = a.in[0];
      for (int i = gt; i < M * D / 8; i += NT) { const f32x4 p = *(const GAS f32x4*)(x + (size_t)i * 8), q = *(const GAS f32x4*)(x + (size_t)i * 8 + 4);
          *(GAS v4u*)(hb + (size_t)i * 8) = (v4u){pk2(p.x, p.y), pk2(p.z, p.w), pk2(q.x, q.y), pk2(q.z, q.w)}; } }
}

struct MoeItem { const float* W; bf16* WT; int K, drow0, k0, n0; };
__device__ __forceinline__ MoeItem moe_item(const Args& a, unsigned char* ws, int l0, int r) {
    constexpr int I_W13 = 16 * 32, I_W2 = 8 * 32; MoeItem m;
    if (r < 64 * I_W13) { const int mat = l0 * 32 + r / I_W13; r = r % I_W13; const int kb = r / 32, n0 = (r % 32) * 32;
        m.W = a.in[18] + (size_t)mat * 1024 * 1024; m.WT = (bf16*)(ws + WS_W13) + (size_t)mat * 1024 * 1024; m.K = 1024; m.k0 = kb * 64; m.n0 = n0; m.drow0 = ((n0 & 511) >> 7) * 256 + (n0 >> 9) * 128 + (n0 & 127); }
    else { r -= 64 * I_W13; const int mat = l0 * 32 + r / I_W2; r = r % I_W2; const int kb = r / 32, n0 = (r % 32) * 32;
        m.W = a.in[19] + (size_t)mat * 512 * 1024; m.WT = (bf16*)(ws + WS_W2) + (size_t)mat * 1024 * 512; m.K = 512; m.k0 = kb * 64; m.n0 = n0; m.drow0 = n0; }
    return m;
}
__device__ __forceinline__ void p0_moe_weights(Frame& F, const Args& a, int l0, int wg_idx, int nwg) {
    PHASE_IDS
    LAS float* scr = (LAS float*)(F.lds + F.wave * 16384);
    constexpr int NIT = 64 * (16 * 32 + 8 * 32);
    const int gw = wg_idx * NWAVES + F.wave, NGW = nwg * NWAVES;
    f32x4 xa[8], xb[8];
    int it = gw;
    if (it >= NIT) return;
    MoeItem ma = moe_item(a, F.ws, l0, it), mb = ma;
    p0_item_load(xa, ma.W, 1024, 1024, ma.k0, ma.n0, lane);
    for (;;) {
        const bool hb_ = (it + NGW) < NIT;
        if (hb_) { mb = moe_item(a, F.ws, l0, it + NGW); p0_item_load(xb, mb.W, 1024, 1024, mb.k0, mb.n0, lane); }
        p0_item_store(xa, ma.WT, ma.K, ma.drow0, ma.k0, scr, lane);
        if (!hb_) break;
        it += NGW;
        const bool ha_ = (it + NGW) < NIT;
        if (ha_) { ma = moe_item(a, F.ws, l0, it + NGW); p0_item_load(xa, ma.W, 1024, 1024, ma.k0, ma.n0, lane); }
        p0_item_store(xb, mb.WT, mb.K, mb.drow0, mb.k0, scr, lane);
        if (!ha_) break;
        it += NGW;
    }
}

__device__ __forceinline__ f32x4 bf4_to_f32(unsigned long long a) { f32x4 y; y.x = __uint_as_float(((unsigned)a) << 16); y.y = __uint_as_float(((unsigned)a) & 0xffff0000u); y.z = __uint_as_float(((unsigned)(a >> 32)) << 16); y.w = __uint_as_float(((unsigned)(a >> 32)) & 0xffff0000u); return y; }
__device__ __forceinline__ void ln_rows8(Frame& F, const int lane, const float* hin_f32, const bf16* hin_b, const bf16* mixb, const float* g, const float* b, bf16* h1b, int row0) {
#pragma unroll 4
    for (int rr = 0; rr < 8; ++rr) {
        const int row = row0 + rr;
        const GAS unsigned long long* mr = (const GAS unsigned long long*)(mixb + (size_t)row * D) + lane;
        f32x4 v[4]; float s = 0.f;
        if (hin_f32) { const GAS f32x4* hr = (const GAS f32x4*)(hin_f32 + (size_t)row * D) + lane;
#pragma unroll
            for (int j = 0; j < 4; ++j) v[j] = hr[64 * j] * ALPHA + bf4_to_f32(mr[64 * j]); }
        else { const GAS unsigned long long* hr = (const GAS unsigned long long*)(hin_b + (size_t)row * D) + lane;
#pragma unroll
            for (int j = 0; j < 4; ++j) v[j] = bf4_to_f32(hr[64 * j]) * ALPHA + bf4_to_f32(mr[64 * j]); }
#pragma unroll
        for (int j = 0; j < 4; ++j) s += (v[j].x + v[j].y) + (v[j].z + v[j].w);
        const float mean = wave_sum(s) * (1.f / D); float s2 = 0.f;
#pragma unroll
        for (int j = 0; j < 4; ++j) { v[j] = v[j] - mean; s2 += (v[j].x * v[j].x + v[j].y * v[j].y) + (v[j].z * v[j].z + v[j].w * v[j].w); }
        const float rstd = 1.f / sqrtf(wave_sum(s2) * (1.f / D) + LN_EPS);
        GAS unsigned long long* o8 = (GAS unsigned long long*)(h1b + (size_t)row * D) + lane;
#pragma unroll
        for (int j = 0; j < 4; ++j) { const f32x4 gv = *((const GAS f32x4*)g + lane + 64 * j), bv = *((const GAS f32x4*)b + lane + 64 * j);
            const f32x4 y = v[j] * rstd * gv + bv;
            o8[64 * j] = (unsigned long long)pk2(y.x, y.y) | ((unsigned long long)pk2(y.z, y.w) << 32); }
    }
}
__device__ __forceinline__ void phase_ln1_router(Frame& F, const float* hin_f32, const bf16* hin_b, const bf16* mixb, const float* g, const float* b, bf16* h1b, const bf16* wr,
                                                 int* eid, float* gate, gu32* counts) {
    PHASE_IDS
    LAS float* lg = (LAS float*)(F.lds);
    LAS int* lcnt = (LAS int*)(F.lds + 16384);
    for (int blk = F.vcu; blk < M / 64; blk += F.G) {
        const int row0 = blk * 64;
        if (tid < 32) lcnt[tid] = 0;
        ln_rows8(F, lane, hin_f32, hin_b, mixb, g, b, h1b, row0 + F.wave * 8);
        VM_WAIT(); __syncthreads();
        if (F.wave < 4) {
            const int fr = lane & 15, fq = lane >> 4;
            const bf16* ap = h1b + (size_t)(row0 + F.wave * 16 + fr) * D + fq * 8;
            f32x4 acc[3]; acc[0] = (f32x4){0.f, 0.f, 0.f, 0.f}; acc[1] = acc[0]; acc[2] = acc[0];
#pragma unroll 8
            for (int ks = 0; ks < 32; ++ks) {
                const bf16x8 av = *(const GAS bf16x8*)(ap + ks * 32);
#pragma unroll
                for (int ct = 0; ct < 3; ++ct) { const bf16x8 bv = *(const GAS bf16x8*)(wr + (size_t)(ct * 16 + fr) * D + ks * 32 + fq * 8);
                    acc[ct] = __builtin_amdgcn_mfma_f32_16x16x32_bf16(av, bv, acc[ct], 0, 0, 0); }
            }
#pragma unroll
            for (int ct = 0; ct < 3; ++ct)
#pragma unroll
                for (int r = 0; r < 4; ++r) lg[(F.wave * 16 + 4 * fq + r) * 52 + ct * 16 + fr] = acc[ct][r];
            LDS_WAIT(); asm volatile("" ::: "memory");
            if (lane < 16) {
                const int rl = F.wave * 16 + lane; const LAS float* L = lg + rl * 52;
                int gi = 0; float gm = L[0];
                for (int q = 1; q < 4; ++q) if (L[q] > gm) { gm = L[q]; gi = q; }
                float gs = 0.f; for (int q = 0; q < 4; ++q) gs += __expf(L[q] - gm);
                const float pg = 1.f / gs; const LAS float* el = L + 4 + gi * 8;
                int i0 = 0; float v0 = el[0];
                for (int i = 1; i < 8; ++i) if (el[i] > v0) { v0 = el[i]; i0 = i; }
                int i1 = 0; float v1 = -INFINITY;
                for (int i = 0; i < 8; ++i) if (i != i0 && el[i] > v1) { v1 = el[i]; i1 = i; }
                const float e1 = __expf(v1 - v0); const int tok = row0 + rl, ea = gi * 8 + i0, eb = gi * 8 + i1;
                eid[2 * tok] = ea; eid[2 * tok + 1] = eb; gate[2 * tok] = pg / (1.f + e1); gate[2 * tok + 1] = pg * e1 / (1.f + e1);
                atomicAdd((int*)&lcnt[ea], 1); atomicAdd((int*)&lcnt[eb], 1);
            }
        }
        LDS_WAIT(); __syncthreads();
        if (tid < 32) { const int c = lcnt[tid]; if (c) __hip_atomic_fetch_add(counts + tid * CSTR, (unsigned)c, __ATOMIC_RELAXED, __HIP_MEMORY_SCOPE_AGENT); }
        __syncthreads();
    }
}
__device__ __forceinline__ int moe_layout(Frame& F, const gu32* counts, LAS int* ps, LAS int* tile_e) {
    PHASE_IDS
    if (tid < NEXP) ps[40 + tid] = (int)__hip_atomic_load(counts + tid * CSTR, __ATOMIC_RELAXED, __HIP_MEMORY_SCOPE_AGENT);
    LDS_WAIT(); __syncthreads();
    if (tid == 0) { int acc = 0; for (int e = 0; e < NEXP; ++e) { ps[e] = acc; const int c = ps[40 + e]; const int nt = (c + 255) >> 8;
            for (int t = 0; t < nt; ++t) tile_e[(acc >> 8) + t] = e; acc += nt << 8; } ps[NEXP] = acc; }
    LDS_WAIT(); __syncthreads();
    return __builtin_amdgcn_readfirstlane(ps[NEXP]) >> 8;
}
__device__ __forceinline__ void phase_scatter(Frame& F, const gu32* counts, gu32* cursor, const int* eid, const bf16* h1b, bf16* xrows, int* apos) {
    PHASE_IDS
    LAS int* ps = (LAS int*)(F.lds + 20480); LAS int* tile_e = (LAS int*)(F.lds + TILEE_OFF);
    LAS int* lcnt = (LAS int*)(F.lds + 16384); LAS int* lbase = (LAS int*)(F.lds + 16384 + 256); LAS int* lpos = (LAS int*)(F.lds + 16384 + 512);
    (void)moe_layout(F, counts, ps, tile_e);
    for (int blk = F.vcu; blk < M / 64; blk += F.G) {
        if (tid < 32) lcnt[tid] = 0;
        __syncthreads();
        int e = 0, rk = 0;
        if (tid < 128) { e = eid[blk * 128 + tid]; rk = atomicAdd((int*)&lcnt[e], 1); }
        LDS_WAIT(); __syncthreads();
        if (tid < 32) { const int c = lcnt[tid]; lbase[tid] = c ? (int)__hip_atomic_fetch_add(cursor + tid * CSTR, (unsigned)c, __ATOMIC_RELAXED, __HIP_MEMORY_SCOPE_AGENT) : 0; }
        LDS_WAIT(); __syncthreads();
        if (tid < 128) { const int pos = ps[e] + lbase[e] + rk; lpos[tid] = pos; apos[blk * 128 + tid] = pos; }
        LDS_WAIT(); __syncthreads();
#pragma unroll 8
        for (int a = F.wave; a < 128; a += NWAVES) {
            const int tok = blk * 64 + (a >> 1), pos = lpos[a];
            const GAS v4u* src = (const GAS v4u*)(h1b + (size_t)tok * D) + lane; GAS v4u* dst = (GAS v4u*)(xrows + (size_t)pos * D) + lane;
            const v4u p0 = src[0], p1 = src[64]; dst[0] = p0; dst[64] = p1;
        }
        __syncthreads();
    }
}
__device__ __forceinline__ void phase_combine_ln2(Frame& F, const bf16* h1b, const bf16* yrows, const int* apos, const float* gate, const float* g, const float* b, float* out_f32, bf16* hb) {
    PHASE_IDS
    const int gw = F.vcu * NWAVES + F.wave, NGW = F.G * NWAVES;
#pragma unroll 4
    for (int row = gw; row < M; row += NGW) {
        const int p0 = apos[2 * row], p1 = apos[2 * row + 1]; const float g0 = gate[2 * row], g1 = gate[2 * row + 1];
        const GAS unsigned long long* hr = (const GAS unsigned long long*)(h1b + (size_t)row * D) + lane;
        const GAS unsigned long long* y0 = (const GAS unsigned long long*)(yrows + (size_t)p0 * D) + lane; const GAS unsigned long long* y1 = (const GAS unsigned long long*)(yrows + (size_t)p1 * D) + lane;
        f32x4 v[4]; float s = 0.f;
#pragma unroll
        for (int j = 0; j < 4; ++j) { v[j] = bf4_to_f32(hr[64 * j]) * ALPHA + bf4_to_f32(y0[64 * j]) * g0 + bf4_to_f32(y1[64 * j]) * g1; s += (v[j].x + v[j].y) + (v[j].z + v[j].w); }
        const float mean = wave_sum(s) * (1.f / D); float s2 = 0.f;
#pragma unroll
        for (int j = 0; j < 4; ++j) { v[j] = v[j] - mean; s2 += (v[j].x * v[j].x + v[j].y * v[j].y) + (v[j].z * v[j].z + v[j].w * v[j].w); }
        const float rstd = 1.f / sqrtf(wave_sum(s2) * (1.f / D) + LN_EPS);
#pragma unroll
        for (int j = 0; j < 4; ++j) { const f32x4 gv = *((const GAS f32x4*)g + lane + 64 * j), bv = *((const GAS f32x4*)b + lane + 64 * j);
            const f32x4 y = v[j] * rstd * gv + bv;
            if (out_f32) *((GAS f32x4*)(out_f32 + (size_t)row * D) + lane + 64 * j) = y;
            else *((GAS unsigned long long*)(hb + (size_t)row * D) + lane + 64 * j) = (unsigned long long)pk2(y.x, y.y) | ((unsigned long long)pk2(y.z, y.w) << 32); }
    }
}
__device__ __forceinline__ void phase_attn_combine(Frame& F, const bf16* O1, const bf16* O2, const float* lam_p, const float* subln, float lam_init, bf16* on) {
    PHASE_IDS
    const float l01 = wave_sum(lam_p[lane] * lam_p[64 + lane]), l23 = wave_sum(lam_p[128 + lane] * lam_p[192 + lane]);
    const float lam = __expf(l01) - __expf(l23) + lam_init;
    float sw[16];
#pragma unroll
    for (int i = 0; i < 16; ++i) sw[i] = subln[(lane & 7) * 16 + i] * (1.f - lam_init);
    const int gw = F.vcu * NWAVES + F.wave, NGW = F.G * NWAVES;
    for (int row = gw; row < M; row += NGW) {
        const GAS v4u* p1 = (const GAS v4u*)(O1 + (size_t)row * D) + 2 * lane; const GAS v4u* p2 = (const GAS v4u*)(O2 + (size_t)row * D) + 2 * lane;
        const v4u a0 = p1[0], a1 = p1[1], b0 = p2[0], b1 = p2[1];
        const unsigned aw[8] = {a0.x, a0.y, a0.z, a0.w, a1.x, a1.y, a1.z, a1.w}, bw[8] = {b0.x, b0.y, b0.z, b0.w, b1.x, b1.y, b1.z, b1.w};
        float o[16]; float ss = 0.f;
#pragma unroll
        for (int i = 0; i < 8; ++i) { o[2 * i] = __uint_as_float(aw[i] << 16) - lam * __uint_as_float(bw[i] << 16); o[2 * i + 1] = __uint_as_float(aw[i] & 0xffff0000u) - lam * __uint_as_float(bw[i] & 0xffff0000u);
            ss += o[2 * i] * o[2 * i] + o[2 * i + 1] * o[2 * i + 1]; }
        ss += __shfl_xor(ss, 1); ss += __shfl_xor(ss, 2); ss += __shfl_xor(ss, 4);
        const float r = 1.f / sqrtf(ss * (1.f / 128.f) + RMS_EPS);
        v4u w0, w1;
        w0.x = pk2(o[0] * r * sw[0], o[1] * r * sw[1]); w0.y = pk2(o[2] * r * sw[2], o[3] * r * sw[3]); w0.z = pk2(o[4] * r * sw[4], o[5] * r * sw[5]); w0.w = pk2(o[6] * r * sw[6], o[7] * r * sw[7]);
        w1.x = pk2(o[8] * r * sw[8], o[9] * r * sw[9]); w1.y = pk2(o[10] * r * sw[10], o[11] * r * sw[11]); w1.z = pk2(o[12] * r * sw[12], o[13] * r * sw[13]); w1.w = pk2(o[14] * r * sw[14], o[15] * r * sw[15]);
        GAS v4u* q = (GAS v4u*)(on + (size_t)row * D) + 2 * lane; q[0] = w0; q[1] = w1;
    }
}

typedef short s16x4v __attribute__((ext_vector_type(4)));
typedef short v4i16_t __attribute__((ext_vector_type(4)));
constexpr size_t WS_WNEG = WS_FAST_END;
constexpr size_t WS_QDEC = WS_WNEG + (size_t)2048 * 64 * 128 * 2;
constexpr size_t WS_KDEC = WS_QDEC + (size_t)2048 * 64 * 128 * 2;
constexpr size_t WS_ATT = WS_KDEC + (size_t)2048 * 64 * 128 * 2;
constexpr size_t WS_U = WS_ATT + (size_t)2048 * 64 * 64 * 2;
constexpr size_t WS_GLAST = WS_U + (size_t)2048 * 64 * 128 * 4;
constexpr size_t WS_VBUF = WS_GLAST + 8192;
constexpr size_t WS_SBUF = WS_VBUF + (size_t)2048 * 8 * 2 * 64 * 8 * 2;
constexpr size_t WS_DN_END = WS_SBUF + (size_t)2048 * 8 * 4 * 64 * 8 * 2;

__device__ __forceinline__ float bf2f(unsigned short v) { return __uint_as_float((unsigned)v << 16); }
__device__ __forceinline__ float silu_f(float x) { return x * __builtin_amdgcn_rcpf(1.f + __builtin_amdgcn_exp2f(-1.4426950408889634f * x)); }
__device__ __forceinline__ s16x4v pack4(const f32x4 v) { s16x4v r; const unsigned a = pk2(v[0], v[1]), b = pk2(v[2], v[3]); r[0] = (short)(a & 0xffff); r[1] = (short)(a >> 16); r[2] = (short)(b & 0xffff); r[3] = (short)(b >> 16); return r; }
__device__ __forceinline__ bf16x8 pack8(const f32x4 lo, const f32x4 hi) { const unsigned a = pk2(lo[0], lo[1]), b = pk2(lo[2], lo[3]), c = pk2(hi[0], hi[1]), d = pk2(hi[2], hi[3]); return __builtin_bit_cast(bf16x8, (v4u){a, b, c, d}); }
#define MFMA16(a, b, c) __builtin_amdgcn_mfma_f32_16x16x16bf16_1k((a), (b), (c), 0, 0, 0)
#define MFMA32(a, b, c) __builtin_amdgcn_mfma_f32_16x16x32_bf16((a), (b), (c), 0, 0, 0)

__device__ __forceinline__ void conv8(const bf16* projb, int row, int pos, int col, const float* cw, float (&out)[8]) {
#pragma unroll
    for (int e = 0; e < 8; ++e) out[e] = 0.f;
#pragma unroll
    for (int j = 0; j < 4; ++j) {
        const bool ok = (pos - 3 + j) >= 0;
        v4u x = *(const GAS v4u*)(projb + (size_t)(ok ? row - 3 + j : row) * NINP + col);
        if (!ok) x = (v4u){0u, 0u, 0u, 0u};
        const f32x4 w0 = *(const GAS f32x4*)(cw + j * 3072 + col), w1 = *(const GAS f32x4*)(cw + j * 3072 + col + 4);
        out[0] = fmaf(w0.x, __uint_as_float(x.x << 16), out[0]); out[1] = fmaf(w0.y, __uint_as_float(x.x & 0xffff0000u), out[1]);
        out[2] = fmaf(w0.z, __uint_as_float(x.y << 16), out[2]); out[3] = fmaf(w0.w, __uint_as_float(x.y & 0xffff0000u), out[3]);
        out[4] = fmaf(w1.x, __uint_as_float(x.z << 16), out[4]); out[5] = fmaf(w1.y, __uint_as_float(x.z & 0xffff0000u), out[5]);
        out[6] = fmaf(w1.z, __uint_as_float(x.w << 16), out[6]); out[7] = fmaf(w1.w, __uint_as_float(x.w & 0xffff0000u), out[7]);
    }
#pragma unroll
    for (int e = 0; e < 8; ++e) out[e] = silu_f(out[e]);
}
template <int N> __device__ __forceinline__ unsigned dpp_row_shr(unsigned v) { return (unsigned)__builtin_amdgcn_update_dpp(0, (int)v, 0x110 + N, 0xF, 0xF, true); }
template <int N> __device__ __forceinline__ unsigned dpp_row_shl(unsigned v) { return (unsigned)__builtin_amdgcn_update_dpp(0, (int)v, 0x100 + N, 0xF, 0xF, true); }
template <int J> __device__ __forceinline__ v4u tap_back(const v4u cur, const v4u prev) {
    return (v4u){dpp_row_shr<J>(cur.x) | dpp_row_shl<16 - J>(prev.x), dpp_row_shr<J>(cur.y) | dpp_row_shl<16 - J>(prev.y), dpp_row_shr<J>(cur.z) | dpp_row_shl<16 - J>(prev.z), dpp_row_shr<J>(cur.w) | dpp_row_shl<16 - J>(prev.w)};
}
__device__ __forceinline__ void conv8d(const v4u cur, const v4u prev, int col, const float* cw, float (&out)[8]) {
    const v4u xs[4] = {tap_back<3>(cur, prev), tap_back<2>(cur, prev), tap_back<1>(cur, prev), cur};
#pragma unroll
    for (int e = 0; e < 8; ++e) out[e] = 0.f;
#pragma unroll
    for (int j = 0; j < 4; ++j) {
        const v4u x = xs[j];
        const f32x4 w0 = *(const GAS f32x4*)(cw + j * 3072 + col), w1 = *(const GAS f32x4*)(cw + j * 3072 + col + 4);
        out[0] = fmaf(w0.x, __uint_as_float(x.x << 16), out[0]); out[1] = fmaf(w0.y, __uint_as_float(x.x & 0xffff0000u), out[1]);
        out[2] = fmaf(w0.z, __uint_as_float(x.y << 16), out[2]); out[3] = fmaf(w0.w, __uint_as_float(x.y & 0xffff0000u), out[3]);
        out[4] = fmaf(w1.x, __uint_as_float(x.z << 16), out[4]); out[5] = fmaf(w1.y, __uint_as_float(x.z & 0xffff0000u), out[5]);
        out[6] = fmaf(w1.z, __uint_as_float(x.w << 16), out[6]); out[7] = fmaf(w1.w, __uint_as_float(x.w & 0xffff0000u), out[7]);
    }
#pragma unroll
    for (int e = 0; e < 8; ++e) out[e] = silu_f(out[e]);
}
__device__ __forceinline__ v4u conv_prev0(const bf16* projb, int row0, int t0, int fr, int col) {
    return (t0 > 0) ? *(const GAS v4u*)(projb + (size_t)(row0 - 16 + fr) * NINP + col) : (v4u){0u, 0u, 0u, 0u};
}
__device__ __forceinline__ f32x4 conv1x4(const bf16* projb, int rowb, int posb, int col, const float* cw) {
    float x[7];
#pragma unroll
    for (int i = 0; i < 7; ++i) { const bool ok = (posb - 3 + i) >= 0; const float v = bf2f(*(const GAS unsigned short*)(projb + (size_t)(ok ? rowb - 3 + i : rowb) * NINP + col)); x[i] = ok ? v : 0.f; }
    const float w0 = cw[col], w1 = cw[3072 + col], w2 = cw[2 * 3072 + col], w3 = cw[3 * 3072 + col];
    f32x4 o;
#pragma unroll
    for (int r = 0; r < 4; ++r) o[r] = silu_f(fmaf(w3, x[r + 3], fmaf(w2, x[r + 2], fmaf(w1, x[r + 1], w0 * x[r]))));
    return o;
}

__device__ __forceinline__ void phase_dn_prep(Frame& F, const bf16* hb, const bf16* wg, const bf16* projb_, const float* convw_, const float* a_log, const float* dt_bias,
                                              bf16* wneg_, bf16* qdec_, bf16* kdec_, bf16* attn_, float* ubuf_, float* glast) {
    const int hh = F.wave;
    { const int unit = F.vcu;
        const float A_h = __expf(a_log[hh]), dtb = dt_bias[hh];
        int lane_ = (int)__builtin_amdgcn_mbcnt_hi(~0u, __builtin_amdgcn_mbcnt_lo(~0u, 0u)); asm volatile("" : "+v"(lane_));
        const int lane = lane_, fr = lane & 15, fq = lane >> 4;
        const float* convw = convw_; asm volatile("" : "+s"(convw));
        const bf16* projb = projb_; asm volatile("" : "+s"(projb));
        bf16* wneg = wneg_; bf16* qdec = qdec_; bf16* kdec = kdec_; bf16* attn = attn_; float* ubuf = ubuf_; asm volatile("" : "+s"(wneg), "+s"(qdec), "+s"(kdec), "+s"(attn), "+s"(ubuf));
        unsigned ldsb = 0; asm volatile("" : "+s"(ldsb));
        LAS float* gcs = (LAS float*)(F.lds + ldsb + PREP_SC_OFF + F.wave * 768); LAS float* bes = gcs + 64; LAS float* rnk = gcs + 128;
        LAS unsigned char* tw = F.lds + ldsb + F.wave * 16384;
        const int b = unit >> 7, n = unit & 127, t0 = n * 64, row0 = b * T + t0, cid = (b * 8 + hh) * 128 + n;
        {
            LAS float* glp = (LAS float*)(F.lds + ldsb);
            const int rt = hh & 3, kh = hh >> 2;
            const bf16* ap = hb + (size_t)(row0 + 16 * rt + fr) * D + kh * 512 + fq * 8; const bf16* bp = wg + (size_t)fr * D + kh * 512 + fq * 8;
            f32x4 acc = (f32x4){0.f, 0.f, 0.f, 0.f};
#pragma unroll 4
            for (int ks = 0; ks < 16; ++ks) acc = MFMA32(*(const GAS bf16x8*)(ap + ks * 32), *(const GAS bf16x8*)(bp + ks * 32), acc);
#pragma unroll
            for (int r = 0; r < 4; ++r) glp[(kh * 64 + 16 * rt + 4 * fq + r) * 17 + fr] = acc[r];
            LDS_WAIT(); __syncthreads();
            const float bl = glp[lane * 17 + hh] + glp[(64 + lane) * 17 + hh], al = glp[lane * 17 + 8 + hh] + glp[(64 + lane) * 17 + 8 + hh];
            LDS_WAIT(); __syncthreads();
            const float x = al + dtb; const float sp = (x > 20.f) ? x : log1pf(__expf(x));
            float c = -A_h * sp;
#pragma unroll
            for (int o = 1; o < 64; o <<= 1) { const float t = __shfl_up(c, o); if (lane >= o) c += t; }
            gcs[lane] = c; bes[lane] = 1.f / (1.f + __expf(-bl));
        }
        LDS_WAIT(); asm volatile("" ::: "memory");
        const float gl = gcs[63];
        if (lane == 0) glast[cid] = __expf(gl);
        v4u pvk[4];
#pragma unroll
        for (int ks = 0; ks < 4; ++ks) pvk[ks] = conv_prev0(projb, row0, t0, fr, 1024 + hh * 128 + 32 * ks + 8 * fq);
#pragma unroll 1
        for (int t = 0; t < 4; ++t) {
            int lb_ = lane; asm volatile("" : "+v"(lb_)); const int fr = lb_ & 15, fq = lb_ >> 4;
            const int tok = 16 * t + fr; float v[4][8]; float ss = 0.f;
#pragma unroll
            for (int ks = 0; ks < 4; ++ks) { const int col_ = 1024 + hh * 128 + 32 * ks + 8 * fq; const v4u cur_ = *(const GAS v4u*)(projb + (size_t)(row0 + tok) * NINP + col_);
                conv8d(cur_, pvk[ks], col_, convw, v[ks]); pvk[ks] = cur_;
#pragma unroll
                for (int e = 0; e < 8; ++e) ss = fmaf(v[ks][e], v[ks][e], ss); }
            ss += __shfl_xor(ss, 16); ss += __shfl_xor(ss, 32);
            const float rn = 1.f / sqrtf(ss + RMS_EPS);
            if (fq == 0) rnk[tok] = rn;
            const float kd = rn * __expf(gl - gcs[tok]);
#pragma unroll
            for (int ks = 0; ks < 4; ++ks) {
                *(LAS v4u*)(tw + tok * 256 + (((4 * ks + fq) ^ fr) << 4)) = (v4u){pk2(v[ks][0] * rn, v[ks][1] * rn), pk2(v[ks][2] * rn, v[ks][3] * rn), pk2(v[ks][4] * rn, v[ks][5] * rn), pk2(v[ks][6] * rn, v[ks][7] * rn)};
                *(GAS v4u*)(kdec + ((size_t)cid * 64 + tok) * 128 + 32 * ks + 8 * fq) = (v4u){pk2(v[ks][0] * kd, v[ks][1] * kd), pk2(v[ks][2] * kd, v[ks][3] * kd), pk2(v[ks][4] * kd, v[ks][5] * kd), pk2(v[ks][6] * kd, v[ks][7] * kd)};
            }
        }
        LDS_WAIT(); asm volatile("" ::: "memory");
#define KFRAG(t_, ks_) (*(const LAS bf16x8*)(tw + (16 * (t_) + fr) * 256 + (((4 * (ks_) + fq) ^ fr) << 4)))
        bf16* attc = attn + (size_t)cid * 64 * 64;
        v4u pvq[4];
#pragma unroll
        for (int ks = 0; ks < 4; ++ks) pvq[ks] = conv_prev0(projb, row0, t0, fr, hh * 128 + 32 * ks + 8 * fq);
#pragma unroll 1
        for (int ti = 0; ti < 4; ++ti) {
            int lc_ = lane; asm volatile("" : "+v"(lc_)); const int fr = lc_ & 15, fq = lc_ >> 4;
            bf16x8 qf[4];
            { const int tok = 16 * ti + fr; float v[4][8]; float ss = 0.f;
#pragma unroll
              for (int ks = 0; ks < 4; ++ks) { const int col_ = hh * 128 + 32 * ks + 8 * fq; const v4u cur_ = *(const GAS v4u*)(projb + (size_t)(row0 + tok) * NINP + col_);
                  conv8d(cur_, pvq[ks], col_, convw, v[ks]); pvq[ks] = cur_;
#pragma unroll
                  for (int e = 0; e < 8; ++e) ss = fmaf(v[ks][e], v[ks][e], ss); }
              ss += __shfl_xor(ss, 16); ss += __shfl_xor(ss, 32);
              const float rn = 1.f / sqrtf(ss + RMS_EPS);
              const float qd = rn * 0.08838834764831845f * __expf(gcs[tok]);
#pragma unroll
              for (int ks = 0; ks < 4; ++ks) {
                  qf[ks] = __builtin_bit_cast(bf16x8, (v4u){pk2(v[ks][0] * rn, v[ks][1] * rn), pk2(v[ks][2] * rn, v[ks][3] * rn), pk2(v[ks][4] * rn, v[ks][5] * rn), pk2(v[ks][6] * rn, v[ks][7] * rn)});
                  { bf16* qrow = qdec + ((size_t)cid * 64 + tok) * 128 + 32 * ks;
                    *(GAS unsigned long long*)(qrow + 8 * ((2 * fq) & 3) + 4 * (fq >> 1)) = (unsigned long long)pk2(v[ks][0] * qd, v[ks][1] * qd) | ((unsigned long long)pk2(v[ks][2] * qd, v[ks][3] * qd) << 32);
                    *(GAS unsigned long long*)(qrow + 8 * ((2 * fq + 1) & 3) + 4 * (fq >> 1)) = (unsigned long long)pk2(v[ks][4] * qd, v[ks][5] * qd) | ((unsigned long long)pk2(v[ks][6] * qd, v[ks][7] * qd) << 32); }
              } }
#pragma unroll 1
            for (int tj = 0; tj <= ti; ++tj) {
                f32x4 acc = (f32x4){0.f, 0.f, 0.f, 0.f};
#pragma unroll
                for (int ks = 0; ks < 4; ++ks) acc = MFMA32(KFRAG(tj, ks), qf[ks], acc);
                const int i = 16 * ti + fr; const float gi = gcs[i]; const f32x4 gj = *(const LAS f32x4*)(gcs + 16 * tj + 4 * fq);
                float a[4];
#pragma unroll
                for (int r = 0; r < 4; ++r) { const int j = 16 * tj + 4 * fq + r; a[r] = (i >= j) ? acc[r] * 0.08838834764831845f * __expf(gi - gj[r]) : 0.f; }
                *(GAS unsigned long long*)(attc + i * 64 + 32 * (tj >> 1) + 8 * fq + 4 * (tj & 1)) = (unsigned long long)pk2(a[0], a[1]) | ((unsigned long long)pk2(a[2], a[3]) << 32);
            }
            if ((ti & 1) == 0)
                *(GAS unsigned long long*)(attc + (16 * ti + fr) * 64 + 32 * ((ti + 1) >> 1) + 8 * fq + 4 * ((ti + 1) & 1)) = 0ull;
        }
        s16x4v nAoff[4][4];
        s16x4v P1n[4], P2[4], P4[4], P8[4];
#pragma unroll
        for (int ti = 0; ti < 4; ++ti)
#pragma unroll
            for (int tj = 0; tj <= ti; ++tj) {
                int le_ = lane; asm volatile("" : "+v"(le_)); const int fr = le_ & 15, fq = le_ >> 4;
                f32x4 acc = (f32x4){0.f, 0.f, 0.f, 0.f};
#pragma unroll
                for (int ks = 0; ks < 4; ++ks) acc = MFMA32(KFRAG(tj, ks), KFRAG(ti, ks), acc);
                const int i = 16 * ti + fr; const float bi = bes[i], gi = gcs[i];
                f32x4 aop;
#pragma unroll
                for (int r = 0; r < 4; ++r) { const int j = 16 * tj + 4 * fq + r; aop[r] = (i > j) ? bi * acc[r] * __expf(gi - gcs[j]) : 0.f; }
                if (tj < ti) { nAoff[ti][tj] = pack4(-aop); }
                else {
                    f32x4 bop;
#pragma unroll
                    for (int r = 0; r < 4; ++r) { const int rw = 16 * ti + 4 * fq + r; bop[r] = (rw > i) ? bes[rw] * acc[r] * __expf(gcs[rw] - gi) : 0.f; }
                    const s16x4v a1 = pack4(aop), b1 = pack4(bop);
                    const f32x4 z = (f32x4){0.f, 0.f, 0.f, 0.f};
                    const s16x4v a2 = pack4(MFMA16(b1, a1, z)), b2 = pack4(MFMA16(a1, b1, z));
                    const s16x4v a4 = pack4(MFMA16(b2, a2, z)), b4 = pack4(MFMA16(a2, b2, z));
                    const s16x4v a8 = pack4(MFMA16(b4, a4, z));
                    P1n[ti] = pack4(-aop); P2[ti] = a2; P4[ti] = a4; P8[ti] = a8;
                }
            }
#undef KFRAG
#define TILE_EL(tok_, ch_) bf2f(*(const LAS unsigned short*)(tw + (tok_) * 256 + (((((ch_) >> 3)) ^ ((tok_) & 15)) << 4) + ((ch_) & 7) * 2))
#define TILE_ST(tok_, ch_, val_) (*(LAS unsigned short*)(tw + (tok_) * 256 + (((((ch_) >> 3)) ^ ((tok_) & 15)) << 4) + ((ch_) & 7) * 2) = (unsigned short)f2bf(val_))
#define SOLVE_PASS(PASS) do { \
        _Pragma("unroll 1") for (int c8 = 0; c8 < 8; ++c8) { \
            int lo2_ = lane; asm volatile("" : "+v"(lo2_)); const int fr = lo2_ & 15, fq = lo2_ >> 4; \
            const int ch = 16 * c8 + fr; \
            s16x4v Xb[4]; \
            _Pragma("unroll") for (int bi = 0; bi < 4; ++bi) { \
                const int tokb = 16 * bi + 4 * fq; \
                f32x4 Y; \
                _Pragma("unroll") for (int r = 0; r < 4; ++r) { const int tok = tokb + r; float f = bes[tok]; if ((PASS) == 0) f *= __expf(gcs[tok]); Y[r] = TILE_EL(tok, ch) * f; } \
                _Pragma("unroll") for (int bj = 0; bj < 4; ++bj) if (bj < bi) Y = MFMA16(nAoff[bi][bj], Xb[bj], Y); \
                Y = MFMA16(P8[bi], pack4(Y), Y); Y = MFMA16(P4[bi], pack4(Y), Y); Y = MFMA16(P2[bi], pack4(Y), Y); Y = MFMA16(P1n[bi], pack4(Y), Y); \
                Xb[bi] = pack4(Y); \
                if ((PASS) == 1) { *(GAS f32x4*)(ubuf + (size_t)cid * 64 * 128 + (size_t)((c8 * 4 + bi) * 64 + lo2_) * 4) = Y; } \
                else { _Pragma("unroll") for (int r = 0; r < 4; ++r) TILE_ST(tokb + r, ch, -Y[r]); } \
            } } } while (0)
        SOLVE_PASS(0);
        LDS_WAIT(); asm volatile("" ::: "memory");
        {
            int lo4_ = lane; asm volatile("" : "+v"(lo4_));
#pragma unroll
            for (int i = 0; i < 16; ++i) { const int p = lo4_ + 64 * i, tok = p >> 4, c16 = p & 15; *(GAS v4u*)(wneg + ((size_t)cid * 64 + tok) * 128 + c16 * 8) = *(const LAS v4u*)(tw + tok * 256 + ((c16 ^ (tok & 15)) << 4)); }
        }
        LDS_WAIT(); asm volatile("" ::: "memory");
        {
            int lo3_ = lane; asm volatile("" : "+v"(lo3_)); const int fr = lo3_ & 15, fq = lo3_ >> 4;
            v4u pvv[4];
#pragma unroll
            for (int ks = 0; ks < 4; ++ks) pvv[ks] = conv_prev0(projb, row0, t0, fr, 2048 + hh * 128 + 32 * ks + 8 * fq);
#pragma unroll 1
            for (int t = 0; t < 4; ++t) {
                const int tok = 16 * t + fr;
#pragma unroll
                for (int ks = 0; ks < 4; ++ks) { float v[8]; const int col_ = 2048 + hh * 128 + 32 * ks + 8 * fq; const v4u cur_ = *(const GAS v4u*)(projb + (size_t)(row0 + tok) * NINP + col_);
                    conv8d(cur_, pvv[ks], col_, convw, v); pvv[ks] = cur_;
                    *(LAS v4u*)(tw + tok * 256 + (((4 * ks + fq) ^ fr) << 4)) = (v4u){pk2(v[0], v[1]), pk2(v[2], v[3]), pk2(v[4], v[5]), pk2(v[6], v[7])}; }
            }
        }
        LDS_WAIT(); asm volatile("" ::: "memory");
        SOLVE_PASS(1);
#undef SOLVE_PASS
#undef TILE_EL
#undef TILE_ST
        LDS_WAIT(); asm volatile("" ::: "memory");
    }
}

constexpr int SC_W = 0, SC_K = 16384, SC_U = 34816, SC_G = 51200, SC_SET = 51456;
__device__ __forceinline__ bf16x8 lds_tr8(const LAS unsigned char* p, int rowstride16) {
    const s16x4v lo = __builtin_bit_cast(s16x4v, __builtin_amdgcn_ds_read_tr16_b64_v4i16((LAS v4i16_t*)p));
    const s16x4v hi = __builtin_bit_cast(s16x4v, __builtin_amdgcn_ds_read_tr16_b64_v4i16((LAS v4i16_t*)(p + rowstride16)));
    return (bf16x8){lo[0], lo[1], lo[2], lo[3], hi[0], hi[1], hi[2], hi[3]};
}
__device__ __forceinline__ void phase_dn_scan(Frame& F, const bf16* wneg, const bf16* kdec, const float* ubuf, const float* glast, bf16* sbuf, bf16* vbuf, const int dbg = 0) {
    PHASE_IDS
    const int fr = lane & 15, fq = lane >> 4;
    const int bh = F.vcu >> 2, quarter = F.vcu & 3, cid0 = bh * 128;
    LAS unsigned char* L = F.lds;
    if (F.wave >= 4) {
        const int lt = (F.wave - 4) * 64 + lane;
        v4u r0[10], r1[10], r2[10], r3[10]; float g0 = 0.f, g1 = 0.f, g2 = 0.f, g3 = 0.f;
#define SC_LOAD(R, G, c) do { const size_t cb = (size_t)(cid0 + (c)) * 64 * 128; \
        _Pragma("unroll") for (int i = 0; i < 4; ++i) { const int p = lt + 256 * i; R[i] = *(const GAS v4u*)(wneg + cb + (size_t)p * 8); R[4 + i] = *(const GAS v4u*)(kdec + cb + (size_t)p * 8); \
            if (i < 2) R[8 + i] = *(const GAS v4u*)(ubuf + cb + (size_t)quarter * 2048 + (size_t)p * 4); } G = glast[cid0 + (c)]; } while (0)
#define SC_WRITE(R, G, set) do { LAS unsigned char* S_ = L + (set) * SC_SET; \
        _Pragma("unroll") for (int i = 0; i < 4; ++i) { const int p = lt + 256 * i, row = p >> 4, c16 = p & 15, sb = c16 >> 2, c = c16 & 3; \
            const int o0 = row * 256 + ((((4 * sb + ((2 * c) & 3)) ^ (row & 15)) << 4) | ((c >> 1) << 3)), o1 = row * 256 + ((((4 * sb + ((2 * c + 1) & 3)) ^ (row & 15)) << 4) | ((c >> 1) << 3)); \
            *(LAS unsigned long long*)(S_ + SC_W + o0) = (unsigned long long)R[i].x | ((unsigned long long)R[i].y << 32); *(LAS unsigned long long*)(S_ + SC_W + o1) = (unsigned long long)R[i].z | ((unsigned long long)R[i].w << 32); \
            *(LAS v4u*)(S_ + SC_K + row * 288 + c16 * 16) = R[4 + i]; if (i < 2) *(LAS v4u*)(S_ + SC_U + p * 16) = R[8 + i]; } if (lt == 0) *(LAS float*)(S_ + SC_G) = G; } while (0)
#define SC_LSTEP(R, G, set, n) do { if (!(dbg & 2)) { if ((n) + 1 < 128) SC_WRITE(R, G, set); if ((n) + 5 < 128) SC_LOAD(R, G, (n) + 5); } LDS_WAIT(); __builtin_amdgcn_s_barrier(); } while (0)
        SC_LOAD(r0, g0, 0); SC_LOAD(r1, g1, 1); SC_LOAD(r2, g2, 2); SC_LOAD(r3, g3, 3);
        SC_WRITE(r0, g0, 0); SC_LOAD(r0, g0, 4);
        LDS_WAIT(); __builtin_amdgcn_s_barrier();
#pragma unroll 1
        for (int n = 0; n < 128; n += 4) {
            SC_LSTEP(r1, g1, 1, n); SC_LSTEP(r2, g2, 0, n + 1); SC_LSTEP(r3, g3, 1, n + 2); SC_LSTEP(r0, g0, 0, n + 3);
        }
#undef SC_LOAD
#undef SC_WRITE
#undef SC_LSTEP
    } else if (F.wave >= 2) {
        for (int n = 0; n < 129; ++n) { LDS_WAIT(); __builtin_amdgcn_s_barrier(); }
    } else {
        const int c0 = quarter * 32 + F.wave * 16, dvt = c0 >> 4;
        f32x4 S[8]; bf16x8 SB[4];
#pragma unroll
        for (int i = 0; i < 8; ++i) S[i] = (f32x4){0.f, 0.f, 0.f, 0.f};
#pragma unroll
        for (int i = 0; i < 4; ++i) SB[i] = (bf16x8){0, 0, 0, 0, 0, 0, 0, 0};
        __builtin_amdgcn_s_barrier();
#define SC_SB() __builtin_amdgcn_sched_barrier(0)
#define SC_STEP() do { if (dbg & 4) { LDS_WAIT(); __builtin_amdgcn_s_barrier(); break; } const LAS unsigned char* Sx = L + (n & 1) * SC_SET; \
            f32x4 vn[4]; const float glc = *(const LAS float*)(Sx + SC_G); \
            _Pragma("unroll") for (int mt = 0; mt < 4; ++mt) vn[mt] = *(const LAS f32x4*)(Sx + SC_U + ((F.wave * 4 + mt) * 64 + lane) * 16); \
            bf16x8 fa[8], fb[8]; \
            _Pragma("unroll") for (int m_ = 0; m_ < 2; ++m_) _Pragma("unroll") for (int s_ = 0; s_ < 4; ++s_) { fa[m_ * 4 + s_] = *(const LAS bf16x8*)(Sx + SC_W + (16 * m_ + fr) * 256 + (((4 * s_ + fq) ^ fr) << 4)); fb[m_ * 4 + s_] = *(const LAS bf16x8*)(Sx + SC_W + (16 * (2 + m_) + fr) * 256 + (((4 * s_ + fq) ^ fr) << 4)); } \
            if (!(dbg & 1)) { GAS v4u* sp_ = (GAS v4u*)(sbuf + ((size_t)(cid0 + n) * 8 + dvt) * 4 * 64 * 8) + lane; _Pragma("unroll") for (int s_ = 0; s_ < 4; ++s_) sp_[s_ * 64] = __builtin_bit_cast(v4u, SB[s_]); } else { asm volatile("" :: "v"(SB[0]), "v"(SB[1]), "v"(SB[2]), "v"(SB[3])); } \
            SC_SB(); \
            _Pragma("unroll") for (int m_ = 0; m_ < 2; ++m_) _Pragma("unroll") for (int s_ = 0; s_ < 4; ++s_) vn[m_] = MFMA32(fa[m_ * 4 + s_], SB[s_], vn[m_]); \
            _Pragma("unroll") for (int d_ = 0; d_ < 4; ++d_) _Pragma("unroll") for (int p_ = 0; p_ < 2; ++p_) fa[d_ * 2 + p_] = lds_tr8(Sx + SC_K + (32 * p_ + 4 * fq + (fr >> 2)) * 288 + (16 * d_ + 4 * (fr & 3)) * 2, 16 * 288); \
            SC_SB(); \
            _Pragma("unroll") for (int m_ = 0; m_ < 2; ++m_) _Pragma("unroll") for (int s_ = 0; s_ < 4; ++s_) vn[2 + m_] = MFMA32(fb[m_ * 4 + s_], SB[s_], vn[2 + m_]); \
            _Pragma("unroll") for (int d_ = 0; d_ < 4; ++d_) _Pragma("unroll") for (int p_ = 0; p_ < 2; ++p_) fb[d_ * 2 + p_] = lds_tr8(Sx + SC_K + (32 * p_ + 4 * fq + (fr >> 2)) * 288 + (16 * (4 + d_) + 4 * (fr & 3)) * 2, 16 * 288); \
            SC_SB(); \
            bf16x8 VB[2]; VB[0] = pack8(vn[0], vn[1]); VB[1] = pack8(vn[2], vn[3]); \
            if (!(dbg & 1)) { GAS v4u* vp_ = (GAS v4u*)(vbuf + ((size_t)(cid0 + n) * 8 + dvt) * 2 * 64 * 8) + lane; vp_[0] = __builtin_bit_cast(v4u, VB[0]); vp_[64] = __builtin_bit_cast(v4u, VB[1]); } else { asm volatile("" :: "v"(VB[0]), "v"(VB[1])); } \
            _Pragma("unroll") for (int dt = 0; dt < 8; ++dt) S[dt] = S[dt] * glc; \
            _Pragma("unroll") for (int dt = 0; dt < 4; ++dt) { S[dt] = MFMA32(fa[dt * 2], VB[0], S[dt]); S[dt] = MFMA32(fa[dt * 2 + 1], VB[1], S[dt]); } \
            _Pragma("unroll") for (int dt = 0; dt < 4; ++dt) { S[4 + dt] = MFMA32(fb[dt * 2], VB[0], S[4 + dt]); S[4 + dt] = MFMA32(fb[dt * 2 + 1], VB[1], S[4 + dt]); } \
            _Pragma("unroll") for (int s_ = 0; s_ < 4; ++s_) SB[s_] = pack8(S[2 * s_], S[2 * s_ + 1]); \
            LDS_WAIT(); __builtin_amdgcn_s_barrier(); } while (0)
#pragma unroll 1
        for (int n2 = 0; n2 < 128; n2 += 2) {
#pragma unroll
            for (int par = 0; par < 2; ++par) {
                const int n = n2 + par;
                SC_STEP();
            }
        }
#undef SC_STEP
#undef SC_SB
    }
}
__device__ __forceinline__ void phase_dn_out(Frame& F, const bf16* qdec, const bf16* attn, const bf16* sbuf, const bf16* vbuf, const bf16* projb, const float* norm_w, bf16* on) {
    PHASE_IDS
    const int fr = lane & 15, fq = lane >> 4;
    LAS unsigned char* tw = F.lds + F.wave * 16384;
    LAS float* rinv = (LAS float*)(F.lds + PREP_SC_OFF + F.wave * 768);
    for (int cid = F.vcu * NWAVES + F.wave; cid < 2048; cid += F.G * NWAVES) {
        const int bh = cid >> 7, n = cid & 127, b = bh >> 3, hh = bh & 7; const size_t row0 = (size_t)b * T + (size_t)n * 64;
        bf16x8 qf[4][4], af[6];
        { const bf16* qb_ = qdec + (size_t)cid * 64 * 128 + fr * 128 + fq * 8;
#pragma unroll
          for (int mt = 0; mt < 4; ++mt)
#pragma unroll
              for (int s_ = 0; s_ < 4; ++s_) qf[mt][s_] = *(const GAS bf16x8*)(qb_ + mt * 16 * 128 + s_ * 32);
          const bf16* ab_ = attn + (size_t)cid * 64 * 64 + fr * 64 + fq * 8;
          af[0] = *(const GAS bf16x8*)(ab_); af[1] = *(const GAS bf16x8*)(ab_ + 16 * 64); af[2] = *(const GAS bf16x8*)(ab_ + 32 * 64); af[3] = *(const GAS bf16x8*)(ab_ + 32 * 64 + 32);
          af[4] = *(const GAS bf16x8*)(ab_ + 48 * 64); af[5] = *(const GAS bf16x8*)(ab_ + 48 * 64 + 32); }
        f32x4 ss[4];
#pragma unroll
        for (int mt = 0; mt < 4; ++mt) ss[mt] = (f32x4){0.f, 0.f, 0.f, 0.f};
#pragma unroll 2
        for (int dvt = 0; dvt < 8; ++dvt) {
            const GAS v4u* sp_ = (const GAS v4u*)(sbuf + ((size_t)cid * 8 + dvt) * 4 * 64 * 8) + lane; const GAS v4u* vp_ = (const GAS v4u*)(vbuf + ((size_t)cid * 8 + dvt) * 2 * 64 * 8) + lane;
            bf16x8 SBf[4], VBf[2];
#pragma unroll
            for (int s_ = 0; s_ < 4; ++s_) SBf[s_] = __builtin_bit_cast(bf16x8, sp_[s_ * 64]);
            VBf[0] = __builtin_bit_cast(bf16x8, vp_[0]); VBf[1] = __builtin_bit_cast(bf16x8, vp_[64]);
            f32x4 o[4];
#pragma unroll
            for (int mt = 0; mt < 4; ++mt) { o[mt] = (f32x4){0.f, 0.f, 0.f, 0.f};
#pragma unroll
                for (int s_ = 0; s_ < 4; ++s_) o[mt] = MFMA32(qf[mt][s_], SBf[s_], o[mt]); }
            o[0] = MFMA32(af[0], VBf[0], o[0]); o[1] = MFMA32(af[1], VBf[0], o[1]); o[2] = MFMA32(af[2], VBf[0], o[2]); o[2] = MFMA32(af[3], VBf[1], o[2]); o[3] = MFMA32(af[4], VBf[0], o[3]); o[3] = MFMA32(af[5], VBf[1], o[3]);
#pragma unroll
            for (int mt = 0; mt < 4; ++mt) { ss[mt] = ss[mt] + o[mt] * o[mt];
                const unsigned lo = pk2(o[mt][0], o[mt][1]), hi2 = pk2(o[mt][2], o[mt][3]);
                LAS unsigned short* tp = (LAS unsigned short*)(tw + (16 * mt + 4 * fq) * 256 + (16 * dvt + fr) * 2);
                tp[0] = (unsigned short)(lo & 0xffff); tp[128] = (unsigned short)(lo >> 16); tp[256] = (unsigned short)(hi2 & 0xffff); tp[384] = (unsigned short)(hi2 >> 16); }
        }
#pragma unroll
        for (int mt = 0; mt < 4; ++mt)
#pragma unroll
            for (int r = 0; r < 4; ++r) { float v = ss[mt][r]; v += __shfl_xor(v, 1); v += __shfl_xor(v, 2); v += __shfl_xor(v, 4); v += __shfl_xor(v, 8);
                if (fr == 0) rinv[16 * mt + 4 * fq + r] = 1.f / sqrtf(v * (1.f / 128.f) + RMS_EPS); }
        LDS_WAIT(); asm volatile("" ::: "memory");
        { const int c16 = lane & 15; f32x4 nw0 = *(const GAS f32x4*)(norm_w + c16 * 8), nw1 = *(const GAS f32x4*)(norm_w + c16 * 8 + 4);
#pragma unroll 4
          for (int i = 0; i < 16; ++i) { const int tok = (lane >> 4) + 4 * i; const float ri = rinv[tok];
              const v4u ov = *(const LAS v4u*)(tw + tok * 256 + c16 * 16); const v4u zv = *(const GAS v4u*)(projb + (row0 + tok) * NINP + 3072 + hh * 128 + c16 * 8);
              const unsigned ow[4] = {ov.x, ov.y, ov.z, ov.w}, zw[4] = {zv.x, zv.y, zv.z, zv.w}; const float nwv[8] = {nw0.x, nw0.y, nw0.z, nw0.w, nw1.x, nw1.y, nw1.z, nw1.w};
              unsigned res[4];
#pragma unroll
              for (int e = 0; e < 4; ++e) { const float o0 = __uint_as_float(ow[e] << 16), o1 = __uint_as_float(ow[e] & 0xffff0000u), z0 = __uint_as_float(zw[e] << 16), z1 = __uint_as_float(zw[e] & 0xffff0000u);
                  res[e] = pk2(o0 * ri * nwv[2 * e] * silu_f(z0), o1 * ri * nwv[2 * e + 1] * silu_f(z1)); }
              *(GAS v4u*)(on + (row0 + tok) * D + hh * 128 + c16 * 8) = (v4u){res[0], res[1], res[2], res[3]}; } }
        LDS_WAIT(); asm volatile("" ::: "memory");
    }
}
#define PH(l, k) (1 + 16 * (l) + (k))
__global__ void __launch_bounds__(NWAVES * 64, 2) mega(Args args) {
    extern __shared__ __attribute__((aligned(16))) unsigned char lds[];
    Frame F;
    F.lds = (LAS unsigned char*)lds; F.MISC = (volatile LAS unsigned*)(F.lds + MISC_OFF);
    F.wave = __builtin_amdgcn_readfirstlane((int)threadIdx.x >> 6);
    F.G = gridDim.x; { const int bx = blockIdx.x; F.vcu = (F.G % 8 == 0) ? (bx % 8) * (F.G / 8) + bx / 8 : bx; }
    F.ws = args.ws; F.ctl = (gu32*)(args.ws + WS_CTL);
    for (int u = threadIdx.x; u < (LDS_BYTES - LDSCTL_OFF) / 4; u += NWAVES * 64) ((LAS unsigned*)(F.lds + LDSCTL_OFF))[u] = 0u;
    __syncthreads();
    const int lo = args.ph_lo, hi = args.ph_hi;
    XcdBarrier bar; bar.bar = (unsigned*)(F.ctl + CW_BAR) + args.bar_region * XCD_BAR_WORDS; bar.x = 0; bar.st = nullptr;
    if (hi - lo > 1) bar = xcd_barrier_post((unsigned*)(F.ctl + CW_BAR) + args.bar_region * XCD_BAR_WORDS, F.MISC + 8, F.wave);
    unsigned char* ws = args.ws;
    bf16* hb = (bf16*)(ws + WS_HB); bf16* h1b = (bf16*)(ws + WS_H1B);
    bf16* projb = (bf16*)(ws + WS_PROJ); bf16* Kb = (bf16*)(ws + WS_KB); bf16* Qb = Kb - (size_t)M * D; bf16* onb = (bf16*)(ws + WS_ON); bf16* mixb = (bf16*)(ws + WS_MIX);
    int* eid = (int*)(ws + WS_EID); float* gate = (float*)(ws + WS_GATE); int* apos = (int*)(ws + WS_APOS);
    bf16* xrows = (bf16*)(ws + WS_XROWS); bf16* hid = (bf16*)(ws + WS_HID); bf16* yrows = (bf16*)(ws + WS_YROWS);
    LAS int* tile_e = (LAS int*)(F.lds + TILEE_OFF); LAS int* psl = (LAS int*)(F.lds + 20480);

#ifndef REPSEL
#define REPSEL(p) 0
#endif
#define IN(p) (lo <= (p) && (p) < hi)
#ifdef PROBE_A
#define STAMP() do { if (blockIdx.x == 0 && F.wave == 0 && __builtin_amdgcn_mbcnt_hi(~0u, __builtin_amdgcn_mbcnt_lo(~0u, 0u)) == 0u) { const unsigned n_ = F.MISC[12]; ((volatile LAS unsigned long long*)(F.lds + STAMP_OFF))[n_] = rt(); F.MISC[12] = n_ + 1; } } while (0)
#else
#define STAMP() do { } while (0)
#endif
#define SEAM(p) do { if ((p) + 1 < hi) xcd_barrier(bar, F.wave); STAMP(); } while (0)
#define DO_PHASE(p, cond, ...) do { if ((cond) && IN(p)) { { const int rep_ = 0; (void)rep_; __VA_ARGS__ } SEAM(p); if (REPSEL(p)) { { const int rep_ = REPSEL(p); (void)rep_; __VA_ARGS__ } if ((p) + 1 < hi) xcd_barrier(bar, F.wave); } } } while (0)
    STAMP();
    DO_PHASE(0, true, p0_prologue(F, args););
#define LAYER(l) do { \
    gu32* counts = F.ctl + CW_CNT + (l) * 64 * CSTR; gu32* cursor = counts + 32 * CSTR; \
    DO_PHASE(PH(l, 0), true, \
        if ((l) < 2) { pg8::Gemm g{hb, (const bf16*)(ws + WS_WIN) + (size_t)(l) * NINP * D, M, NINP, D}; pg8::StaticOrder S; S.init(M, NINP, F.G, (int)blockIdx.x); \
            pg8::EpiBf16<0> E{projb, NINP, nullptr, 0, 0, 1.f}; pg8::gemm_phase<pg8::EpiBf16<0>, pg8::StaticOrder, true, true>(F.lds, g, S, E, F.wave); } \
        else { const int NQ = ((l) == 2) ? 3 * D : D; pg8::Gemm g{hb, (const bf16*)(ws + ((l) == 2 ? WS_WQKV : WS_WQ3)), M, NQ, D}; pg8::StaticOrder S; S.init(M, NQ, F.G, (int)blockIdx.x); \
            pg8::EpiBf16<0> E{Qb, D, nullptr, D, (size_t)M * D, QSCALE}; pg8::gemm_phase<pg8::EpiBf16<0>, pg8::StaticOrder, true, true>(F.lds, g, S, E, F.wave); } ); \
    DO_PHASE(PH(l, 1), (l) < 2, \
        phase_dn_prep(F, hb, (const bf16*)(ws + WS_WG) + (size_t)(l) * 16 * D, projb, args.in[2] + (size_t)(l) * 4 * 3072, args.in[3] + (l) * 8, args.in[4] + (l) * 8, (bf16*)(ws + WS_WNEG), (bf16*)(ws + WS_QDEC), (bf16*)(ws + WS_KDEC), (bf16*)(ws + WS_ATT), (float*)(ws + WS_U), (float*)(ws + WS_GLAST)); ); \
    DO_PHASE(PH(l, 2), (l) < 2, \
        if (F.vcu >= 64) { if (rep_ != 1 && rep_ < 8) p0_moe_weights(F, args, 2 * (l), F.vcu - 64, F.G - 64); } \
        else if (rep_ != 2) phase_dn_scan(F, (const bf16*)(ws + WS_WNEG), (const bf16*)(ws + WS_KDEC), (const float*)(ws + WS_U), (const float*)(ws + WS_GLAST), (bf16*)(ws + WS_SBUF), (bf16*)(ws + WS_VBUF), rep_ >= 8 ? (rep_ & 7) : 0); ); \
    DO_PHASE(PH(l, 3), (l) < 2, \
        phase_dn_out(F, (const bf16*)(ws + WS_QDEC), (const bf16*)(ws + WS_ATT), (const bf16*)(ws + WS_SBUF), (const bf16*)(ws + WS_VBUF), projb, args.in[5] + (l) * 128, onb); ); \
    DO_PHASE(PH(l, 1), (l) >= 2, \
        const attn_body::AttnTensors AT{(const attn_body::bf16*)Qb, (const attn_body::bf16*)Kb, (const attn_body::bf16*)(ws + WS_VB), (attn_body::bf16*)projb, (attn_body::bf16*)(projb + (size_t)M * D)}; \
        const attn_body::StaticOrder S((int)F.G, (int)blockIdx.x); \
        attn_body::attn_phase<attn_body::StaticOrder>((char*)lds, AT, S, F.wave); ); \
    DO_PHASE(PH(l, 3), (l) >= 2, \
        phase_attn_combine(F, projb, projb + (size_t)M * D, args.in[9] + ((l) - 2) * 256, args.in[10] + ((l) - 2) * 128, args.lam_init[(l) & 1], onb); ); \
    DO_PHASE(PH(l, 4), true, \
        const bf16* W = ((l) < 2) ? (const bf16*)(ws + WS_WAOUT) + (size_t)(l) * D * D : (const bf16*)(ws + WS_WBOUT) + (size_t)((l) - 2) * D * D; \
        pg8::Gemm g{onb, W, M, D, D}; pg8::StaticOrder S; S.init(M, D, F.G, (int)blockIdx.x); \
        pg8::EpiBf16<0> E{mixb, D, nullptr, 0, 0, 1.f}; pg8::gemm_phase<pg8::EpiBf16<0>, pg8::StaticOrder, true, true>(F.lds, g, S, E, F.wave); ); \
    DO_PHASE(PH(l, 5), true, \
        phase_ln1_router(F, ((l) == 0) ? args.in[0] : nullptr, hb, mixb, args.in[12] + (l) * D, args.in[13] + (l) * D, h1b, (const bf16*)(ws + WS_WR) + (size_t)(l) * 48 * D, eid, gate, rep_ ? F.ctl + 131072 : counts); ); \
    DO_PHASE(PH(l, 6), true, phase_scatter(F, counts, rep_ ? F.ctl + 131072 + 4096 : cursor, eid, h1b, rep_ ? yrows : xrows, rep_ ? (int*)hid : apos); ); \
    DO_PHASE(PH(l, 7), true, const int ntiles = moe_layout(F, counts, psl, tile_e); \
        pg8::Gemm g{xrows, (const bf16*)(ws + WS_W13) + (size_t)(l) * 32 * 1024 * 1024, NROWS2, 1024, 1024}; pg8::MoeOrder S{ntiles * 4, F.G, F.vcu, tile_e}; \
        pg8::EpiSwiGLU E{hid, 512}; pg8::gemm_phase<pg8::EpiSwiGLU, pg8::MoeOrder, true, true>(F.lds, g, S, E, F.wave); ); \
    DO_PHASE(PH(l, 8), true, const int ntiles = moe_layout(F, counts, psl, tile_e); \
        pg8::Gemm g{hid, (const bf16*)(ws + WS_W2) + (size_t)(l) * 32 * 1024 * 512, NROWS2, 1024, 512}; pg8::MoeOrder S{ntiles * 4, F.G, F.vcu, tile_e}; \
        pg8::EpiBf16G E{yrows, 1024, 3}; pg8::gemm_phase<pg8::EpiBf16G, pg8::MoeOrder, true, true>(F.lds, g, S, E, F.wave); ); \
    DO_PHASE(PH(l, 9), true, \
        phase_combine_ln2(F, h1b, yrows, apos, gate, args.in[14] + (l) * D, args.in[15] + (l) * D, ((l) == 3) ? args.out : nullptr, hb); ); \
    } while (0)
    LAYER(0); LAYER(1); LAYER(2); LAYER(3);
#ifdef PROBE_A
    if (blockIdx.x == 0 && F.wave == 0 && __builtin_amdgcn_mbcnt_hi(~0u, __builtin_amdgcn_mbcnt_lo(~0u, 0u)) == 0u) {
        asm volatile("s_waitcnt vmcnt(0)" ::: "memory");
        volatile LAS unsigned long long* st = (volatile LAS unsigned long long*)(F.lds + STAMP_OFF);
        const float da = (PROBE_A >= 0) ? (float)(st[PROBE_A + 1] - st[PROBE_A]) * 0.01f : 1000.f;
        const float db = (PROBE_B >= 0) ? (float)(st[PROBE_B + 1] - st[PROBE_B]) * 0.01f : 0.f;
        args.out[0] = da; args.out[1] = db;
    }
#endif
#undef LAYER
#undef IN
#undef SEAM
#undef DO_PHASE
#undef STAMP
}

__global__ __launch_bounds__(256) void b2f_k(const unsigned short* __restrict__ src, int lds_, float* __restrict__ dst, int ldd, int cols, float scale) {
    const int row = blockIdx.x; for (int c = threadIdx.x; c < cols; c += 256) dst[(size_t)row * ldd + c] = __uint_as_float((unsigned)src[(size_t)row * lds_ + c] << 16) * scale;
}
__global__ __launch_bounds__(256) void f2b_k(const float* __restrict__ src, int lds_, unsigned short* __restrict__ dst, int ldd, int cols) {
    const int row = blockIdx.x; for (int c = threadIdx.x; c < cols; c += 256) dst[(size_t)row * ldd + c] = (unsigned short)f2bf(src[(size_t)row * lds_ + c]);
}

extern "C" void kernel_launch(void* const* d_in, const int* in_sizes, int n_in, void* d_out, int out_size, void* d_ws, size_t ws_size, hipStream_t stream) {
    static int grid = 0;
    if (grid == 0) {
        int dev = 0, cus = 0;
        if (hipGetDevice(&dev) != hipSuccess || hipDeviceGetAttribute(&cus, hipDeviceAttributeMultiprocessorCount, dev) != hipSuccess) { fprintf(stderr, "kernel_launch: device query failed\n"); grid = -1; return; }
        if (hipFuncSetAttribute((const void*)mega, hipFuncAttributeMaxDynamicSharedMemorySize, LDS_BYTES) != hipSuccess) { fprintf(stderr, "kernel_launch: hipFuncSetAttribute failed\n"); grid = -1; return; }
        int per_cu = 0; (void)hipOccupancyMaxActiveBlocksPerMultiprocessor(&per_cu, (const void*)mega, NWAVES * 64, LDS_BYTES); (void)hipGetLastError();
        if (per_cu < 1) fprintf(stderr, "kernel_launch: occupancy query says %d blocks per CU\n", per_cu);
        grid = cus;
        if (grid != 256) { fprintf(stderr, "kernel_launch: this kernel is built for a 256-CU device (got %d CUs); nothing launched\n", grid); grid = -1; return; }
    }
    if (grid < 0) return;
    unsigned char* ws = (unsigned char*)d_ws;
    if (WS_DN_END > ws_size) { fprintf(stderr, "kernel_launch: workspace too small: need %zu have %zu\n", (size_t)WS_DN_END, ws_size); return; }
    (void)hipMemsetAsync(ws + WS_CTL, 0, CTL_ZERO_BYTES, stream);
    Args a{};
    for (int i = 0; i < 20; ++i) a.in[i] = (const float*)d_in[i];
    a.out = (float*)d_out; a.ws = ws; a.lam_init[0] = (float)(0.8 - 0.6 * exp(-0.3 * 2.0)); a.lam_init[1] = (float)(0.8 - 0.6 * exp(-0.3 * 3.0));
    int nlaunch = 0;
    auto mk = [&](int lo, int hi) { a.ph_lo = lo; a.ph_hi = hi; a.bar_region = nlaunch++; hipLaunchKernelGGL(mega, dim3(grid), dim3(NWAVES * 64), LDS_BYTES, stream, a); };
#ifndef MULTI_LAUNCH
    mk(0, PH(3, 9) + 1);
#else
    mk(0, 1);
    for (int l = 0; l < 4; ++l) mk(PH(l, 0), PH(l, 9) + 1);
#endif
}
```
